# Optimizing an MI355X kernel written in HIP

```python
import math
import jax, jax.numpy as jnp
from jax import lax
import numpy as np

D_MODEL = 2048
BATCH = 8
SEQ = 2048
DEPTH = 1

HEAD_DIM = 128
N_HEADS_A = 8
D_A = N_HEADS_A * HEAD_DIM
DILATION_PATTERNS = ((128, 1), (512, 4), (2048, 16))
N_BUCKETS = 32
MAX_DISTANCE = 2048
CHUNK = 128
N_GROUPS_B = 8
D_GROUP_B = 128
D_B = N_GROUPS_B * D_GROUP_B
D_FF = 4 * D_MODEL
D_IN = 3 * D_A + 2 * D_B + 2 * D_MODEL
SPLITS = tuple(np.cumsum([D_A, D_A, D_A, D_B, D_B, D_MODEL]).tolist())
ALPHA = (2 * DEPTH) ** 0.25
BETA = (8 * DEPTH) ** -0.25
LN_EPS = 1e-5
NEG_INF = -1e30

kernel_name = "hybrid_dilated_attn_gmlp_block"


def layer_norm(x, gain, bias):
    xf = x.astype(jnp.float32)
    mean = jnp.mean(xf, axis=-1, keepdims=True)
    var = jnp.mean(jnp.square(xf - mean), axis=-1, keepdims=True)
    y = (xf - mean) * lax.rsqrt(var + LN_EPS) * gain.astype(jnp.float32) + bias.astype(jnp.float32)
    return y.astype(x.dtype)


def t5_causal_bucket(n):
    max_exact = N_BUCKETS // 2
    nf = jnp.maximum(n, 1).astype(jnp.float32)
    large = max_exact + (jnp.log(nf / max_exact) / math.log(MAX_DISTANCE / max_exact)
                         * (N_BUCKETS - max_exact)).astype(jnp.int32)
    large = jnp.minimum(large, N_BUCKETS - 1)
    return jnp.where(n < max_exact, n, large)


def dilated_window_attention(q, k, v, rel_bias, window, dilation):
    B, S, H, Dh = q.shape
    nb = window // dilation
    L = S // dilation
    nblk = -(-L // nb)
    Lp = nblk * nb

    def to_sub(t):
        t = t.reshape(B, L, dilation, H, Dh).transpose(0, 2, 1, 3, 4)
        t = jnp.pad(t, ((0, 0), (0, 0), (0, Lp - L), (0, 0), (0, 0)))
        return t.reshape(B, dilation, nblk, nb, H, Dh)

    def with_prev(t):
        prev = jnp.concatenate([jnp.zeros_like(t[:, :, :1]), t[:, :, :-1]], axis=2)
        return jnp.concatenate([prev, t], axis=3)

    qs = to_sub(q)
    kw = with_prev(to_sub(k))
    vw = with_prev(to_sub(v))

    scores = jnp.einsum('brnqhd,brnkhd->brnhqk', qs, kw).astype(jnp.float32) * (HEAD_DIM ** -0.5)

    qi = jnp.arange(nb)[:, None]
    kj = jnp.arange(2 * nb)[None, :]
    steps = nb + qi - kj
    band = (steps >= 0) & (steps <= nb)
    blk = jnp.arange(nblk)[:, None, None]
    key_ok = (blk * nb + kj[None] - nb) >= 0
    mask = band[None] & key_ok
    bucket = t5_causal_bucket(jnp.clip(steps, 0, nb) * dilation)
    bias = jnp.transpose(rel_bias[bucket].astype(jnp.float32), (2, 0, 1))

    scores = jnp.where(mask[None, None, :, None], scores + bias[None, None, None], NEG_INF)
    m = jnp.max(scores, axis=-1, keepdims=True)
    p = jnp.exp(scores - m)
    den = jnp.sum(p, axis=-1, keepdims=True)
    out = jnp.einsum('brnhqk,brnkhd->brnqhd', p, vw.astype(jnp.float32))
    den_t = jnp.transpose(den[..., 0], (0, 1, 2, 4, 3))
    out = out / den_t[..., None]
    lse = jnp.transpose(m[..., 0], (0, 1, 2, 4, 3)) + jnp.log(den_t)

    def from_sub(t):
        rest = t.shape[5:]
        t = t.reshape((B, dilation, Lp, H) + rest)[:, :, :L]
        t = jnp.moveaxis(t, 1, 2)
        return t.reshape((B, S, H) + rest)

    return from_sub(out), from_sub(lse)


def token_mixers(x, w_in, rel_bias, ln_v_gain, ln_v_bias, w_spatial, b_spatial,
                 w_proj_a, w_proj_b, w_out):
    B, S, _ = x.shape
    proj = jnp.einsum('bsd,de->bse', x, w_in)
    q, k, v, u, vb, ga, gb = jnp.split(proj, SPLITS, axis=-1)

    q = q.reshape(B, S, N_HEADS_A, HEAD_DIM)
    k = k.reshape(B, S, N_HEADS_A, HEAD_DIM)
    v = v.reshape(B, S, N_HEADS_A, HEAD_DIM)
    outs, lses = [], []
    for window, dilation in DILATION_PATTERNS:
        o, l = dilated_window_attention(q, k, v, rel_bias, window, dilation)
        outs.append(o)
        lses.append(l)
    mix_w = jax.nn.softmax(jnp.stack(lses, axis=0), axis=0)
    attn = jnp.sum(mix_w[..., None] * jnp.stack(outs, axis=0), axis=0)
    attn = attn.astype(x.dtype).reshape(B, S, D_A)

    u = jax.nn.gelu(u)
    vb = layer_norm(jax.nn.gelu(vb), ln_v_gain, ln_v_bias)
    nc = S // CHUNK
    vr = vb.reshape(B, nc, CHUNK, N_GROUPS_B, D_GROUP_B)
    causal = jnp.tril(jnp.ones((CHUNK, CHUNK), dtype=bool))
    ws = jnp.where(causal[None], w_spatial, 0.0).astype(vr.dtype)
    z = jnp.einsum('gij,bcjgd->bcigd', ws, vr) + jnp.transpose(b_spatial)[None, None, :, :, None]
    gmlp = (u.reshape(B, nc, CHUNK, N_GROUPS_B, D_GROUP_B) * z).reshape(B, S, D_B)

    y_a = jnp.einsum('bse,ed->bsd', attn, w_proj_a)
    y_b = jnp.einsum('bse,ed->bsd', gmlp, w_proj_b)
    merged = jax.nn.sigmoid(ga) * y_a + jax.nn.sigmoid(gb) * y_b
    return jnp.einsum('bsd,de->bse', merged, w_out)


def squared_relu_mlp(h, w_ff1, b_ff1, w_ff2, b_ff2):
    a = jnp.square(jax.nn.relu(jnp.einsum('bsd,df->bsf', h, w_ff1) + b_ff1))
    return jnp.einsum('bsf,fd->bsd', a, w_ff2) + b_ff2


def setup_inputs(seed: int = 0) -> dict:
    key = jax.random.key(seed)
    ks = jax.random.split(key, 20)
    nrm = jax.random.normal
    f32 = jnp.float32
    x = nrm(ks[0], (BATCH, SEQ, D_MODEL), f32)
    col_scale = jnp.concatenate([
        jnp.ones((2 * D_A,), f32),
        BETA * jnp.ones((D_A,), f32),
        jnp.ones((2 * D_B + 2 * D_MODEL,), f32)]) * (D_MODEL ** -0.5)
    w_in = nrm(ks[1], (DEPTH, D_MODEL, D_IN), f32) * col_scale
    rel_bias = 0.1 * nrm(ks[2], (N_BUCKETS, N_HEADS_A), f32)
    ln_v_gain = 1.0 + 0.01 * nrm(ks[3], (DEPTH, D_B), f32)
    ln_v_bias = 0.01 * nrm(ks[4], (DEPTH, D_B), f32)
    w_spatial = nrm(ks[5], (DEPTH, N_GROUPS_B, CHUNK, CHUNK), f32) * (CHUNK ** -0.5)
    b_spatial = 1.0 + 0.01 * nrm(ks[6], (DEPTH, N_GROUPS_B, CHUNK), f32)
    w_proj_a = nrm(ks[7], (DEPTH, D_A, D_MODEL), f32) * (D_A ** -0.5) * BETA
    w_proj_b = nrm(ks[8], (DEPTH, D_B, D_MODEL), f32) * (D_B ** -0.5) * BETA
    w_out = nrm(ks[9], (DEPTH, D_MODEL, D_MODEL), f32) * (D_MODEL ** -0.5) * BETA
    ln1_gain = 1.0 + 0.01 * nrm(ks[10], (DEPTH, D_MODEL), f32)
    ln1_bias = 0.01 * nrm(ks[11], (DEPTH, D_MODEL), f32)
    w_ff1 = nrm(ks[12], (DEPTH, D_MODEL, D_FF), f32) * (D_MODEL ** -0.5) * BETA
    b_ff1 = 0.01 * nrm(ks[13], (DEPTH, D_FF), f32)
    w_ff2 = nrm(ks[14], (DEPTH, D_FF, D_MODEL), f32) * (D_FF ** -0.5) * BETA
    b_ff2 = 0.01 * nrm(ks[15], (DEPTH, D_MODEL), f32)
    ln2_gain = 1.0 + 0.01 * nrm(ks[16], (DEPTH, D_MODEL), f32)
    ln2_bias = 0.01 * nrm(ks[17], (DEPTH, D_MODEL), f32)
    return {"x": x, "w_in": w_in, "rel_bias": rel_bias, "ln_v_gain": ln_v_gain,
            "ln_v_bias": ln_v_bias, "w_spatial": w_spatial, "b_spatial": b_spatial,
            "w_proj_a": w_proj_a, "w_proj_b": w_proj_b, "w_out": w_out,
            "ln1_gain": ln1_gain, "ln1_bias": ln1_bias, "w_ff1": w_ff1, "b_ff1": b_ff1,
            "w_ff2": w_ff2, "b_ff2": b_ff2, "ln2_gain": ln2_gain, "ln2_bias": ln2_bias}


def reference(x, w_in, rel_bias, ln_v_gain, ln_v_bias, w_spatial, b_spatial,
              w_proj_a, w_proj_b, w_out, ln1_gain, ln1_bias, w_ff1, b_ff1,
              w_ff2, b_ff2, ln2_gain, ln2_bias):
    h = x
    for layer in range(DEPTH):
        mix = token_mixers(h, w_in[layer], rel_bias, ln_v_gain[layer], ln_v_bias[layer],
                           w_spatial[layer], b_spatial[layer], w_proj_a[layer],
                           w_proj_b[layer], w_out[layer])
        h = layer_norm(ALPHA * h + mix, ln1_gain[layer], ln1_bias[layer])
        ff = squared_relu_mlp(h, w_ff1[layer], b_ff1[layer], w_ff2[layer], b_ff2[layer])
        h = layer_norm(ALPHA * h + ff, ln2_gain[layer], ln2_bias[layer])
    return h
```

```cpp
#include <hip/hip_runtime.h>
#include <cstdio>
#include <cstdint>

#ifndef MK_DEBUG_CHECKS
#define MK_DEBUG_CHECKS 0
#endif
#ifndef MK_ONE_LAUNCH
#define MK_ONE_LAUNCH 1
#endif

namespace pg8 {
#define PG8_LAS __attribute__((address_space(3)))
typedef unsigned short bf16_t;
typedef short bf16x8 __attribute__((ext_vector_type(8)));
typedef float f32x4 __attribute__((ext_vector_type(4)));
typedef float f32x2 __attribute__((ext_vector_type(2)));
typedef unsigned u32x4 __attribute__((ext_vector_type(4)));
typedef unsigned u32x2 __attribute__((ext_vector_type(2)));
constexpr int BM = 256, BK = 64, HALF = 128, HTB = HALF * BK * 2, STAGE_BYTES = 8 * HTB, NXCD = 8, WGM = 8;

__host__ __device__ __forceinline__ int lds_byte(int r, int c) { const int st = (r >> 4) * 2 + (c >> 5), rr = r & 15, cc = c & 31, ob = rr * 64 + cc * 2; return st * 1024 + (ob ^ (((ob >> 9) & 1) << 5)); }
__host__ __device__ __forceinline__ void stage_rc(int b, int& R, int& C) { const int st = b / 1024, sb = b % 1024, swz = sb ^ (((sb >> 9) & 1) << 5); R = (st >> 1) * 16 + swz / 64; C = (st & 1) * 32 + (swz % 64) / 2; }
__host__ __device__ __forceinline__ int perm32(int rho) { const int n = rho >> 4, i = rho & 15; return 8 * (i >> 2) + 4 * n + (i & 3); }

struct Unit { int pm, pn, kh; };
struct Gemm { const bf16_t* A; const bf16_t* Bt; int K; int ld; int khstep; };

struct StaticOrder {
    int nM, nN, nwg, G, c;
    __host__ __device__ void init(int M, int N, int G_, int c_) { nM = M / BM; nN = N / BM; nwg = nM * nN; G = G_; c = c_; }
    __host__ __device__ bool next(int i, Unit& u) const {
        const long L = (long)i * G + c; if (L >= nwg) return false;
        int wgid = (int)L; { const int q = nwg / NXCD, r = nwg % NXCD, xcd = wgid % NXCD, off = wgid / NXCD; wgid = (xcd < r ? xcd * (q + 1) : r * (q + 1) + (xcd - r) * q) + off; }
        const int nig = WGM * nN, gid = wgid / nig, fm = gid * WGM, gsz = (nM - fm) < WGM ? (nM - fm) : WGM;
        u.pm = fm + ((wgid % nig) % gsz); u.pn = (wgid % nig) / gsz; u.kh = 0; return true;
    }
};
struct PairOrder {
    StaticOrder so;
    __host__ __device__ bool next(int i, Unit& u) const { if (!so.next(i >> 1, u)) return false; u.kh = i & 1; return true; }
};

__device__ __forceinline__ unsigned cvt_pk_bf16(float lo, float hi) { unsigned r; asm volatile("v_cvt_pk_bf16_f32 %0, %1, %2" : "=v"(r) : "v"(lo), "v"(hi)); return r; }
__device__ __forceinline__ float bf_lo(unsigned w) { return __uint_as_float(w << 16); }
__device__ __forceinline__ float bf_hi(unsigned w) { return __uint_as_float(w & 0xffff0000u); }
__device__ __forceinline__ float fast_exp2(float x) { return __builtin_amdgcn_exp2f(x); }
__device__ __forceinline__ float fast_rcp(float x) { return __builtin_amdgcn_rcpf(x); }
__device__ __forceinline__ float gelu_tanh(float v) {
    const float t = v * (1.0f + 0.044715f * v * v);
    const float e = fast_exp2(t * (-2.0f * 0.7978845608028654f * 1.4426950408889634f));
    return v * fast_rcp(1.0f + e);
}


struct EpiProj {
    static constexpr bool PERM = true, AFTER_DRAIN = false, KEEPS = false;
    bf16_t *Q, *Kb, *V, *U, *VB, *GA, *GB; f32x2* vstat; float qscale;
    __device__ __forceinline__ bool operator()(f32x4 (&acc)[2][2][4][2], const Unit& u, int wr, int wc, int fr, int fq) const {
        const int pn = u.pn; bf16_t* base; int ldc = 1024, colt, act = 0; float sc = 1.0f;
        if (pn < 4) { base = Q; colt = pn * BM; sc = qscale; }
        else if (pn < 8) { base = Kb; colt = (pn - 4) * BM; }
        else if (pn < 12) { base = V; colt = (pn - 8) * BM; }
        else if (pn < 16) { base = U; colt = (pn - 12) * BM; act = 1; }
        else if (pn < 20) { base = VB; colt = (pn - 16) * BM; act = 2; }
        else if (pn < 28) { base = GA; colt = (pn - 20) * BM; ldc = 2048; }
        else { base = GB; colt = (pn - 28) * BM; ldc = 2048; }
        const int row0 = u.pm * BM + wr * 64 + fr, col0 = colt + wc * 32 + 8 * fq;
#pragma unroll
        for (int ai = 0; ai < 2; ++ai)
#pragma unroll
            for (int m = 0; m < 4; ++m) {
                const int row = row0 + ai * HALF + m * 16; bf16_t* rowp = base + (size_t)row * ldc + col0; float s1 = 0.f, s2 = 0.f;
#pragma unroll
                for (int bj = 0; bj < 2; ++bj) { f32x4 v0 = acc[ai][bj][m][0], v1 = acc[ai][bj][m][1];
                    if (act != 0) {
#pragma unroll
                        for (int e = 0; e < 4; ++e) { v0[e] = gelu_tanh(v0[e]); v1[e] = gelu_tanh(v1[e]); }
                        s1 += (v0[0] + v0[1]) + (v0[2] + v0[3]) + (v1[0] + v1[1]) + (v1[2] + v1[3]);
                        s2 += (v0[0] * v0[0] + v0[1] * v0[1]) + (v0[2] * v0[2] + v0[3] * v0[3]) + (v1[0] * v1[0] + v1[1] * v1[1]) + (v1[2] * v1[2] + v1[3] * v1[3]);
                    }
                    v0 = v0 * sc; v1 = v1 * sc; u32x4 w; w.x = cvt_pk_bf16(v0[0], v0[1]); w.y = cvt_pk_bf16(v0[2], v0[3]); w.z = cvt_pk_bf16(v1[0], v1[1]); w.w = cvt_pk_bf16(v1[2], v1[3]);
                    *(u32x4*)(rowp + bj * HALF) = w; }
                if (act == 2) {
                    s1 += __shfl_xor(s1, 16); s1 += __shfl_xor(s1, 32); s2 += __shfl_xor(s2, 16); s2 += __shfl_xor(s2, 32);
                    if (fq == 0) vstat[(size_t)row * 16 + (pn - 16) * 4 + wc] = (f32x2){s1, s2};
                }
            }
        return false;
    }
};
struct EpiGate {
    static constexpr bool PERM = true, AFTER_DRAIN = false, KEEPS = true;
    const bf16_t *GA, *GB; bf16_t* O;
    __device__ __forceinline__ bool operator()(f32x4 (&acc)[2][2][4][2], const Unit& u, int wr, int wc, int fr, int fq) const {
        const int row0 = u.pm * BM + wr * 64 + fr, col0 = u.pn * BM + wc * 32 + 8 * fq; const float NL2E = -1.4426950408889634f;
#pragma unroll
        for (int ai = 0; ai < 2; ++ai)
#pragma unroll
            for (int m = 0; m < 4; ++m) { const size_t off = (size_t)(row0 + ai * HALF + m * 16) * 2048 + col0;
#pragma unroll
                for (int bj = 0; bj < 2; ++bj) {
                    const u32x4 gb = *(const u32x4*)(GB + off + bj * HALF);
                    float eb[8]; eb[0] = bf_lo(gb.x); eb[1] = bf_hi(gb.x); eb[2] = bf_lo(gb.y); eb[3] = bf_hi(gb.y); eb[4] = bf_lo(gb.z); eb[5] = bf_hi(gb.z); eb[6] = bf_lo(gb.w); eb[7] = bf_hi(gb.w);
#pragma unroll
                    for (int e = 0; e < 8; ++e) eb[e] = 1.0f + fast_exp2(fmaxf(eb[e], -40.f) * NL2E);
                    if (u.kh == 0) {
                        const u32x4 ga = *(const u32x4*)(GA + off + bj * HALF);
                        float ea[8]; ea[0] = bf_lo(ga.x); ea[1] = bf_hi(ga.x); ea[2] = bf_lo(ga.y); ea[3] = bf_hi(ga.y); ea[4] = bf_lo(ga.z); ea[5] = bf_hi(ga.z); ea[6] = bf_lo(ga.w); ea[7] = bf_hi(ga.w);
#pragma unroll
                        for (int e = 0; e < 8; ++e) { const float r = eb[e] * fast_rcp(1.0f + fast_exp2(ea[e] * NL2E)); if (e < 4) acc[ai][bj][m][0][e] *= r; else acc[ai][bj][m][1][e - 4] *= r; }
                    } else {
                        float o[8];
#pragma unroll
                        for (int e = 0; e < 8; ++e) o[e] = (e < 4 ? acc[ai][bj][m][0][e] : acc[ai][bj][m][1][e - 4]) * fast_rcp(eb[e]);
                        u32x4 w; w.x = cvt_pk_bf16(o[0], o[1]); w.y = cvt_pk_bf16(o[2], o[3]); w.z = cvt_pk_bf16(o[4], o[5]); w.w = cvt_pk_bf16(o[6], o[7]);
                        *(u32x4*)(O + off + bj * HALF) = w;
                    }
                } }
        return u.kh == 0;
    }
};
struct EpiRelu2 {
    static constexpr bool PERM = true, AFTER_DRAIN = false, KEEPS = false;
    bf16_t* O; int ldc; const float* bias;
    __device__ __forceinline__ bool operator()(f32x4 (&acc)[2][2][4][2], const Unit& u, int wr, int wc, int fr, int fq) const {
        const int row0 = u.pm * BM + wr * 64 + fr, col0 = u.pn * BM + wc * 32 + 8 * fq;
        f32x4 bv[2][2];
#pragma unroll
        for (int bj = 0; bj < 2; ++bj)
#pragma unroll
            for (int n = 0; n < 2; ++n) bv[bj][n] = *(const f32x4*)(bias + col0 + bj * HALF + 4 * n);
#pragma unroll
        for (int ai = 0; ai < 2; ++ai)
#pragma unroll
            for (int m = 0; m < 4; ++m) { bf16_t* rowp = O + (size_t)(row0 + ai * HALF + m * 16) * ldc + col0;
#pragma unroll
                for (int bj = 0; bj < 2; ++bj) { f32x4 v0 = acc[ai][bj][m][0] + bv[bj][0], v1 = acc[ai][bj][m][1] + bv[bj][1];
#pragma unroll
                    for (int e = 0; e < 4; ++e) { const float a = fmaxf(v0[e], 0.f), b = fmaxf(v1[e], 0.f); v0[e] = a * a; v1[e] = b * b; }
                    u32x4 w; w.x = cvt_pk_bf16(v0[0], v0[1]); w.y = cvt_pk_bf16(v0[2], v0[3]); w.z = cvt_pk_bf16(v1[0], v1[1]); w.w = cvt_pk_bf16(v1[2], v1[3]);
                    *(u32x4*)(rowp + bj * HALF) = w; } }
        return false;
    }
};
struct EpiResF32 {
    static constexpr bool PERM = false, AFTER_DRAIN = false, KEEPS = false;
    const float* base; float* out; const float* bias; float alpha;
    __device__ __forceinline__ bool operator()(f32x4 (&acc)[2][2][4][2], const Unit& u, int wr, int wc, int fr, int fq) const {
        const int row0 = u.pm * BM + wr * 64 + fr, col0 = u.pn * BM + wc * 32 + 4 * fq;
        f32x4 bv[2][2];
#pragma unroll
        for (int bj = 0; bj < 2; ++bj)
#pragma unroll
            for (int n = 0; n < 2; ++n) bv[bj][n] = bias ? *(const f32x4*)(bias + col0 + bj * HALF + n * 16) : (f32x4){0.f, 0.f, 0.f, 0.f};
#pragma unroll
        for (int ai = 0; ai < 2; ++ai)
#pragma unroll
            for (int m = 0; m < 4; ++m) { const size_t off = (size_t)(row0 + ai * HALF + m * 16) * 2048 + col0;
#pragma unroll
                for (int bj = 0; bj < 2; ++bj)
#pragma unroll
                    for (int n = 0; n < 2; ++n) { const f32x4 bs = *(const f32x4*)(base + off + bj * HALF + n * 16);
                        *(f32x4*)(out + off + bj * HALF + n * 16) = bs * alpha + (acc[ai][bj][m][n] + bv[bj][n]); }
                if (m & 1) asm volatile("" ::: "memory"); }
        return false;
    }
};

template <class Epi, class Sched, bool ALIGN_EPI = false>
__device__ __forceinline__ void gemm_phase(PG8_LAS unsigned char* lds, const Gemm g, const Sched& S, const Epi& E) {
    const int tid = threadIdx.x, wid = __builtin_amdgcn_readfirstlane(tid >> 6), lane = tid & 63, wr = wid >> 2, wc = wid & 3, fr = lane & 15, fq = lane >> 4;
    const int K = g.K, nt = K / BK, ld = g.ld;
    unsigned voffA[2], voffB[2];
#pragma unroll
    for (int i = 0; i < 2; ++i) { int R, C; stage_rc(tid * 16 + i * 8192, R, C); const int Rb = Epi::PERM ? ((R & ~31) + perm32(R & 31)) : R;
        voffA[i] = (unsigned)(R * ld + C) * 2u; voffB[i] = (unsigned)(Rb * ld + C) * 2u; }
    const size_t kstep = (size_t)(BK * 2);
    const size_t hstep = (size_t)HALF * ld * 2;
    const size_t tstep = 2 * hstep;
    const unsigned ldsw = (unsigned)wid * 1024u;
    const int aoff = lds_byte(wr * 64 + fr, fq * 8), boff = lds_byte(wc * 32 + fr, fq * 8);
#define PG8_SA(b, h) (((b) * 2 + (h)) * HTB)
#define PG8_SB(b, h) ((4 + (b) * 2 + (h)) * HTB)
#define PG8_STAGE(bufoff, gbase, voff) do { _Pragma("unroll") for (int _i = 0; _i < 2; ++_i) \
        __builtin_amdgcn_global_load_lds((const unsigned*)((const char*)(gbase) + (voff)[_i]), (PG8_LAS unsigned*)(lds + (bufoff) + ldsw + _i * 8192), 16, 0, 0); } while (0)
#define PG8_LDA(dst, b, h) do { _Pragma("unroll") for (int m = 0; m < 4; ++m) _Pragma("unroll") for (int k = 0; k < 2; ++k) dst[m][k] = *(const PG8_LAS bf16x8*)(lds + PG8_SA(b, h) + aoff + m * 2048 + k * 1024); } while (0)
#define PG8_LDB(dst, b, h) do { _Pragma("unroll") for (int n = 0; n < 2; ++n) _Pragma("unroll") for (int k = 0; k < 2; ++k) dst[n][k] = *(const PG8_LAS bf16x8*)(lds + PG8_SB(b, h) + boff + n * 2048 + k * 1024); } while (0)
#define PG8_MMA(ai, bj, At, Bt) do { __builtin_amdgcn_s_setprio(1); _Pragma("unroll") for (int m = 0; m < 4; ++m) _Pragma("unroll") for (int n = 0; n < 2; ++n) _Pragma("unroll") for (int k = 0; k < 2; ++k) \
        acc[ai][bj][m][n] = __builtin_amdgcn_mfma_f32_16x16x32_bf16(Bt[n][k], At[m][k], acc[ai][bj][m][n], 0, 0, 0); __builtin_amdgcn_s_setprio(0); } while (0)
#define PG8_WAIT_V(n) asm volatile("s_waitcnt vmcnt(" #n ")" ::: "memory")
#define PG8_WAIT_L(n) asm volatile("s_waitcnt lgkmcnt(" #n ")" ::: "memory")
#define PG8_BAR __builtin_amdgcn_s_barrier()
#define PG8_SCHED __builtin_amdgcn_sched_barrier(0)
    Unit cur, nxt; int ui = 0;
    if (!S.next(0, cur)) return;
    f32x4 acc[2][2][4][2];
#pragma unroll
    for (int a = 0; a < 2; ++a)
#pragma unroll
        for (int b = 0; b < 2; ++b)
#pragma unroll
            for (int m = 0; m < 4; ++m)
#pragma unroll
                for (int n = 0; n < 2; ++n) acc[a][b][m][n] = (f32x4){0.f, 0.f, 0.f, 0.f};
    bf16x8 At[4][2], B0[2][2], B1[2][2];
    const char* cA = (const char*)g.A + (size_t)cur.pm * tstep + (size_t)cur.kh * g.khstep; const char* cB = (const char*)g.Bt + (size_t)cur.pn * tstep + (size_t)cur.kh * g.khstep;
    PG8_STAGE(PG8_SB(0, 0), cB, voffB); PG8_STAGE(PG8_SB(0, 1), cB + hstep, voffB); PG8_STAGE(PG8_SA(0, 0), cA, voffA); PG8_STAGE(PG8_SA(0, 1), cA + hstep, voffA);
    if (wr == 1) PG8_BAR;
    PG8_WAIT_V(2); PG8_BAR;
    PG8_STAGE(PG8_SB(1, 0), cB + kstep, voffB); PG8_STAGE(PG8_SA(1, 0), cA + kstep, voffA); PG8_STAGE(PG8_SB(1, 1), cB + hstep + kstep, voffB);
    PG8_WAIT_V(6); PG8_BAR;
    for (;;) {
        const bool has_next = S.next(ui + 1, nxt);
        const char* nA = has_next ? (const char*)g.A + (size_t)nxt.pm * tstep + (size_t)nxt.kh * g.khstep : cA; const char* nB = has_next ? (const char*)g.Bt + (size_t)nxt.pn * tstep + (size_t)nxt.kh * g.khstep : cB;
        for (int t = 0; t < nt; t += 2) {
            const bool last = (t == nt - 2);
            const char* a1 = cA + (size_t)(t + 1) * kstep;
            const char* a2 = last ? nA : cA + (size_t)(t + 2) * kstep; const char* b2 = last ? nB : cB + (size_t)(t + 2) * kstep;
            const char* a3 = a2 + kstep; const char* b3 = b2 + kstep;
            PG8_LDB(B0, 0, 0); PG8_LDB(B1, 0, 1); PG8_SCHED; PG8_LDA(At, 0, 0); PG8_STAGE(PG8_SA(1, 1), a1 + hstep, voffA);
            PG8_WAIT_V(8); PG8_WAIT_L(0); PG8_BAR; PG8_MMA(0, 0, At, B0); PG8_MMA(0, 1, At, B1); PG8_BAR; PG8_SCHED;
            PG8_LDA(At, 0, 1); PG8_STAGE(PG8_SB(0, 0), b2, voffB); PG8_STAGE(PG8_SB(0, 1), b2 + hstep, voffB); PG8_STAGE(PG8_SA(0, 0), a2, voffA);
            PG8_WAIT_V(8); PG8_WAIT_L(0); PG8_BAR; PG8_MMA(1, 0, At, B0); PG8_MMA(1, 1, At, B1); PG8_BAR; PG8_SCHED;
            PG8_LDB(B0, 1, 0); PG8_LDB(B1, 1, 1); PG8_SCHED; PG8_LDA(At, 1, 0); PG8_STAGE(PG8_SA(0, 1), a2 + hstep, voffA);
            PG8_WAIT_V(8); PG8_WAIT_L(0); PG8_BAR; PG8_MMA(0, 0, At, B0); PG8_MMA(0, 1, At, B1); PG8_BAR; PG8_SCHED;
            PG8_LDA(At, 1, 1); PG8_STAGE(PG8_SB(1, 0), b3, voffB); PG8_STAGE(PG8_SB(1, 1), b3 + hstep, voffB); PG8_STAGE(PG8_SA(1, 0), a3, voffA);
            PG8_WAIT_V(8); PG8_WAIT_L(0); PG8_BAR; PG8_MMA(1, 0, At, B0); PG8_MMA(1, 1, At, B1); PG8_BAR; PG8_SCHED;
        }
        if constexpr (ALIGN_EPI) { if (wr == 0) PG8_BAR; }
        const bool keep = E(acc, cur, wr, wc, fr, fq);
        if (!has_next) break;
        if (!(Epi::KEEPS && keep)) {
#pragma unroll
            for (int a = 0; a < 2; ++a)
#pragma unroll
                for (int b = 0; b < 2; ++b)
#pragma unroll
                    for (int m = 0; m < 4; ++m)
#pragma unroll
                        for (int n = 0; n < 2; ++n) acc[a][b][m][n] = (f32x4){0.f, 0.f, 0.f, 0.f};
        }
        cur = nxt; cA = nA; cB = nB; ++ui;
        if constexpr (ALIGN_EPI) { if (wr == 1) PG8_BAR; }
    }
    PG8_WAIT_V(0);
    if constexpr (!ALIGN_EPI) { if (wr == 0) PG8_BAR; }
    PG8_BAR;
#undef PG8_SA
#undef PG8_SB
#undef PG8_STAGE
#undef PG8_LDA
#undef PG8_LDB
#undef PG8_MMA
#undef PG8_WAIT_V
#undef PG8_WAIT_L
#undef PG8_BAR
#undef PG8_SCHED
}
}

constexpr int NWAVES = 8;
constexpr int BATCH = 8, SEQ = 2048, DM = 2048, M = BATCH * SEQ;
constexpr int NH = 8, HD = 128, DA = 1024, DB = 1024, DFF = 8192, DIN = 9216;
constexpr int NPAT = 3;
constexpr float LN_EPS = 1e-5f;
constexpr float ALPHA = 1.189207115002721f;
constexpr float LOG2E = 1.4426950408889634f;
constexpr float QSCALE = 0.08838834764831845f * 1.4426950408889634f;

constexpr size_t MiB = 1u << 20;
constexpr size_t WS_CTL = 0, CTL_ZERO_BYTES = 256 * 1024;
constexpr size_t WS_VSTAT = 1 * MiB;
constexpr size_t WS_LSE = 3 * MiB;
constexpr size_t WS_WSP = 5 * MiB - 512 * 1024;
constexpr size_t WS_BTAB = 5 * MiB - 128 * 1024;
constexpr size_t WS_WIN = 5 * MiB;
constexpr size_t WS_O1 = 5 * MiB;
constexpr size_t WS_WPAB = 41 * MiB;
constexpr size_t WS_WOUT = 49 * MiB;
constexpr size_t WS_W1 = 57 * MiB;
constexpr size_t WS_W2 = 89 * MiB;
constexpr size_t WS_O0 = 57 * MiB, WS_O2 = 89 * MiB;
constexpr size_t WS_XB = 121 * MiB;
constexpr size_t WS_AG = WS_XB, WS_HB = WS_XB;
constexpr size_t WS_Q = 185 * MiB, WS_K = 217 * MiB, WS_V = 249 * MiB, WS_U = 281 * MiB, WS_VB = 313 * MiB;
constexpr size_t WS_GA = 345 * MiB, WS_GB = 409 * MiB;
constexpr size_t WS_MRG = WS_Q;
constexpr size_t WS_ACT = 185 * MiB;
constexpr size_t WS_END = 473 * MiB;
constexpr int BT_PITCH = 132;
constexpr int CW_BAR = 4096;
constexpr int CW_CHK = 1024;

constexpr int RING_OFF = 0, RING_BYTES = 131072;
constexpr int LDSCTL_OFF = RING_BYTES, MISC_OFF = LDSCTL_OFF + 320;
constexpr int LDS_BT_OFF = RING_BYTES + 1024;
constexpr int LDS_BYTES = 147456;

#define GAS __attribute__((address_space(1)))
#define LAS __attribute__((address_space(3)))
typedef unsigned short bf16;
typedef unsigned v4u __attribute__((ext_vector_type(4)));
typedef unsigned v2u __attribute__((ext_vector_type(2)));
typedef float f32x4 __attribute__((ext_vector_type(4)));
typedef float f32x2 __attribute__((ext_vector_type(2)));
typedef short bf16x8 __attribute__((ext_vector_type(8)));
typedef short s16x4 __attribute__((ext_vector_type(4)));
typedef GAS unsigned gu32;
#define RLX_AGENT __ATOMIC_RELAXED, __HIP_MEMORY_SCOPE_AGENT
#define LDS_WAIT() asm volatile("s_waitcnt lgkmcnt(0)" ::: "memory")
#define VM_WAIT() asm volatile("s_waitcnt vmcnt(0)" ::: "memory")
__device__ __forceinline__ unsigned f2bf(float f) { unsigned u = __builtin_bit_cast(unsigned, f); return (u + 0x7fffu + ((u >> 16) & 1u)) >> 16; }
__device__ __forceinline__ unsigned pk2(float lo, float hi) { return f2bf(lo) | (f2bf(hi) << 16); }
__device__ __forceinline__ float bf2f(bf16 v) { return __uint_as_float((unsigned)v << 16); }

#define XB_TMO      128
#define XB_XCNT(j)  (256  + 64 * (j))
#define XB_XSUB(j)  (1280 + 64 * (j))
#define XB_XGEN(j)  (2304 + 64 * (j))
#define XB_TOP      3328
#define XB_TOPGEN   3392
#define XCD_BAR_WORDS 3456
#define XB_SPIN_CAP (1u << 22)
__device__ __forceinline__ unsigned xb_ld(unsigned* p)              { return __hip_atomic_load(p, __ATOMIC_RELAXED, __HIP_MEMORY_SCOPE_AGENT); }
__device__ __forceinline__ unsigned xb_add(unsigned* p, unsigned v) { return __hip_atomic_fetch_add(p, v, __ATOMIC_RELAXED, __HIP_MEMORY_SCOPE_AGENT); }
__device__ __forceinline__ unsigned xb_xcc_id() { return (unsigned)__builtin_amdgcn_s_getreg((3 << 11) | 20) & 0xFu; }
#define XB_SPIN(cond, bar) do { unsigned _sp = 0; while (cond) { __builtin_amdgcn_s_sleep(1); \
    if ((++_sp & 255u) == 0u) { if (xb_ld(&(bar)[XB_TMO])) break; if (_sp > XB_SPIN_CAP) { atomicAdd(&(bar)[XB_TMO], 1u); break; } } } } while (0)
struct XcdBarrier { unsigned* bar; unsigned x; volatile LAS unsigned* st; };
__device__ __forceinline__ XcdBarrier xcd_barrier_post(unsigned* bar, volatile LAS unsigned* st) {
    XcdBarrier b; b.bar = bar; b.x = xb_xcc_id(); b.st = st;
    if (threadIdx.x == 0) (void)xb_add(&bar[XB_XCNT(b.x)], 1u);
    return b;
}
__device__ __forceinline__ void xcd_barrier_complete(unsigned* bar, unsigned x, unsigned& nloc, unsigned& nx) {
    const unsigned G = gridDim.x * gridDim.y * gridDim.z;
    unsigned sum, cnt, mine, sp = 0u;
    for (;;) {
        sum = 0u; cnt = 0u; mine = 0u;
#pragma unroll
        for (unsigned j = 0; j < 16; ++j) { const unsigned c = xb_ld(&bar[XB_XCNT(j)]); sum += c; cnt += (c > 0u) ? 1u : 0u; mine = (j == x) ? c : mine; }
        if (sum == G) break;
        __builtin_amdgcn_s_sleep(1);
        if ((++sp & 255u) == 0u) { if (xb_ld(&bar[XB_TMO])) break; if (sp > XB_SPIN_CAP) { atomicAdd(&bar[XB_TMO], 1u); break; } }
    }
    nloc = mine > 0u ? mine : 1u; nx = cnt > 0u ? cnt : 1u;
}
__device__ __forceinline__ void xcd_barrier(const XcdBarrier& b) {
    asm volatile("s_waitcnt vmcnt(0)" ::: "memory");
    __syncthreads();
    if (threadIdx.x == 0) {
        unsigned* bar = b.bar;
        __builtin_amdgcn_s_waitcnt(0);
        unsigned nloc = b.st[0], nx = b.st[1];
        if (nloc == 0u) { xcd_barrier_complete(bar, b.x, nloc, nx); b.st[0] = nloc; b.st[1] = nx; }
        const unsigned old = xb_add(&bar[XB_XSUB(b.x)], 1u);
        const unsigned gen = old / nloc;
        if (old + 1u == (gen + 1u) * nloc) {
            __builtin_amdgcn_fence(__ATOMIC_RELEASE, "agent");
            asm volatile("s_waitcnt vmcnt(0)" ::: "memory");
            const unsigned og = xb_add(&bar[XB_TOP], 1u);
            const unsigned tg = og / nx;
            if (og + 1u == (tg + 1u) * nx) xb_add(&bar[XB_TOPGEN], 1u);
            else XB_SPIN(xb_ld(&bar[XB_TOPGEN]) == tg, bar);
            __builtin_amdgcn_fence(__ATOMIC_ACQUIRE, "agent");
            xb_add(&bar[XB_XGEN(b.x)], 1u);
            asm volatile("s_waitcnt vmcnt(0)" ::: "memory");
        } else {
            XB_SPIN(xb_ld(&bar[XB_XGEN(b.x)]) == gen, bar);
            __builtin_amdgcn_fence(__ATOMIC_ACQUIRE, "agent");
            asm volatile("s_waitcnt vmcnt(0)" ::: "memory");
        }
    }
    __syncthreads();
}

struct Args { const float* in[18]; float* out; unsigned char* ws; int ph_lo, ph_hi; };
struct Frame {
    LAS unsigned char* lds;
    int tid, lane, wave, G, bid;
    const float* const* in; float* out; unsigned char* ws;
};
__device__ __forceinline__ float wave_sum(float v) {
#pragma unroll
    for (int o = 1; o < 64; o <<= 1) v += __shfl_xor(v, o);
    return v;
}

__device__ __forceinline__ void transpose_item(const float* W, int N, bf16* WT, int ldt, int koff, LAS float* scr, int item, int lane) {
    const int nblk = N / 32, kb = item / nblk, nb = item % nblk, k0 = 64 * kb, n0 = 32 * nb;
#pragma unroll 8
    for (int i = 0; i < 32; ++i) { const int kk = 2 * i + (lane >> 5); scr[kk * 33 + (lane & 31)] = W[(size_t)(k0 + kk) * N + n0 + (lane & 31)]; }
    LDS_WAIT(); asm volatile("" ::: "memory");
    const int c = lane & 7;
#pragma unroll
    for (int j = 0; j < 4; ++j) { const int n = (lane >> 3) + 8 * j; const LAS float* s = scr + (8 * c) * 33 + n;
        v4u o; o.x = pk2(s[0 * 33], s[1 * 33]); o.y = pk2(s[2 * 33], s[3 * 33]); o.z = pk2(s[4 * 33], s[5 * 33]); o.w = pk2(s[6 * 33], s[7 * 33]);
        *(GAS v4u*)(WT + (size_t)(n0 + n) * ldt + koff + k0 + 8 * c) = o; }
    LDS_WAIT(); asm volatile("" ::: "memory");
}
__device__ __forceinline__ int t5_bucket(int n) {
    if (n < 16) return n;
    const float nf = (float)n;
    int large = 16 + (int)(logf(nf / 16.0f) / 4.852030263919617f * 16.0f);
    return large < 31 ? large : 31;
}
__device__ __forceinline__ int pat_dil(int p) { return p == 0 ? 1 : (p == 1 ? 4 : 16); }

__device__ __forceinline__ void phase_prologue(Frame& F) {
    LAS float* scr = (LAS float*)(F.lds + RING_OFF + F.wave * 16384);
    const int gw = F.bid * NWAVES + F.wave, NGW = F.G * NWAVES;
    const float* w_in = F.in[1]; const float* wpa = F.in[7]; const float* wpb = F.in[8]; const float* wout = F.in[9];
    bf16* Win_t = (bf16*)(F.ws + WS_WIN); bf16* Wpab_t = (bf16*)(F.ws + WS_WPAB); bf16* Wout_t = (bf16*)(F.ws + WS_WOUT);
    constexpr int I_IN = (DM / 64) * (DIN / 32), I_PA = (DA / 64) * (DM / 32), I_OUT = (DM / 64) * (DM / 32);
    constexpr int NITEMS = I_IN + 2 * I_PA + I_OUT;
    for (int it = gw; it < NITEMS; it += NGW) {
        int r = it;
        if (r < I_IN) { transpose_item(w_in, DIN, Win_t, DM, 0, scr, r, F.lane); continue; } r -= I_IN;
        if (r < I_PA) { transpose_item(wpa, DM, Wpab_t, 2048, 0, scr, r, F.lane); continue; } r -= I_PA;
        if (r < I_PA) { transpose_item(wpb, DM, Wpab_t, 2048, 1024, scr, r, F.lane); continue; } r -= I_PA;
        transpose_item(wout, DM, Wout_t, 2048, 0, scr, r, F.lane);
    }
    const float* x = F.in[0]; bf16* XB = (bf16*)(F.ws + WS_XB);
    for (int m = gw; m < M; m += NGW) {
        const GAS f32x4* xr = (const GAS f32x4*)(x + (size_t)m * DM) + F.lane; GAS v2u* o = (GAS v2u*)(XB + (size_t)m * DM) + F.lane;
#pragma unroll
        for (int j = 0; j < 8; ++j) { const f32x4 v = xr[64 * j]; o[64 * j] = (v2u){pk2(v.x, v.y), pk2(v.z, v.w)}; }
    }
    const int gt = F.bid * (NWAVES * 64) + F.tid, NGT = F.G * NWAVES * 64;
    const float* wsp = F.in[5]; bf16* WSP = (bf16*)(F.ws + WS_WSP);
    for (int e = gt; e < 8 * 128 * 128; e += NGT) { const int i = (e >> 7) & 127, j = e & 127; WSP[e] = (bf16)(j <= i ? f2bf(wsp[e]) : 0u); }
    const float* rb = F.in[2]; float* BT = (float*)(F.ws + WS_BTAB);
    for (int e = gt; e < NPAT * NH * BT_PITCH; e += NGT) { const int p = e / (NH * BT_PITCH), h = (e / BT_PITCH) % NH, j = e % BT_PITCH;
        BT[e] = (j <= 128) ? rb[t5_bucket(j * pat_dil(p)) * NH + h] * LOG2E : 0.f; }
}
__device__ __forceinline__ void phase_convert_ffn(Frame& F) {
    LAS float* scr = (LAS float*)(F.lds + RING_OFF + F.wave * 16384);
    const int gw = F.bid * NWAVES + F.wave, NGW = F.G * NWAVES;
    constexpr int I_1 = (DM / 64) * (DFF / 32), I_2 = (DFF / 64) * (DM / 32);
    bf16* W1_t = (bf16*)(F.ws + WS_W1); bf16* W2_t = (bf16*)(F.ws + WS_W2);
    for (int it = gw; it < I_1 + I_2; it += NGW) {
        if (it < I_1) transpose_item(F.in[12], DFF, W1_t, DM, 0, scr, it, F.lane);
        else transpose_item(F.in[14], DM, W2_t, DFF, 0, scr, it - I_1, F.lane);
    }
}
__device__ __forceinline__ void phase_ln(Frame& F, float* buf, const float* gain, const float* bias, bf16* ob) {
    const int gw = F.bid * NWAVES + F.wave, NGW = F.G * NWAVES;
    for (int m = gw; m < M; m += NGW) {
        GAS f32x4* xr = (GAS f32x4*)(buf + (size_t)m * DM) + F.lane;
        f32x4 v[8]; float s = 0.f;
#pragma unroll
        for (int j = 0; j < 8; ++j) { v[j] = xr[64 * j]; s += (v[j].x + v[j].y) + (v[j].z + v[j].w); }
        const float mean = wave_sum(s) * (1.f / DM); float s2 = 0.f;
#pragma unroll
        for (int j = 0; j < 8; ++j) { v[j] = v[j] - mean; s2 += (v[j].x * v[j].x + v[j].y * v[j].y) + (v[j].z * v[j].z + v[j].w * v[j].w); }
        const float rstd = 1.f / sqrtf(wave_sum(s2) * (1.f / DM) + LN_EPS);
#pragma unroll
        for (int j = 0; j < 8; ++j) { const f32x4 g = ((const GAS f32x4*)gain)[64 * j + F.lane], b = ((const GAS f32x4*)bias)[64 * j + F.lane];
            const f32x4 o = v[j] * rstd * g + b; xr[64 * j] = o;
            if (ob) ((GAS v2u*)(ob + (size_t)m * DM))[64 * j + F.lane] = (v2u){pk2(o.x, o.y), pk2(o.z, o.w)}; }
    }
}
__device__ __forceinline__ void phase_combine(Frame& F) {
    const int gw = F.bid * NWAVES + F.wave, NGW = F.G * NWAVES;
    const bf16* O0 = (const bf16*)(F.ws + WS_O0); const bf16* O1 = (const bf16*)(F.ws + WS_O1); const bf16* O2 = (const bf16*)(F.ws + WS_O2);
    const float* LSE = (const float*)(F.ws + WS_LSE); bf16* AG = (bf16*)(F.ws + WS_AG);
    for (int m = gw; m < M; m += NGW) {
        const int h = F.lane >> 3;
        const float l0 = LSE[((size_t)0 * M + m) * NH + h], l1 = LSE[((size_t)1 * M + m) * NH + h], l2 = LSE[((size_t)2 * M + m) * NH + h];
        const float mx = fmaxf(l0, fmaxf(l1, l2)); float w0 = exp2f(l0 - mx), w1 = exp2f(l1 - mx), w2 = exp2f(l2 - mx); const float inv = 1.f / (w0 + w1 + w2); w0 *= inv; w1 *= inv; w2 *= inv;
        const size_t off = (size_t)m * DA + F.lane * 16;
#pragma unroll
        for (int c = 0; c < 2; ++c) {
            const v4u a = *(const GAS v4u*)(O0 + off + c * 8), b = *(const GAS v4u*)(O1 + off + c * 8), d = *(const GAS v4u*)(O2 + off + c * 8); v4u o;
#pragma unroll
            for (int e = 0; e < 4; ++e) { const float lo = w0 * pg8::bf_lo(a[e]) + w1 * pg8::bf_lo(b[e]) + w2 * pg8::bf_lo(d[e]); const float hi = w0 * pg8::bf_hi(a[e]) + w1 * pg8::bf_hi(b[e]) + w2 * pg8::bf_hi(d[e]); o[e] = pk2(lo, hi); }
            *(GAS v4u*)(AG + (size_t)m * 2048 + F.lane * 16 + c * 8) = o;
        }
    }
}

__device__ __forceinline__ s16x4 tr_read(const LAS unsigned char* p) { return __builtin_bit_cast(s16x4, __builtin_amdgcn_ds_read_tr16_b64_v4i16((LAS s16x4*)p)); }
constexpr int ATT_K_OFF = 0, ATT_V_OFF = 65536;

__device__ __forceinline__ void attn_unit(Frame& F, int uid) {
    const int bh = uid / 48, x = uid % 48, b = bh >> 3, h = bh & 7;
    int p, r, blk;
    if (x < 16) { p = 0; r = 0; blk = x; } else if (x < 32) { p = 1; r = (x - 16) >> 2; blk = (x - 16) & 3; } else { p = 2; r = x - 32; blk = 0; }
    const int d = pat_dil(p);
    const int tid = F.tid, lane = F.lane, w = F.wave, fr = lane & 15, g = lane >> 4;
    const bf16* Qg = (const bf16*)(F.ws + WS_Q); const bf16* Kg = (const bf16*)(F.ws + WS_K); const bf16* Vg = (const bf16*)(F.ws + WS_V);
    bf16* Og = (bf16*)(F.ws + (p == 0 ? WS_O0 : (p == 1 ? WS_O1 : WS_O2)));
    float* LSE = (float*)(F.ws + WS_LSE);
    LAS unsigned char* lds = F.lds;
    LAS float* BTl = (LAS float*)(lds + LDS_BT_OFF);
    const size_t rowbase = (size_t)b * SEQ;
    const int kt_lo = (blk == 0) ? 8 : 0;
    {
        v4u kr[8], vr[8];
#pragma unroll
        for (int it = 0; it < 8; ++it) if (it * 2 >= kt_lo) {
            const int idx = it * 512 + tid, kj = idx >> 4, gr = idx & 15;
            const size_t row = rowbase + r + d * (128 * (blk - 1) + kj);
            kr[it] = *(const GAS v4u*)(Kg + row * DA + h * HD + gr * 8); vr[it] = *(const GAS v4u*)(Vg + row * DA + h * HD + gr * 8);
        }
#pragma unroll
        for (int it = 0; it < 8; ++it) if (it * 2 >= kt_lo) {
            const int idx = it * 512 + tid, kj = idx >> 4, gr = idx & 15;
            *(LAS v4u*)(lds + ATT_K_OFF + kj * 256 + ((gr ^ (kj & 15)) << 4)) = kr[it];
            *(LAS v4u*)(lds + ATT_V_OFF + kj * 256 + ((gr ^ ((kj & 7) << 1)) << 4)) = vr[it];
        }
        if (tid < BT_PITCH) BTl[tid] = ((const float*)(F.ws + WS_BTAB))[(p * NH + h) * BT_PITCH + tid];
    }
    const int qi = 16 * w + fr;
    const size_t qrow = rowbase + r + d * (128 * blk + qi);
    bf16x8 qf[4];
#pragma unroll
    for (int ks = 0; ks < 4; ++ks) qf[ks] = *(const GAS bf16x8*)(Qg + qrow * DA + h * HD + 32 * ks + 8 * g);
    LDS_WAIT(); __syncthreads();
    f32x4 st[9]; float mx = -1e30f;
#pragma unroll
    for (int t = 0; t < 9; ++t) {
        const int kt = w + t;
        if (kt >= kt_lo) {
            f32x4 a = (f32x4){0.f, 0.f, 0.f, 0.f};
            const int key = 16 * kt + fr;
#pragma unroll
            for (int ks = 0; ks < 4; ++ks) { const bf16x8 kf = *(const LAS bf16x8*)(lds + ATT_K_OFF + key * 256 + (((4 * ks + g) ^ fr) << 4));
                a = __builtin_amdgcn_mfma_f32_16x16x32_bf16(kf, qf[ks], a, 0, 0, 0); }
#pragma unroll
            for (int e = 0; e < 4; ++e) { const int kj = 16 * kt + 4 * g + e, steps = 128 + qi - kj; const bool ok = (steps >= 0) && (steps <= 128);
                const float v = ok ? a[e] + BTl[ok ? steps : 0] : -1e30f; a[e] = v; mx = fmaxf(mx, v); }
            st[t] = a;
        } else st[t] = (f32x4){-1e30f, -1e30f, -1e30f, -1e30f};
    }
    mx = fmaxf(mx, __shfl_xor(mx, 16)); mx = fmaxf(mx, __shfl_xor(mx, 32));
    float lsum = 0.f;
#pragma unroll
    for (int t = 0; t < 9; ++t)
#pragma unroll
        for (int e = 0; e < 4; ++e) { const float pv = pg8::fast_exp2(st[t][e] - mx); st[t][e] = pv; lsum += pv; }
    lsum += __shfl_xor(lsum, 16); lsum += __shfl_xor(lsum, 32);
    f32x4 o[8];
#pragma unroll
    for (int mt = 0; mt < 8; ++mt) o[mt] = (f32x4){0.f, 0.f, 0.f, 0.f};
#pragma unroll
    for (int a = 0; a < 5; ++a) {
        const int kt0 = w + 2 * a, kt1 = kt0 + 1; const bool v0 = kt0 >= kt_lo, v1 = (2 * a + 1 <= 8) && (kt1 >= kt_lo);
        if (v0 || v1) {
            v4u pw; pw.x = pg8::cvt_pk_bf16(st[2 * a][0], st[2 * a][1]); pw.y = pg8::cvt_pk_bf16(st[2 * a][2], st[2 * a][3]);
            if (2 * a + 1 <= 8) { pw.z = pg8::cvt_pk_bf16(st[(2 * a + 1 <= 8) ? 2 * a + 1 : 0][0], st[(2 * a + 1 <= 8) ? 2 * a + 1 : 0][1]); pw.w = pg8::cvt_pk_bf16(st[(2 * a + 1 <= 8) ? 2 * a + 1 : 0][2], st[(2 * a + 1 <= 8) ? 2 * a + 1 : 0][3]); }
            else { pw.z = 0u; pw.w = 0u; }
            if (!v0) { pw.x = 0u; pw.y = 0u; }
            if (!v1) { pw.z = 0u; pw.w = 0u; }
            const bf16x8 pf = __builtin_bit_cast(bf16x8, pw);
            const int krow = 4 * g + (fr >> 2), ksw = ((krow & 7) << 1);
            const LAS unsigned char* v0p = lds + ATT_V_OFF + (16 * kt0 + krow) * 256 + ((lane & 1) << 3);
            const LAS unsigned char* v1p = lds + ATT_V_OFF + (16 * kt1 + krow) * 256 + ((lane & 1) << 3);
#pragma unroll
            for (int mt = 0; mt < 8; ++mt) {
                const int gsw = ((2 * mt + ((lane & 3) >> 1)) ^ ksw) << 4;
                s16x4 lo = (s16x4){0, 0, 0, 0}, hi = (s16x4){0, 0, 0, 0};
                if (v0) lo = tr_read(v0p + gsw);
                if (v1) hi = tr_read(v1p + gsw);
                const bf16x8 vf = (bf16x8){lo[0], lo[1], lo[2], lo[3], hi[0], hi[1], hi[2], hi[3]};
                o[mt] = __builtin_amdgcn_mfma_f32_16x16x32_bf16(vf, pf, o[mt], 0, 0, 0);
            }
        }
    }
    const float inv = 1.0f / lsum;
    bf16* orow = Og + qrow * DA + h * HD + 4 * g;
#pragma unroll
    for (int mt = 0; mt < 8; ++mt) { const f32x4 v = o[mt] * inv; *(GAS v2u*)(orow + 16 * mt) = (v2u){pg8::cvt_pk_bf16(v[0], v[1]), pg8::cvt_pk_bf16(v[2], v[3])}; }
    if (g == 0) LSE[((size_t)p * M + qrow) * NH + h] = mx + log2f(lsum);
    LDS_WAIT(); __syncthreads();
}

__device__ __forceinline__ void gmlp_unit(Frame& F, int uid) {
    const int gg = uid & 7, c = (uid >> 3) & 15, b = uid >> 7;
    const int tid = F.tid, lane = F.lane, w = F.wave, fr = lane & 15, g = lane >> 4;
    LAS unsigned char* lds = F.lds;
    LAS f32x2* STl = (LAS f32x2*)(lds + LDS_BT_OFF);
    const size_t R0 = (size_t)b * SEQ + 128 * c;
    const bf16* VBg = (const bf16*)(F.ws + WS_VB); const bf16* Ug = (const bf16*)(F.ws + WS_U); const bf16* WSP = (const bf16*)(F.ws + WS_WSP) + (size_t)gg * 128 * 128;
    const f32x2* VST = (const f32x2*)(F.ws + WS_VSTAT); bf16* AG = (bf16*)(F.ws + WS_AG);
    const float* gain = F.in[3]; const float* biasv = F.in[4]; const float* bsp = F.in[6];
    if (tid < 128) { float s1 = 0.f, s2 = 0.f;
#pragma unroll
        for (int k = 0; k < 16; ++k) { const f32x2 t = VST[(R0 + tid) * 16 + k]; s1 += t.x; s2 += t.y; }
        const float mean = s1 * (1.f / DB), var = fmaxf(s2 * (1.f / DB) - mean * mean, 0.f);
        STl[tid] = (f32x2){mean, 1.0f / sqrtf(var + LN_EPS)}; }
    LDS_WAIT(); __syncthreads();
#pragma unroll
    for (int it = 0; it < 4; ++it) {
        const int idx = it * 512 + tid, j = idx >> 4, gr = idx & 15;
        const v4u raw = *(const GAS v4u*)(VBg + (R0 + j) * DB + gg * 128 + gr * 8);
        const f32x2 st = STl[j];
        const f32x4 g0 = *(const GAS f32x4*)(gain + gg * 128 + gr * 8), g1 = *(const GAS f32x4*)(gain + gg * 128 + gr * 8 + 4);
        const f32x4 b0 = *(const GAS f32x4*)(biasv + gg * 128 + gr * 8), b1 = *(const GAS f32x4*)(biasv + gg * 128 + gr * 8 + 4);
        v4u o;
        o.x = pk2((pg8::bf_lo(raw.x) - st.x) * st.y * g0[0] + b0[0], (pg8::bf_hi(raw.x) - st.x) * st.y * g0[1] + b0[1]);
        o.y = pk2((pg8::bf_lo(raw.y) - st.x) * st.y * g0[2] + b0[2], (pg8::bf_hi(raw.y) - st.x) * st.y * g0[3] + b0[3]);
        o.z = pk2((pg8::bf_lo(raw.z) - st.x) * st.y * g1[0] + b1[0], (pg8::bf_hi(raw.z) - st.x) * st.y * g1[1] + b1[1]);
        o.w = pk2((pg8::bf_lo(raw.w) - st.x) * st.y * g1[2] + b1[2], (pg8::bf_hi(raw.w) - st.x) * st.y * g1[3] + b1[3]);
        *(LAS v4u*)(lds + j * 256 + ((gr ^ ((j & 7) << 1)) << 4)) = o;
    }
    LDS_WAIT(); __syncthreads();
    const int i = 16 * w + fr;
    f32x4 acc[8];
#pragma unroll
    for (int mt = 0; mt < 8; ++mt) acc[mt] = (f32x4){0.f, 0.f, 0.f, 0.f};
    const int nks = (w >> 1) + 1;
    for (int ks = 0; ks < nks; ++ks) {
        const bf16x8 wf = *(const GAS bf16x8*)(WSP + (size_t)i * 128 + 32 * ks + 8 * g);
        const int j0 = 32 * ks + 8 * g + (fr >> 2), j1 = j0 + 4;
        const LAS unsigned char* p0 = lds + j0 * 256 + ((lane & 1) << 3); const LAS unsigned char* p1 = lds + j1 * 256 + ((lane & 1) << 3);
        const int s0 = (j0 & 7) << 1, s1 = (j1 & 7) << 1;
#pragma unroll
        for (int mt = 0; mt < 8; ++mt) {
            const int gb = 2 * mt + ((lane & 3) >> 1);
            const s16x4 lo = tr_read(p0 + ((gb ^ s0) << 4)), hi = tr_read(p1 + ((gb ^ s1) << 4));
            const bf16x8 vf = (bf16x8){lo[0], lo[1], lo[2], lo[3], hi[0], hi[1], hi[2], hi[3]};
            acc[mt] = __builtin_amdgcn_mfma_f32_16x16x32_bf16(vf, wf, acc[mt], 0, 0, 0);
        }
    }
    const float bs = bsp[gg * 128 + i];
    const bf16* urow = Ug + (R0 + i) * DB + gg * 128 + 4 * g; bf16* orow = AG + (R0 + i) * 2048 + 1024 + gg * 128 + 4 * g;
#pragma unroll
    for (int mt = 0; mt < 8; ++mt) { const v2u uu = *(const GAS v2u*)(urow + 16 * mt);
        const float z0 = (acc[mt][0] + bs) * pg8::bf_lo(uu.x), z1 = (acc[mt][1] + bs) * pg8::bf_hi(uu.x), z2 = (acc[mt][2] + bs) * pg8::bf_lo(uu.y), z3 = (acc[mt][3] + bs) * pg8::bf_hi(uu.y);
        *(GAS v2u*)(orow + 16 * mt) = (v2u){pg8::cvt_pk_bf16(z0, z1), pg8::cvt_pk_bf16(z2, z3)}; }
    LDS_WAIT(); __syncthreads();
}
__device__ __forceinline__ void phase_mixers(Frame& F) {
    for (int u = F.bid; u < BATCH * NH * 48; u += F.G) attn_unit(F, u);
    for (int u = F.bid; u < BATCH * 16 * 8; u += F.G) gmlp_unit(F, u);
}

constexpr int N_PHASES = 10;
__global__ void __launch_bounds__(NWAVES * 64, 2) mk_fwd(Args args) {
    extern __shared__ __attribute__((aligned(16))) unsigned char lds_raw[];
    Frame F;
    F.lds = (LAS unsigned char*)lds_raw;
    F.tid = threadIdx.x; F.lane = F.tid & 63; F.wave = __builtin_amdgcn_readfirstlane(F.tid >> 6);
    F.G = gridDim.x; F.bid = blockIdx.x; F.in = args.in; F.out = args.out; F.ws = args.ws;
    for (int u = F.tid; u < (LDS_BYTES - LDSCTL_OFF) / 4; u += NWAVES * 64) ((LAS unsigned*)(F.lds + LDSCTL_OFF))[u] = 0u;
    __syncthreads();
    gu32* ctl = (gu32*)(args.ws + WS_CTL);
    const int lo = args.ph_lo, hi = args.ph_hi;
    XcdBarrier bar; bar.bar = (unsigned*)(ctl + CW_BAR); bar.x = 0; bar.st = nullptr;
    if (hi - lo > 1) bar = xcd_barrier_post((unsigned*)(ctl + CW_BAR), (volatile LAS unsigned*)(F.lds + MISC_OFF) + 8);
#define IN(k) (lo <= (k) && (k) < hi)
#define SEAM(k) do { if (IN(k) && IN((k) + 1)) xcd_barrier(bar); } while (0)
    unsigned char* ws = args.ws;
    if (IN(0)) { phase_prologue(F); SEAM(0); }
    if (IN(1)) {
        pg8::Gemm g{(const bf16*)(ws + WS_XB), (const bf16*)(ws + WS_WIN), DM, DM, 0}; pg8::StaticOrder S; S.init(M, DIN, F.G, F.bid);
        pg8::EpiProj E{(bf16*)(ws + WS_Q), (bf16*)(ws + WS_K), (bf16*)(ws + WS_V), (bf16*)(ws + WS_U), (bf16*)(ws + WS_VB), (bf16*)(ws + WS_GA), (bf16*)(ws + WS_GB), (pg8::f32x2*)(ws + WS_VSTAT), QSCALE};
        pg8::gemm_phase<pg8::EpiProj, pg8::StaticOrder, true>(F.lds + RING_OFF, g, S, E);
        SEAM(1);
    }
    if (IN(2)) { phase_mixers(F); SEAM(2); }
    if (IN(3)) { phase_combine(F); SEAM(3); }
    if (IN(4)) {
        pg8::Gemm g{(const bf16*)(ws + WS_AG), (const bf16*)(ws + WS_WPAB), 1024, 2048, 2048}; pg8::PairOrder S; S.so.init(M, DM, F.G, F.bid);
        pg8::EpiGate E{(const bf16*)(ws + WS_GA), (const bf16*)(ws + WS_GB), (bf16*)(ws + WS_MRG)};
        pg8::gemm_phase<pg8::EpiGate, pg8::PairOrder, true>(F.lds + RING_OFF, g, S, E);
        SEAM(4);
    }
    if (IN(5)) {
        pg8::Gemm g{(const bf16*)(ws + WS_MRG), (const bf16*)(ws + WS_WOUT), DM, DM, 0}; pg8::StaticOrder S; S.init(M, DM, F.G, F.bid);
        pg8::EpiResF32 E{args.in[0], args.out, nullptr, ALPHA};
        pg8::gemm_phase<pg8::EpiResF32, pg8::StaticOrder, true>(F.lds + RING_OFF, g, S, E);
        SEAM(5);
    }
    if (IN(6)) { phase_ln(F, args.out, args.in[10], args.in[11], (bf16*)(ws + WS_HB)); phase_convert_ffn(F); SEAM(6); }
    if (IN(7)) {
        pg8::Gemm g{(const bf16*)(ws + WS_HB), (const bf16*)(ws + WS_W1), DM, DM, 0}; pg8::StaticOrder S; S.init(M, DFF, F.G, F.bid);
        pg8::EpiRelu2 E{(bf16*)(ws + WS_ACT), DFF, args.in[13]};
        pg8::gemm_phase<pg8::EpiRelu2, pg8::StaticOrder, true>(F.lds + RING_OFF, g, S, E);
        SEAM(7);
    }
    if (IN(8)) {
        pg8::Gemm g{(const bf16*)(ws + WS_ACT), (const bf16*)(ws + WS_W2), DFF, DFF, 0}; pg8::StaticOrder S; S.init(M, DM, F.G, F.bid);
        pg8::EpiResF32 E{args.out, args.out, args.in[15], ALPHA};
        pg8::gemm_phase<pg8::EpiResF32, pg8::StaticOrder, true>(F.lds + RING_OFF, g, S, E);
        SEAM(8);
    }
    if (IN(9)) { phase_ln(F, args.out, args.in[16], args.in[17], nullptr); }
#undef IN
#undef SEAM
}

#if MK_DEBUG_CHECKS
__device__ __forceinline__ unsigned hsh(unsigned x) { x ^= x >> 16; x *= 0x7feb352dU; x ^= x >> 15; x *= 0x846ca68bU; x ^= x >> 16; return x; }
__device__ float dot_bf(const bf16* a, const bf16* b, int K) { float s = 0.f; for (int k = 0; k < K; ++k) s += bf2f(a[k]) * bf2f(b[k]); return s; }
__device__ __forceinline__ bool bad(float got, float ex, float rt, float at) { return !(fabsf(got - ex) <= at + rt * fabsf(ex)); }
__device__ float gelu_ref(float v) { return 0.5f * v * (1.0f + tanhf(0.7978845608028654f * (v + 0.044715f * v * v * v))); }
__global__ void mk_check(Args args, int stage) {
    const unsigned gid = blockIdx.x * blockDim.x + threadIdx.x; unsigned char* ws = args.ws; unsigned* flag = (unsigned*)(ws + WS_CTL) + CW_CHK + stage;
    const unsigned h1 = hsh(gid * 2654435761u + 17u * stage + 1u), h2 = hsh(h1 + 0x9e3779b9u), h3 = hsh(h2 + 0x85ebca6bu);
    bool fail = false;
    if (stage == 0) {
        const int sel = gid % 7;
        if (sel == 0) { const int n = h1 % DIN, k = h2 % DM; fail = ((const bf16*)(ws + WS_WIN))[(size_t)n * DM + k] != (bf16)f2bf(args.in[1][(size_t)k * DIN + n]); }
        else if (sel == 1) { const int n = h1 % DM, k = h2 % DA; fail = ((const bf16*)(ws + WS_WPAB))[(size_t)n * 2048 + k] != (bf16)f2bf(args.in[7][(size_t)k * DM + n]); }
        else if (sel == 2) { const int n = h1 % DM, k = h2 % DB; fail = ((const bf16*)(ws + WS_WPAB))[(size_t)n * 2048 + 1024 + k] != (bf16)f2bf(args.in[8][(size_t)k * DM + n]); }
        else if (sel == 3) { const int n = h1 % DM, k = h2 % DM; fail = ((const bf16*)(ws + WS_WOUT))[(size_t)n * DM + k] != (bf16)f2bf(args.in[9][(size_t)k * DM + n]); }
        else if (sel == 4) { const int m = h1 % M, k = h2 % DM; fail = ((const bf16*)(ws + WS_XB))[(size_t)m * DM + k] != (bf16)f2bf(args.in[0][(size_t)m * DM + k]); }
        else if (sel == 5) { const int e = h1 % (8 * 128 * 128), i = (e >> 7) & 127, j = e & 127; fail = ((const bf16*)(ws + WS_WSP))[e] != (bf16)(j <= i ? f2bf(args.in[5][e]) : 0u); }
        else { const int p = h1 % 3, h = h2 % 8, j = h3 % 129; const float ex = args.in[2][t5_bucket(j * pat_dil(p)) * NH + h] * LOG2E; fail = bad(((const float*)(ws + WS_BTAB))[(p * NH + h) * BT_PITCH + j], ex, 1e-5f, 1e-6f); }
    } else if (stage == 1) {
        const int row = h1 % M, col = h2 % DIN;
        if (gid < 7680) {
            const float dv = dot_bf((const bf16*)(ws + WS_XB) + (size_t)row * DM, (const bf16*)(ws + WS_WIN) + (size_t)col * DM, DM);
            float ex, got;
            if (col < 1024) { ex = dv * QSCALE; got = bf2f(((const bf16*)(ws + WS_Q))[(size_t)row * 1024 + col]); }
            else if (col < 2048) { ex = dv; got = bf2f(((const bf16*)(ws + WS_K))[(size_t)row * 1024 + col - 1024]); }
            else if (col < 3072) { ex = dv; got = bf2f(((const bf16*)(ws + WS_V))[(size_t)row * 1024 + col - 2048]); }
            else if (col < 4096) { ex = gelu_ref(dv); got = bf2f(((const bf16*)(ws + WS_U))[(size_t)row * 1024 + col - 3072]); }
            else if (col < 5120) { ex = gelu_ref(dv); got = bf2f(((const bf16*)(ws + WS_VB))[(size_t)row * 1024 + col - 4096]); }
            else if (col < 7168) { ex = dv; got = bf2f(((const bf16*)(ws + WS_GA))[(size_t)row * 2048 + col - 5120]); }
            else { ex = dv; got = bf2f(((const bf16*)(ws + WS_GB))[(size_t)row * 2048 + col - 7168]); }
            fail = bad(got, ex, 1.5e-2f, 1e-2f);
        } else {
            float s1 = 0.f, s2 = 0.f; for (int c = 0; c < 1024; ++c) { const float v = bf2f(((const bf16*)(ws + WS_VB))[(size_t)row * 1024 + c]); s1 += v; s2 += v * v; }
            float t1 = 0.f, t2 = 0.f; for (int k = 0; k < 16; ++k) { const f32x2 t = ((const f32x2*)(ws + WS_VSTAT))[(size_t)row * 16 + k]; t1 += t.x; t2 += t.y; }
            fail = bad(t1, s1, 1e-2f, 1.0f) || bad(t2, s2, 1e-2f, 1.0f);
        }
    } else if (stage == 2) {
        if (gid < 6144) {
            const int b = h1 % BATCH, s = h2 % SEQ, h = h3 % NH, p = (h3 >> 8) % 3, d = pat_dil(p);
            const bf16* Qg = (const bf16*)(ws + WS_Q); const bf16* Kg = (const bf16*)(ws + WS_K); const bf16* Vg = (const bf16*)(ws + WS_V);
            const bf16* Og = (const bf16*)(ws + (p == 0 ? WS_O0 : (p == 1 ? WS_O1 : WS_O2))); const float* BT = (const float*)(ws + WS_BTAB) + (p * NH + h) * BT_PITCH;
            const size_t qrow = (size_t)b * SEQ + s; float mx = -1e30f;
            for (int j = 0; j <= 128; ++j) { const int sk = s - j * d; if (sk < 0) break; const float sc = dot_bf(Qg + qrow * DA + h * HD, Kg + ((size_t)b * SEQ + sk) * DA + h * HD, HD) + BT[j]; mx = fmaxf(mx, sc); }
            float den = 0.f; for (int j = 0; j <= 128; ++j) { const int sk = s - j * d; if (sk < 0) break; const float sc = dot_bf(Qg + qrow * DA + h * HD, Kg + ((size_t)b * SEQ + sk) * DA + h * HD, HD) + BT[j]; den += exp2f(sc - mx); }
            const float l2 = mx + log2f(den);
            fail = bad(((const float*)(ws + WS_LSE))[((size_t)p * M + qrow) * NH + h], l2, 2e-3f, 2e-2f);
            for (int dd = 0; dd < HD; dd += 7) { float o = 0.f;
                for (int j = 0; j <= 128; ++j) { const int sk = s - j * d; if (sk < 0) break; const float sc = dot_bf(Qg + qrow * DA + h * HD, Kg + ((size_t)b * SEQ + sk) * DA + h * HD, HD) + BT[j]; o += exp2f(sc - mx) * bf2f(Vg[((size_t)b * SEQ + sk) * DA + h * HD + dd]); }
                o /= den; fail = fail || bad(bf2f(Og[qrow * DA + h * HD + dd]), o, 3e-2f, 1e-2f); }
        } else {
            const int row = h1 % M, ch = h2 % DB, gg = ch >> 7, i = row & 127; const size_t R0 = (size_t)(row - i);
            const bf16* WSP = (const bf16*)(ws + WS_WSP) + (size_t)gg * 128 * 128;
            float z = args.in[6][gg * 128 + i];
            for (int j = 0; j <= i; ++j) { float s1 = 0.f, s2 = 0.f; for (int k = 0; k < 16; ++k) { const f32x2 t = ((const f32x2*)(ws + WS_VSTAT))[(R0 + j) * 16 + k]; s1 += t.x; s2 += t.y; }
                const float mean = s1 / DB, var = fmaxf(s2 / DB - mean * mean, 0.f), rstd = 1.0f / sqrtf(var + LN_EPS);
                const float vn = (bf2f(((const bf16*)(ws + WS_VB))[(R0 + j) * DB + ch]) - mean) * rstd * args.in[3][ch] + args.in[4][ch];
                z += bf2f(WSP[i * 128 + j]) * bf2f((bf16)f2bf(vn)); }
            const float ex = z * bf2f(((const bf16*)(ws + WS_U))[(size_t)row * DB + ch]);
            fail = bad(bf2f(((const bf16*)(ws + WS_AG))[(size_t)row * 2048 + 1024 + ch]), ex, 2e-2f, 1e-2f);
        }
    } else if (stage == 3) {
        const int row = h1 % M, col = h2 % DA, h = col >> 7; const float* LSE = (const float*)(ws + WS_LSE);
        const float l0 = LSE[((size_t)0 * M + row) * NH + h], l1 = LSE[((size_t)1 * M + row) * NH + h], l2 = LSE[((size_t)2 * M + row) * NH + h], mx = fmaxf(l0, fmaxf(l1, l2));
        const float w0 = exp2f(l0 - mx), w1 = exp2f(l1 - mx), w2 = exp2f(l2 - mx);
        const float ex = (w0 * bf2f(((const bf16*)(ws + WS_O0))[(size_t)row * DA + col]) + w1 * bf2f(((const bf16*)(ws + WS_O1))[(size_t)row * DA + col]) + w2 * bf2f(((const bf16*)(ws + WS_O2))[(size_t)row * DA + col])) / (w0 + w1 + w2);
        fail = bad(bf2f(((const bf16*)(ws + WS_AG))[(size_t)row * 2048 + col]), ex, 1e-2f, 5e-3f);
    } else if (stage == 4) {
        const int row = h1 % M, col = h2 % DM; const bf16* AG = (const bf16*)(ws + WS_AG) + (size_t)row * 2048; const bf16* Wt = (const bf16*)(ws + WS_WPAB) + (size_t)col * 2048;
        const float ya = dot_bf(AG, Wt, 1024), yb = dot_bf(AG + 1024, Wt + 1024, 1024);
        const float ga = bf2f(((const bf16*)(ws + WS_GA))[(size_t)row * 2048 + col]), gb = bf2f(((const bf16*)(ws + WS_GB))[(size_t)row * 2048 + col]);
        const float ex = ya / (1.f + expf(-ga)) + yb / (1.f + expf(-gb));
        fail = bad(bf2f(((const bf16*)(ws + WS_MRG))[(size_t)row * 2048 + col]), ex, 2e-2f, 5e-3f);
    } else if (stage == 5) {
        const int row = h1 % M, col = h2 % DM;
        const float ex = ALPHA * args.in[0][(size_t)row * DM + col] + dot_bf((const bf16*)(ws + WS_MRG) + (size_t)row * 2048, (const bf16*)(ws + WS_WOUT) + (size_t)col * 2048, DM);
        fail = bad(args.out[(size_t)row * DM + col], ex, 2e-3f, 2e-3f);
    } else if (stage == 6 || stage == 9) {
        const float* gain = args.in[stage == 6 ? 10 : 16]; const float* bias = args.in[stage == 6 ? 11 : 17];
        if (gid < 2048) { const int row = h1 % M; float s1 = 0.f, s2 = 0.f;
            for (int c = 0; c < DM; ++c) { const float v = (args.out[(size_t)row * DM + c] - bias[c]) / gain[c]; s1 += v; s2 += v * v; }
            const float mean = s1 / DM, var = s2 / DM - mean * mean; fail = (fabsf(mean) > 2e-3f) || (fabsf(var - 1.f) > 1e-2f);
        } else if (stage == 6) {
            const int sel = gid % 3;
            if (sel == 0) { const int row = h1 % M, c = h2 % DM; fail = bad(bf2f(((const bf16*)(ws + WS_HB))[(size_t)row * DM + c]), args.out[(size_t)row * DM + c], 5e-3f, 1e-4f); }
            else if (sel == 1) { const int n = h1 % DFF, k = h2 % DM; fail = ((const bf16*)(ws + WS_W1))[(size_t)n * DM + k] != (bf16)f2bf(args.in[12][(size_t)k * DFF + n]); }
            else { const int n = h1 % DM, k = h2 % DFF; fail = ((const bf16*)(ws + WS_W2))[(size_t)n * DFF + k] != (bf16)f2bf(args.in[14][(size_t)k * DM + n]); }
        }
    } else if (stage == 7) {
        const int row = h1 % M, col = h2 % DFF;
        const float v = dot_bf((const bf16*)(ws + WS_HB) + (size_t)row * DM, (const bf16*)(ws + WS_W1) + (size_t)col * DM, DM) + args.in[13][col]; const float r = fmaxf(v, 0.f);
        fail = bad(bf2f(((const bf16*)(ws + WS_ACT))[(size_t)row * DFF + col]), r * r, 2e-2f, 5e-3f);
    } else if (stage == 8) {
        const int row = h1 % M, col = h2 % DM;
        const float ex = ALPHA * bf2f(((const bf16*)(ws + WS_HB))[(size_t)row * DM + col]) + dot_bf((const bf16*)(ws + WS_ACT) + (size_t)row * DFF, (const bf16*)(ws + WS_W2) + (size_t)col * DFF, DFF) + args.in[15][col];
        fail = bad(args.out[(size_t)row * DM + col], ex, 5e-3f, 3e-2f);
    }
    if (fail) atomicAdd(flag, 1u);
}
__global__ void mk_report(Args args) {
    const unsigned* flag = (const unsigned*)(args.ws + WS_CTL) + CW_CHK;
    if (threadIdx.x == 0 && blockIdx.x == 0) { for (int s = 0; s < N_PHASES; ++s) if (flag[s] != 0u) { args.out[0] = 1000.0f * (float)(s + 1); break; } }
}
#endif

extern "C" void kernel_launch(void* const* d_in, const int* in_sizes, int n_in, void* d_out, int out_size, void* d_ws, size_t ws_size, hipStream_t stream) {
    static int grid = 0;
    if (grid == 0) {
        if (n_in != 18 || in_sizes[0] != M * DM || out_size != M * DM || ws_size < WS_END) { fprintf(stderr, "kernel_launch: unexpected shapes (n_in %d, in0 %d, out %d, ws %zu); nothing launched\n", n_in, n_in > 0 ? in_sizes[0] : -1, out_size, ws_size); grid = -1; return; }
        int dev = 0, cus = 0, per_cu = 0;
        if (hipGetDevice(&dev) != hipSuccess || hipDeviceGetAttribute(&cus, hipDeviceAttributeMultiprocessorCount, dev) != hipSuccess) { grid = -1; return; }
        if (hipFuncSetAttribute((const void*)mk_fwd, hipFuncAttributeMaxDynamicSharedMemorySize, LDS_BYTES) != hipSuccess) { fprintf(stderr, "kernel_launch: hipFuncSetAttribute failed\n"); grid = -1; return; }
        if (hipOccupancyMaxActiveBlocksPerMultiprocessor(&per_cu, (const void*)mk_fwd, NWAVES * 64, LDS_BYTES) != hipSuccess || per_cu < 1) { fprintf(stderr, "kernel_launch: occupancy query reports %d blocks per CU\n", per_cu); (void)hipGetLastError(); grid = -1; return; }
        grid = cus;
    }
    if (grid < 0) return;
    (void)hipMemsetAsync((char*)d_ws + WS_CTL, 0, CTL_ZERO_BYTES, stream);
    Args a{};
    for (int i = 0; i < 18; ++i) a.in[i] = (const float*)d_in[i];
    a.out = (float*)d_out; a.ws = (unsigned char*)d_ws;
#if MK_ONE_LAUNCH
    a.ph_lo = 0; a.ph_hi = N_PHASES;
    hipLaunchKernelGGL(mk_fwd, dim3(grid), dim3(NWAVES * 64), LDS_BYTES, stream, a);
#else
    for (int ph = 0; ph < N_PHASES; ++ph) {
        a.ph_lo = ph; a.ph_hi = ph + 1;
        hipLaunchKernelGGL(mk_fwd, dim3(grid), dim3(NWAVES * 64), LDS_BYTES, stream, a);
#if MK_DEBUG_CHECKS
        hipLaunchKernelGGL(mk_check, dim3(32), dim3(256), 0, stream, a, ph);
#endif
    }
#if MK_DEBUG_CHECKS
    hipLaunchKernelGGL(mk_report, dim3(1), dim3(64), 0, stream, a);
#endif
#endif
}
```

```cpp
#include <hip/hip_runtime.h>
#include <cstdio>
#include <cstdint>

#ifndef MK_DEBUG_CHECKS
#define MK_DEBUG_CHECKS 0
#endif
#ifndef MK_REPEAT_PHASE
#define MK_REPEAT_PHASE 3
#endif
#ifndef MK_TPROBE
#define MK_TPROBE 0
#endif
#ifndef MK_TPA
#define MK_TPA 0
#endif
#ifndef MK_TPB
#define MK_TPB 4
#endif
#ifndef MK_ONE_LAUNCH
#define MK_ONE_LAUNCH 1
#endif

namespace pg8 {
#define PG8_LAS __attribute__((address_space(3)))
typedef unsigned short bf16_t;
typedef short bf16x8 __attribute__((ext_vector_type(8)));
typedef float f32x4 __attribute__((ext_vector_type(4)));
typedef float f32x2 __attribute__((ext_vector_type(2)));
typedef unsigned u32x4 __attribute__((ext_vector_type(4)));
typedef unsigned u32x2 __attribute__((ext_vector_type(2)));
constexpr int BM = 256, BK = 64, HALF = 128, HTB = HALF * BK * 2, STAGE_BYTES = 8 * HTB, NXCD = 8, WGM = 8;

__host__ __device__ __forceinline__ int lds_byte(int r, int c) { const int st = (r >> 4) * 2 + (c >> 5), rr = r & 15, cc = c & 31, ob = rr * 64 + cc * 2; return st * 1024 + (ob ^ (((ob >> 9) & 1) << 5)); }
__host__ __device__ __forceinline__ void stage_rc(int b, int& R, int& C) { const int st = b / 1024, sb = b % 1024, swz = sb ^ (((sb >> 9) & 1) << 5); R = (st >> 1) * 16 + swz / 64; C = (st & 1) * 32 + (swz % 64) / 2; }
__host__ __device__ __forceinline__ int perm32(int rho) { const int n = rho >> 4, i = rho & 15; return 8 * (i >> 2) + 4 * n + (i & 3); }

struct Unit { int pm, pn, kh; };
struct Gemm { const bf16_t* A; const bf16_t* Bt; int K; int ld; int khstep; };

struct StaticOrder {
    int nM, nN, nwg, G, c;
    __host__ __device__ void init(int M, int N, int G_, int c_) { nM = M / BM; nN = N / BM; nwg = nM * nN; G = G_; c = c_; }
    __host__ __device__ bool next(int i, Unit& u) const {
        const long L = (long)i * G + c; if (L >= nwg) return false;
        int wgid = (int)L; { const int q = nwg / NXCD, r = nwg % NXCD, xcd = wgid % NXCD, off = wgid / NXCD; wgid = (xcd < r ? xcd * (q + 1) : r * (q + 1) + (xcd - r) * q) + off; }
        const int nig = WGM * nN, gid = wgid / nig, fm = gid * WGM, gsz = (nM - fm) < WGM ? (nM - fm) : WGM;
        u.pm = fm + ((wgid % nig) % gsz); u.pn = (wgid % nig) / gsz; u.kh = 0; return true;
    }
};
struct PairOrder {
    StaticOrder so;
    __host__ __device__ bool next(int i, Unit& u) const { if (!so.next(i >> 1, u)) return false; u.kh = i & 1; return true; }
};

__device__ __forceinline__ unsigned cvt_pk_bf16(float lo, float hi) { unsigned r; asm volatile("v_cvt_pk_bf16_f32 %0, %1, %2" : "=v"(r) : "v"(lo), "v"(hi)); return r; }
__device__ __forceinline__ float bf_lo(unsigned w) { return __uint_as_float(w << 16); }
__device__ __forceinline__ float bf_hi(unsigned w) { return __uint_as_float(w & 0xffff0000u); }
__device__ __forceinline__ float fast_exp2(float x) { return __builtin_amdgcn_exp2f(x); }
__device__ __forceinline__ float fast_rcp(float x) { return __builtin_amdgcn_rcpf(x); }
__device__ __forceinline__ float gelu_tanh(float v) {
    const float t = v * (1.0f + 0.044715f * v * v);
    const float e = fast_exp2(t * (-2.0f * 0.7978845608028654f * 1.4426950408889634f));
    return v * fast_rcp(1.0f + e);
}


struct EpiProj {
    static constexpr bool PERM = true, AFTER_DRAIN = false, KEEPS = false;
    bf16_t *Q, *Kb, *V, *U, *VB, *GA, *GB; f32x2* vstat; float qscale;
    __device__ __forceinline__ bool operator()(f32x4 (&acc)[2][2][4][2], const Unit& u, int wr, int wc, int fr, int fq) const {
        const int pn = 35 - u.pn; bf16_t* base; int ldc = 1024, colt, act = 0; float sc = 1.0f;
        if (pn < 4) { base = Q; colt = pn * BM; sc = qscale; }
        else if (pn < 8) { base = Kb; colt = (pn - 4) * BM; }
        else if (pn < 12) { base = V; colt = (pn - 8) * BM; }
        else if (pn < 16) { base = U; colt = (pn - 12) * BM; act = 1; }
        else if (pn < 20) { base = VB; colt = (pn - 16) * BM; act = 2; }
        else if (pn < 28) { base = GA; colt = (pn - 20) * BM; ldc = 2048; }
        else { base = GB; colt = (pn - 28) * BM; ldc = 2048; }
        const int row0 = u.pm * BM + wr * 64 + fr, col0 = colt + wc * 32 + 8 * fq;
#pragma unroll
        for (int ai = 0; ai < 2; ++ai)
#pragma unroll
            for (int m = 0; m < 4; ++m) {
                const int row = row0 + ai * HALF + m * 16; bf16_t* rowp = base + (size_t)row * ldc + col0; float s1 = 0.f, s2 = 0.f;
#pragma unroll
                for (int bj = 0; bj < 2; ++bj) { f32x4 v0 = acc[ai][bj][m][0], v1 = acc[ai][bj][m][1];
                    if (act != 0) {
#pragma unroll
                        for (int e = 0; e < 4; ++e) { v0[e] = gelu_tanh(v0[e]); v1[e] = gelu_tanh(v1[e]); }
                        s1 += (v0[0] + v0[1]) + (v0[2] + v0[3]) + (v1[0] + v1[1]) + (v1[2] + v1[3]);
                        s2 += (v0[0] * v0[0] + v0[1] * v0[1]) + (v0[2] * v0[2] + v0[3] * v0[3]) + (v1[0] * v1[0] + v1[1] * v1[1]) + (v1[2] * v1[2] + v1[3] * v1[3]);
                    }
                    v0 = v0 * sc; v1 = v1 * sc; u32x4 w; w.x = cvt_pk_bf16(v0[0], v0[1]); w.y = cvt_pk_bf16(v0[2], v0[3]); w.z = cvt_pk_bf16(v1[0], v1[1]); w.w = cvt_pk_bf16(v1[2], v1[3]);
                    *(u32x4*)(rowp + bj * HALF) = w; }
                if (act == 2) {
                    s1 += __shfl_xor(s1, 16); s1 += __shfl_xor(s1, 32); s2 += __shfl_xor(s2, 16); s2 += __shfl_xor(s2, 32);
                    if (fq == 0) vstat[(size_t)row * 16 + (pn - 16) * 4 + wc] = (f32x2){s1, s2};
                }
            }
        return false;
    }
};
struct EpiGate {
    static constexpr bool PERM = true, AFTER_DRAIN = false, KEEPS = true;
    const bf16_t *GA, *GB; bf16_t* O;
    __device__ __forceinline__ bool operator()(f32x4 (&acc)[2][2][4][2], const Unit& u, int wr, int wc, int fr, int fq) const {
        const int row0 = u.pm * BM + wr * 64 + fr, col0 = u.pn * BM + wc * 32 + 8 * fq; const float NL2E = -1.4426950408889634f;
#pragma unroll
        for (int ai = 0; ai < 2; ++ai)
#pragma unroll
            for (int m = 0; m < 4; ++m) { const size_t off = (size_t)(row0 + ai * HALF + m * 16) * 2048 + col0;
#pragma unroll
                for (int bj = 0; bj < 2; ++bj) {
                    const u32x4 gb = *(const u32x4*)(GB + off + bj * HALF);
                    float eb[8]; eb[0] = bf_lo(gb.x); eb[1] = bf_hi(gb.x); eb[2] = bf_lo(gb.y); eb[3] = bf_hi(gb.y); eb[4] = bf_lo(gb.z); eb[5] = bf_hi(gb.z); eb[6] = bf_lo(gb.w); eb[7] = bf_hi(gb.w);
#pragma unroll
                    for (int e = 0; e < 8; ++e) eb[e] = 1.0f + fast_exp2(fmaxf(eb[e], -40.f) * NL2E);
                    if (u.kh == 0) {
                        const u32x4 ga = *(const u32x4*)(GA + off + bj * HALF);
                        float ea[8]; ea[0] = bf_lo(ga.x); ea[1] = bf_hi(ga.x); ea[2] = bf_lo(ga.y); ea[3] = bf_hi(ga.y); ea[4] = bf_lo(ga.z); ea[5] = bf_hi(ga.z); ea[6] = bf_lo(ga.w); ea[7] = bf_hi(ga.w);
#pragma unroll
                        for (int e = 0; e < 8; ++e) { const float r = eb[e] * fast_rcp(1.0f + fast_exp2(ea[e] * NL2E)); if (e < 4) acc[ai][bj][m][0][e] *= r; else acc[ai][bj][m][1][e - 4] *= r; }
                    } else {
                        float o[8];
#pragma unroll
                        for (int e = 0; e < 8; ++e) o[e] = (e < 4 ? acc[ai][bj][m][0][e] : acc[ai][bj][m][1][e - 4]) * fast_rcp(eb[e]);
                        u32x4 w; w.x = cvt_pk_bf16(o[0], o[1]); w.y = cvt_pk_bf16(o[2], o[3]); w.z = cvt_pk_bf16(o[4], o[5]); w.w = cvt_pk_bf16(o[6], o[7]);
                        *(u32x4*)(O + off + bj * HALF) = w;
                    }
                } }
        return u.kh == 0;
    }
};
template <int ACT> struct EpiBiasAct {
    static constexpr bool PERM = true, AFTER_DRAIN = false, KEEPS = false;
    bf16_t* O; int ldc; const float* bias;
    __device__ __forceinline__ bool operator()(f32x4 (&acc)[2][2][4][2], const Unit& u, int wr, int wc, int fr, int fq) const {
        const int row0 = u.pm * BM + wr * 64 + fr, col0 = u.pn * BM + wc * 32 + 8 * fq;
        f32x4 bv[2][2];
#pragma unroll
        for (int bj = 0; bj < 2; ++bj)
#pragma unroll
            for (int n = 0; n < 2; ++n) bv[bj][n] = bias ? *(const f32x4*)(bias + col0 + bj * HALF + 4 * n) : (f32x4){0.f, 0.f, 0.f, 0.f};
#pragma unroll
        for (int ai = 0; ai < 2; ++ai)
#pragma unroll
            for (int m = 0; m < 4; ++m) { bf16_t* rowp = O + (size_t)(row0 + ai * HALF + m * 16) * ldc + col0;
#pragma unroll
                for (int bj = 0; bj < 2; ++bj) { f32x4 v0 = acc[ai][bj][m][0] + bv[bj][0], v1 = acc[ai][bj][m][1] + bv[bj][1];
                    if (ACT == 1) {
#pragma unroll
                        for (int e = 0; e < 4; ++e) { const float a = fmaxf(v0[e], 0.f), b = fmaxf(v1[e], 0.f); v0[e] = a * a; v1[e] = b * b; } }
                    u32x4 w; w.x = cvt_pk_bf16(v0[0], v0[1]); w.y = cvt_pk_bf16(v0[2], v0[3]); w.z = cvt_pk_bf16(v1[0], v1[1]); w.w = cvt_pk_bf16(v1[2], v1[3]);
                    *(u32x4*)(rowp + bj * HALF) = w; } }
        return false;
    }
};
struct EpiResF32 {
    static constexpr bool PERM = false, AFTER_DRAIN = false, KEEPS = false;
    const float* base; float* out; const float* bias; float alpha;
    __device__ __forceinline__ bool operator()(f32x4 (&acc)[2][2][4][2], const Unit& u, int wr, int wc, int fr, int fq) const {
        const int row0 = u.pm * BM + wr * 64 + fr, col0 = u.pn * BM + wc * 32 + 4 * fq;
        f32x4 bv[2][2];
#pragma unroll
        for (int bj = 0; bj < 2; ++bj)
#pragma unroll
            for (int n = 0; n < 2; ++n) bv[bj][n] = bias ? *(const f32x4*)(bias + col0 + bj * HALF + n * 16) : (f32x4){0.f, 0.f, 0.f, 0.f};
#pragma unroll
        for (int ai = 0; ai < 2; ++ai)
#pragma unroll
            for (int m = 0; m < 4; ++m) { const size_t off = (size_t)(row0 + ai * HALF + m * 16) * 2048 + col0;
#pragma unroll
                for (int bj = 0; bj < 2; ++bj)
#pragma unroll
                    for (int n = 0; n < 2; ++n) { const f32x4 bs = *(const f32x4*)(base + off + bj * HALF + n * 16);
                        *(f32x4*)(out + off + bj * HALF + n * 16) = bs * alpha + (acc[ai][bj][m][n] + bv[bj][n]); }
                if (m & 1) asm volatile("" ::: "memory"); }
        return false;
    }
};

template <class Epi, class Sched, bool ALIGN_EPI = false>
__device__ __forceinline__ void gemm_phase(PG8_LAS unsigned char* lds, const Gemm g, const Sched& S, const Epi& E) {
    const int tid = threadIdx.x, wid = __builtin_amdgcn_readfirstlane(tid >> 6), lane = tid & 63, wr = wid >> 2, wc = wid & 3, fr = lane & 15, fq = lane >> 4;
    const int K = g.K, nt = K / BK, ld = g.ld;
    unsigned voffA[2], voffB[2];
#pragma unroll
    for (int i = 0; i < 2; ++i) { int R, C; stage_rc(tid * 16 + i * 8192, R, C); const int Rb = Epi::PERM ? ((R & ~31) + perm32(R & 31)) : R;
        voffA[i] = (unsigned)(R * ld + C) * 2u; voffB[i] = (unsigned)(Rb * ld + C) * 2u; }
    const size_t kstep = (size_t)(BK * 2);
    const size_t hstep = (size_t)HALF * ld * 2;
    const size_t tstep = 2 * hstep;
    const unsigned ldsw = (unsigned)wid * 1024u;
    const int aoff = lds_byte(wr * 64 + fr, fq * 8), boff = lds_byte(wc * 32 + fr, fq * 8);
#define PG8_SA(b, h) (((b) * 2 + (h)) * HTB)
#define PG8_SB(b, h) ((4 + (b) * 2 + (h)) * HTB)
#define PG8_STAGE(bufoff, gbase, voff) do { _Pragma("unroll") for (int _i = 0; _i < 2; ++_i) \
        __builtin_amdgcn_global_load_lds((const unsigned*)((const char*)(gbase) + (voff)[_i]), (PG8_LAS unsigned*)(lds + (bufoff) + ldsw + _i * 8192), 16, 0, 0); } while (0)
#define PG8_LDA(dst, b, h) do { _Pragma("unroll") for (int m = 0; m < 4; ++m) _Pragma("unroll") for (int k = 0; k < 2; ++k) dst[m][k] = *(const PG8_LAS bf16x8*)(lds + PG8_SA(b, h) + aoff + m * 2048 + k * 1024); } while (0)
#define PG8_LDB(dst, b, h) do { _Pragma("unroll") for (int n = 0; n < 2; ++n) _Pragma("unroll") for (int k = 0; k < 2; ++k) dst[n][k] = *(const PG8_LAS bf16x8*)(lds + PG8_SB(b, h) + boff + n * 2048 + k * 1024); } while (0)
#define PG8_MMA(ai, bj, At, Bt) do { __builtin_amdgcn_s_setprio(1); _Pragma("unroll") for (int m = 0; m < 4; ++m) _Pragma("unroll") for (int n = 0; n < 2; ++n) _Pragma("unroll") for (int k = 0; k < 2; ++k) \
        acc[ai][bj][m][n] = __builtin_amdgcn_mfma_f32_16x16x32_bf16(Bt[n][k], At[m][k], acc[ai][bj][m][n], 0, 0, 0); __builtin_amdgcn_s_setprio(0); } while (0)
#define PG8_WAIT_V(n) asm volatile("s_waitcnt vmcnt(" #n ")" ::: "memory")
#define PG8_WAIT_L(n) asm volatile("s_waitcnt lgkmcnt(" #n ")" ::: "memory")
#define PG8_BAR __builtin_amdgcn_s_barrier()
#define PG8_SCHED __builtin_amdgcn_sched_barrier(0)
    Unit cur, nxt; int ui = 0;
    if (!S.next(0, cur)) return;
    f32x4 acc[2][2][4][2];
#pragma unroll
    for (int a = 0; a < 2; ++a)
#pragma unroll
        for (int b = 0; b < 2; ++b)
#pragma unroll
            for (int m = 0; m < 4; ++m)
#pragma unroll
                for (int n = 0; n < 2; ++n) acc[a][b][m][n] = (f32x4){0.f, 0.f, 0.f, 0.f};
    bf16x8 At[4][2], B0[2][2], B1[2][2];
    const char* cA = (const char*)g.A + (size_t)cur.pm * tstep + (size_t)cur.kh * g.khstep; const char* cB = (const char*)g.Bt + (size_t)cur.pn * tstep + (size_t)cur.kh * g.khstep;
    PG8_STAGE(PG8_SB(0, 0), cB, voffB); PG8_STAGE(PG8_SB(0, 1), cB + hstep, voffB); PG8_STAGE(PG8_SA(0, 0), cA, voffA); PG8_STAGE(PG8_SA(0, 1), cA + hstep, voffA);
    if (wr == 1) PG8_BAR;
    PG8_WAIT_V(2); PG8_BAR;
    PG8_STAGE(PG8_SB(1, 0), cB + kstep, voffB); PG8_STAGE(PG8_SA(1, 0), cA + kstep, voffA); PG8_STAGE(PG8_SB(1, 1), cB + hstep + kstep, voffB);
    PG8_WAIT_V(6); PG8_BAR;
    for (;;) {
        const bool has_next = S.next(ui + 1, nxt);
        const char* nA = has_next ? (const char*)g.A + (size_t)nxt.pm * tstep + (size_t)nxt.kh * g.khstep : cA; const char* nB = has_next ? (const char*)g.Bt + (size_t)nxt.pn * tstep + (size_t)nxt.kh * g.khstep : cB;
        for (int t = 0; t < nt; t += 2) {
            const bool last = (t == nt - 2);
            const char* a1 = cA + (size_t)(t + 1) * kstep;
            const char* a2 = last ? nA : cA + (size_t)(t + 2) * kstep; const char* b2 = last ? nB : cB + (size_t)(t + 2) * kstep;
            const char* a3 = a2 + kstep; const char* b3 = b2 + kstep;
            PG8_LDB(B0, 0, 0); PG8_LDB(B1, 0, 1); PG8_SCHED; PG8_LDA(At, 0, 0); PG8_STAGE(PG8_SA(1, 1), a1 + hstep, voffA);
            PG8_WAIT_V(8); PG8_WAIT_L(0); PG8_BAR; PG8_MMA(0, 0, At, B0); PG8_MMA(0, 1, At, B1); PG8_BAR; PG8_SCHED;
            PG8_LDA(At, 0, 1); PG8_STAGE(PG8_SB(0, 0), b2, voffB); PG8_STAGE(PG8_SB(0, 1), b2 + hstep, voffB); PG8_STAGE(PG8_SA(0, 0), a2, voffA);
            PG8_WAIT_V(8); PG8_WAIT_L(0); PG8_BAR; PG8_MMA(1, 0, At, B0); PG8_MMA(1, 1, At, B1); PG8_BAR; PG8_SCHED;
            PG8_LDB(B0, 1, 0); PG8_LDB(B1, 1, 1); PG8_SCHED; PG8_LDA(At, 1, 0); PG8_STAGE(PG8_SA(0, 1), a2 + hstep, voffA);
            PG8_WAIT_V(8); PG8_WAIT_L(0); PG8_BAR; PG8_MMA(0, 0, At, B0); PG8_MMA(0, 1, At, B1); PG8_BAR; PG8_SCHED;
            PG8_LDA(At, 1, 1); PG8_STAGE(PG8_SB(1, 0), b3, voffB); PG8_STAGE(PG8_SB(1, 1), b3 + hstep, voffB); PG8_STAGE(PG8_SA(1, 0), a3, voffA);
            PG8_WAIT_V(8); PG8_WAIT_L(0); PG8_BAR; PG8_MMA(1, 0, At, B0); PG8_MMA(1, 1, At, B1); PG8_BAR; PG8_SCHED;
        }
        if constexpr (ALIGN_EPI) { if (wr == 0) PG8_BAR; }
        const bool keep = E(acc, cur, wr, wc, fr, fq);
        if (!has_next) break;
        if (!(Epi::KEEPS && keep)) {
#pragma unroll
            for (int a = 0; a < 2; ++a)
#pragma unroll
                for (int b = 0; b < 2; ++b)
#pragma unroll
                    for (int m = 0; m < 4; ++m)
#pragma unroll
                        for (int n = 0; n < 2; ++n) acc[a][b][m][n] = (f32x4){0.f, 0.f, 0.f, 0.f};
        }
        cur = nxt; cA = nA; cB = nB; ++ui;
        if constexpr (ALIGN_EPI) { if (wr == 1) PG8_BAR; }
    }
    PG8_WAIT_V(0);
    if constexpr (!ALIGN_EPI) { if (wr == 0) PG8_BAR; }
    PG8_BAR;
#undef PG8_SA
#undef PG8_SB
#undef PG8_STAGE
#undef PG8_LDA
#undef PG8_LDB
#undef PG8_MMA
#undef PG8_WAIT_V
#undef PG8_WAIT_L
#undef PG8_BAR
#undef PG8_SCHED
}
}

constexpr int NWAVES = 8;
constexpr int BATCH = 8, SEQ = 2048, DM = 2048, M = BATCH * SEQ;
constexpr int NH = 8, HD = 128, DA = 1024, DB = 1024, DFF = 8192, DIN = 9216;
constexpr int NPAT = 3;
constexpr float LN_EPS = 1e-5f;
constexpr float ALPHA = 1.189207115002721f;
constexpr float LOG2E = 1.4426950408889634f;
constexpr float QSCALE = 0.08838834764831845f * 1.4426950408889634f;

constexpr size_t MiB = 1u << 20;
constexpr size_t WS_CTL = 0, CTL_ZERO_BYTES = 256 * 1024;
constexpr size_t WS_VSTAT = 1 * MiB;
constexpr size_t WS_LSE = 3 * MiB;
constexpr size_t WS_WSP = 5 * MiB - 512 * 1024;
constexpr size_t WS_BTAB = 5 * MiB - 128 * 1024;
constexpr size_t WS_WIN = 5 * MiB;
constexpr size_t WS_O1 = 5 * MiB;
constexpr size_t WS_WPAB = 41 * MiB;
constexpr size_t WS_WOUT = 49 * MiB;
constexpr size_t WS_W1 = 57 * MiB;
constexpr size_t WS_W2 = 89 * MiB;
constexpr size_t WS_O0 = 57 * MiB, WS_O2 = 89 * MiB;
constexpr size_t WS_XB = 121 * MiB;
constexpr size_t WS_AG = WS_XB, WS_HB = WS_XB;
constexpr size_t WS_Q = 185 * MiB, WS_K = 217 * MiB, WS_V = 249 * MiB, WS_U = 281 * MiB, WS_VB = 313 * MiB;
constexpr size_t WS_GA = 345 * MiB, WS_GB = 409 * MiB;
constexpr size_t WS_MRG = WS_Q;
constexpr size_t WS_ACT = 185 * MiB;
constexpr size_t WS_MIX = WS_V;
constexpr size_t WS_FF = WS_XB;
constexpr size_t WS_END = 473 * MiB;
constexpr int BT_PITCH = 132;
constexpr int CW_BAR = 4096;
constexpr int CW_CHK = 1024;
constexpr int CW_TS = 2048;

constexpr int RING_OFF = 0, RING_BYTES = 131072;
constexpr int LDSCTL_OFF = RING_BYTES, MISC_OFF = LDSCTL_OFF + 320;
constexpr int LDS_BT_OFF = RING_BYTES + 1024;
constexpr int LDS_BYTES = 147456;

#define GAS __attribute__((address_space(1)))
#define LAS __attribute__((address_space(3)))
typedef unsigned short bf16;
typedef unsigned v4u __attribute__((ext_vector_type(4)));
typedef unsigned v2u __attribute__((ext_vector_type(2)));
typedef float f32x4 __attribute__((ext_vector_type(4)));
typedef float f32x2 __attribute__((ext_vector_type(2)));
typedef short bf16x8 __attribute__((ext_vector_type(8)));
typedef short s16x4 __attribute__((ext_vector_type(4)));
typedef GAS unsigned gu32;
#define RLX_AGENT __ATOMIC_RELAXED, __HIP_MEMORY_SCOPE_AGENT
#define LDS_WAIT() asm volatile("s_waitcnt lgkmcnt(0)" ::: "memory")
#define VM_WAIT() asm volatile("s_waitcnt vmcnt(0)" ::: "memory")
__device__ __forceinline__ unsigned f2bf(float f) { unsigned u = __builtin_bit_cast(unsigned, f); return (u + 0x7fffu + ((u >> 16) & 1u)) >> 16; }
__device__ __forceinline__ unsigned pk2(float lo, float hi) { return f2bf(lo) | (f2bf(hi) << 16); }
__device__ __forceinline__ float bf2f(bf16 v) { return __uint_as_float((unsigned)v << 16); }

#define XB_TMO      128
#define XB_XCNT(j)  (256  + 64 * (j))
#define XB_XSUB(j)  (1280 + 64 * (j))
#define XB_XGEN(j)  (2304 + 64 * (j))
#define XB_TOP      3328
#define XB_TOPGEN   3392
#define XCD_BAR_WORDS 3456
#define XB_SPIN_CAP (1u << 22)
__device__ __forceinline__ unsigned xb_ld(unsigned* p)              { return __hip_atomic_load(p, __ATOMIC_RELAXED, __HIP_MEMORY_SCOPE_AGENT); }
__device__ __forceinline__ unsigned xb_add(unsigned* p, unsigned v) { return __hip_atomic_fetch_add(p, v, __ATOMIC_RELAXED, __HIP_MEMORY_SCOPE_AGENT); }
__device__ __forceinline__ unsigned xb_xcc_id() { return (unsigned)__builtin_amdgcn_s_getreg((3 << 11) | 20) & 0xFu; }
#define XB_SPIN(cond, bar) do { unsigned _sp = 0; while (cond) { __builtin_amdgcn_s_sleep(1); \
    if ((++_sp & 255u) == 0u) { if (xb_ld(&(bar)[XB_TMO])) break; if (_sp > XB_SPIN_CAP) { atomicAdd(&(bar)[XB_TMO], 1u); break; } } } } while (0)
struct XcdBarrier { unsigned* bar; unsigned x; volatile LAS unsigned* st; };
__device__ __forceinline__ XcdBarrier xcd_barrier_post(unsigned* bar, volatile LAS unsigned* st) {
    XcdBarrier b; b.bar = bar; b.x = xb_xcc_id(); b.st = st;
    if (threadIdx.x == 0) (void)xb_add(&bar[XB_XCNT(b.x)], 1u);
    return b;
}
__device__ __forceinline__ void xcd_barrier_complete(unsigned* bar, unsigned x, unsigned& nloc, unsigned& nx) {
    const unsigned G = gridDim.x * gridDim.y * gridDim.z;
    unsigned sum, cnt, mine, sp = 0u;
    for (;;) {
        sum = 0u; cnt = 0u; mine = 0u;
#pragma unroll
        for (unsigned j = 0; j < 16; ++j) { const unsigned c = xb_ld(&bar[XB_XCNT(j)]); sum += c; cnt += (c > 0u) ? 1u : 0u; mine = (j == x) ? c : mine; }
        if (sum == G) break;
        __builtin_amdgcn_s_sleep(1);
        if ((++sp & 255u) == 0u) { if (xb_ld(&bar[XB_TMO])) break; if (sp > XB_SPIN_CAP) { atomicAdd(&bar[XB_TMO], 1u); break; } }
    }
    nloc = mine > 0u ? mine : 1u; nx = cnt > 0u ? cnt : 1u;
}
__device__ __forceinline__ void xcd_barrier(const XcdBarrier& b) {
    asm volatile("s_waitcnt vmcnt(0)" ::: "memory");
    __syncthreads();
    if (threadIdx.x == 0) {
        unsigned* bar = b.bar;
        __builtin_amdgcn_s_waitcnt(0);
        unsigned nloc = b.st[0], nx = b.st[1];
        if (nloc == 0u) { xcd_barrier_complete(bar, b.x, nloc, nx); b.st[0] = nloc; b.st[1] = nx; }
        const unsigned old = xb_add(&bar[XB_XSUB(b.x)], 1u);
        const unsigned gen = old / nloc;
        if (old + 1u == (gen + 1u) * nloc) {
            __builtin_amdgcn_fence(__ATOMIC_RELEASE, "agent");
            asm volatile("s_waitcnt vmcnt(0)" ::: "memory");
            const unsigned og = xb_add(&bar[XB_TOP], 1u);
            const unsigned tg = og / nx;
            if (og + 1u == (tg + 1u) * nx) xb_add(&bar[XB_TOPGEN], 1u);
            else XB_SPIN(xb_ld(&bar[XB_TOPGEN]) == tg, bar);
            __builtin_amdgcn_fence(__ATOMIC_ACQUIRE, "agent");
            xb_add(&bar[XB_XGEN(b.x)], 1u);
            asm volatile("s_waitcnt vmcnt(0)" ::: "memory");
        } else {
            XB_SPIN(xb_ld(&bar[XB_XGEN(b.x)]) == gen, bar);
            __builtin_amdgcn_fence(__ATOMIC_ACQUIRE, "agent");
            asm volatile("s_waitcnt vmcnt(0)" ::: "memory");
        }
    }
    __syncthreads();
}

struct Args { const float* in[18]; float* out; unsigned char* ws; int ph_lo, ph_hi; };
struct Frame {
    LAS unsigned char* lds;
    int tid, lane, wave, G, bid;
    const float* const* in; float* out; unsigned char* ws;
};
__device__ __forceinline__ float wave_sum(float v) {
#pragma unroll
    for (int o = 1; o < 64; o <<= 1) v += __shfl_xor(v, o);
    return v;
}

__device__ __forceinline__ void transpose_item(const float* W, int N, bf16* WT, int ldt, int koff, LAS unsigned* scr, int item, int lane, bool rev = false) {
    const int nblk = N / 64, sub = item & 7, grp = item >> 3, nb = 2 * (grp % (nblk / 2)) + (sub & 1), kb = 4 * (grp / (nblk / 2)) + (sub >> 1), k0 = 64 * kb, n0 = 64 * nb;
    const int n0d = rev ? (N / 256 - 1 - n0 / 256) * 256 + (n0 & 255) : n0;
    const int cg = lane & 15, rg = lane >> 4;
    f32x4 va[8], vb[8];
#pragma unroll
    for (int i = 0; i < 8; ++i) { const GAS float* src = (const GAS float*)W + (size_t)(k0 + 8 * i + 2 * rg) * N + n0 + 4 * cg; va[i] = *(const GAS f32x4*)src; vb[i] = *(const GAS f32x4*)(src + N); }
#pragma unroll
    for (int i = 0; i < 8; ++i) { const int kp = 4 * i + rg;
        scr[(4 * cg + 0) * 33 + kp] = pk2(va[i].x, vb[i].x); scr[(4 * cg + 1) * 33 + kp] = pk2(va[i].y, vb[i].y);
        scr[(4 * cg + 2) * 33 + kp] = pk2(va[i].z, vb[i].z); scr[(4 * cg + 3) * 33 + kp] = pk2(va[i].w, vb[i].w); }
    LDS_WAIT(); asm volatile("" ::: "memory");
    const int c = lane & 7;
#pragma unroll
    for (int j = 0; j < 8; ++j) { const int n = (lane >> 3) + 8 * j; const LAS unsigned* sp = scr + n * 33 + 4 * c;
        v4u o; o.x = sp[0]; o.y = sp[1]; o.z = sp[2]; o.w = sp[3];
        *(GAS v4u*)(WT + (size_t)(n0d + n) * ldt + koff + k0 + 8 * c) = o; }
    LDS_WAIT(); asm volatile("" ::: "memory");
}
__device__ __forceinline__ int t5_bucket(int n) {
    if (n < 16) return n;
    const float nf = (float)n;
    int large = 16 + (int)(logf(nf / 16.0f) / 4.852030263919617f * 16.0f);
    return large < 31 ? large : 31;
}
__device__ __forceinline__ int pat_dil(int p) { return p == 0 ? 1 : (p == 1 ? 4 : 16); }

__device__ __forceinline__ void phase_convert_ffn(Frame& F) {
    LAS unsigned* scr = (LAS unsigned*)(F.lds + RING_OFF + F.wave * 16384);
    const int gw = F.bid * NWAVES + F.wave, NGW = F.G * NWAVES;
    constexpr int I_1 = (DM / 64) * (DFF / 64), I_2 = (DFF / 64) * (DM / 64);
    bf16* W1_t = (bf16*)(F.ws + WS_W1); bf16* W2_t = (bf16*)(F.ws + WS_W2);
    for (int it = gw; it < I_1 + I_2; it += NGW) {
        if (it < I_1) transpose_item(F.in[12], DFF, W1_t, DM, 0, scr, it, F.lane);
        else transpose_item(F.in[14], DM, W2_t, DFF, 0, scr, it - I_1, F.lane);
    }
}
__device__ __forceinline__ void phase_prologue(Frame& F) {
    LAS unsigned* scr = (LAS unsigned*)(F.lds + RING_OFF + F.wave * 16384);
    const int gw = F.bid * NWAVES + F.wave, NGW = F.G * NWAVES;
    const float* w_in = F.in[1]; const float* wpa = F.in[7]; const float* wpb = F.in[8]; const float* wout = F.in[9];
    bf16* Win_t = (bf16*)(F.ws + WS_WIN); bf16* Wpab_t = (bf16*)(F.ws + WS_WPAB); bf16* Wout_t = (bf16*)(F.ws + WS_WOUT);
    constexpr int I_IN = (DM / 64) * (DIN / 64), I_PA = (DA / 64) * (DM / 64), I_OUT = (DM / 64) * (DM / 64);
    constexpr int NITEMS = I_IN + 2 * I_PA + I_OUT;
    for (int it = gw; it < NITEMS; it += NGW) {
        int r = it;
        if (r < I_IN) { transpose_item(w_in, DIN, Win_t, DM, 0, scr, r, F.lane, true); continue; } r -= I_IN;
        if (r < I_PA) { transpose_item(wpa, DM, Wpab_t, 2048, 0, scr, r, F.lane); continue; } r -= I_PA;
        if (r < I_PA) { transpose_item(wpb, DM, Wpab_t, 2048, 1024, scr, r, F.lane); continue; } r -= I_PA;
        transpose_item(wout, DM, Wout_t, 2048, 0, scr, r, F.lane);
    }
    phase_convert_ffn(F);
    const float* x = F.in[0]; bf16* XB = (bf16*)(F.ws + WS_XB);
    for (int m = gw; m < M; m += 2 * NGW) {
        const GAS f32x4* xr0 = (const GAS f32x4*)(x + (size_t)m * DM) + F.lane; const GAS f32x4* xr1 = (const GAS f32x4*)(x + (size_t)(m + NGW) * DM) + F.lane;
        GAS v2u* o0 = (GAS v2u*)(XB + (size_t)m * DM) + F.lane; GAS v2u* o1 = (GAS v2u*)(XB + (size_t)(m + NGW) * DM) + F.lane;
        f32x4 v0[8], v1[8];
#pragma unroll
        for (int j = 0; j < 8; ++j) { v0[j] = xr0[64 * j]; v1[j] = xr1[64 * j]; }
#pragma unroll
        for (int j = 0; j < 8; ++j) { o0[64 * j] = (v2u){pk2(v0[j].x, v0[j].y), pk2(v0[j].z, v0[j].w)}; o1[64 * j] = (v2u){pk2(v1[j].x, v1[j].y), pk2(v1[j].z, v1[j].w)}; }
    }
    const int gt = F.bid * (NWAVES * 64) + F.tid, NGT = F.G * NWAVES * 64;
    const float* wsp = F.in[5]; bf16* WSP = (bf16*)(F.ws + WS_WSP);
    for (int e = gt; e < 8 * 128 * 128; e += NGT) { const int i = (e >> 7) & 127, j = e & 127; WSP[e] = (bf16)(j <= i ? f2bf(wsp[e]) : 0u); }
    const float* rb = F.in[2]; float* BT = (float*)(F.ws + WS_BTAB);
    for (int e = gt; e < NPAT * NH * BT_PITCH; e += NGT) { const int p = e / (NH * BT_PITCH), h = (e / BT_PITCH) % NH, j = e % BT_PITCH;
        BT[e] = (j <= 128) ? rb[t5_bucket(j * pat_dil(p)) * NH + h] * LOG2E : 0.f; }
}
__device__ __forceinline__ void phase_ln(Frame& F, const float* base, const bf16* add, float* outf, const float* gain, const float* bias, bf16* ob) {
    const int gw = F.bid * NWAVES + F.wave, NGW = F.G * NWAVES;
    for (int m = gw; m < M; m += NGW) {
        const GAS f32x4* xr = (const GAS f32x4*)(base + (size_t)m * DM) + F.lane; const GAS v2u* ar = (const GAS v2u*)(add + (size_t)m * DM) + F.lane;
        f32x4 v[8]; float s = 0.f;
#pragma unroll
        for (int j = 0; j < 8; ++j) { const f32x4 x = xr[64 * j]; const v2u a = ar[64 * j];
            v[j] = x * ALPHA + (f32x4){pg8::bf_lo(a.x), pg8::bf_hi(a.x), pg8::bf_lo(a.y), pg8::bf_hi(a.y)}; s += (v[j].x + v[j].y) + (v[j].z + v[j].w); }
        const float mean = wave_sum(s) * (1.f / DM); float s2 = 0.f;
#pragma unroll
        for (int j = 0; j < 8; ++j) { v[j] = v[j] - mean; s2 += (v[j].x * v[j].x + v[j].y * v[j].y) + (v[j].z * v[j].z + v[j].w * v[j].w); }
        const float rstd = 1.f / sqrtf(wave_sum(s2) * (1.f / DM) + LN_EPS);
        GAS f32x4* orow = (GAS f32x4*)(outf + (size_t)m * DM) + F.lane;
#pragma unroll
        for (int j = 0; j < 8; ++j) { const f32x4 g = ((const GAS f32x4*)gain)[64 * j + F.lane], b = ((const GAS f32x4*)bias)[64 * j + F.lane];
            const f32x4 o = v[j] * rstd * g + b; orow[64 * j] = o;
            if (ob) ((GAS v2u*)(ob + (size_t)m * DM))[64 * j + F.lane] = (v2u){pk2(o.x, o.y), pk2(o.z, o.w)}; }
    }
}
__device__ __forceinline__ void phase_combine(Frame& F) {
    const int gw = F.bid * NWAVES + F.wave, NGW = F.G * NWAVES;
    const bf16* O0 = (const bf16*)F.out; const bf16* O1 = O0 + (size_t)M * DA; const bf16* O2 = O1 + (size_t)M * DA;
    const float* LSE = (const float*)(F.ws + WS_LSE); bf16* AG = (bf16*)(F.ws + WS_AG);
    for (int m = gw; m < M; m += NGW) {
        const int h = F.lane >> 3;
        const float l0 = LSE[((size_t)0 * M + m) * NH + h], l1 = LSE[((size_t)1 * M + m) * NH + h], l2 = LSE[((size_t)2 * M + m) * NH + h];
        const float mx = fmaxf(l0, fmaxf(l1, l2)); float w0 = exp2f(l0 - mx), w1 = exp2f(l1 - mx), w2 = exp2f(l2 - mx); const float inv = 1.f / (w0 + w1 + w2); w0 *= inv; w1 *= inv; w2 *= inv;
        const size_t off = (size_t)m * DA + F.lane * 16;
#pragma unroll
        for (int c = 0; c < 2; ++c) {
            const v4u a = *(const GAS v4u*)(O0 + off + c * 8), b = *(const GAS v4u*)(O1 + off + c * 8), d = *(const GAS v4u*)(O2 + off + c * 8); v4u o;
#pragma unroll
            for (int e = 0; e < 4; ++e) { const float lo = w0 * pg8::bf_lo(a[e]) + w1 * pg8::bf_lo(b[e]) + w2 * pg8::bf_lo(d[e]); const float hi = w0 * pg8::bf_hi(a[e]) + w1 * pg8::bf_hi(b[e]) + w2 * pg8::bf_hi(d[e]); o[e] = pk2(lo, hi); }
            *(GAS v4u*)(AG + (size_t)m * 2048 + F.lane * 16 + c * 8) = o;
        }
    }
}

__device__ __forceinline__ s16x4 tr_read(const LAS unsigned char* p) { return __builtin_bit_cast(s16x4, __builtin_amdgcn_ds_read_tr16_b64_v4i16((LAS s16x4*)p)); }
constexpr int ATT_K_OFF = 0, ATT_V_OFF = 65536;

struct AUnit { int b, h, p, d, r, blk; };
__device__ __forceinline__ AUnit aunit(int uid) {
    AUnit u; const int bh = uid / 48, x = uid % 48; u.b = bh >> 3; u.h = bh & 7;
    if (x < 16) { u.p = 0; u.d = 1; u.r = 0; u.blk = x; } else if (x < 32) { u.p = 1; u.d = 4; u.r = (x - 16) >> 2; u.blk = (x - 16) & 3; } else { u.p = 2; u.d = 16; u.r = x - 32; u.blk = 0; }
    return u;
}
__device__ __forceinline__ void attn_units(Frame& F, int vcu, float* Opart) {
    const int tid = F.tid, lane = F.lane, w = F.wave, fr = lane & 15, g = lane >> 4;
    const bf16* Qg = (const bf16*)(F.ws + WS_Q); const bf16* Kg = (const bf16*)(F.ws + WS_K); const bf16* Vg = (const bf16*)(F.ws + WS_V);
    float* LSE = (float*)(F.ws + WS_LSE);
    LAS unsigned char* lds = F.lds;
    LAS float* BTl = (LAS float*)(lds + LDS_BT_OFF);
    constexpr int NU = BATCH * NH * 48;
    for (int e = tid; e < NPAT * NH * BT_PITCH; e += NWAVES * 64) BTl[e] = ((const float*)(F.ws + WS_BTAB))[e];
    v4u kr[8], vr[8]; bf16x8 qn[4];
#define ATT_PREFETCH(U) do { const size_t _rb = (size_t)(U).b * SEQ; const int _lo = ((U).blk == 0) ? 4 : 0; \
        _Pragma("unroll") for (int it = 0; it < 8; ++it) if (it >= _lo) { const int idx = it * 512 + tid, kj = idx >> 4, gr = idx & 15; \
            const size_t row = _rb + (U).r + (U).d * (128 * ((U).blk - 1) + kj); \
            kr[it] = *(const GAS v4u*)(Kg + row * DA + (U).h * HD + gr * 8); vr[it] = *(const GAS v4u*)(Vg + row * DA + (U).h * HD + gr * 8); } \
        const size_t _qrow = _rb + (U).r + (U).d * (128 * (U).blk + 16 * w + fr); \
        _Pragma("unroll") for (int ks = 0; ks < 4; ++ks) qn[ks] = *(const GAS bf16x8*)(Qg + _qrow * DA + (U).h * HD + 32 * ks + 8 * g); } while (0)
    const bool loc = false; const int nsteps = loc ? 12 : (NU - vcu + F.G - 1) / F.G;
#define ATT_UID(t) (loc ? ((((t) / 3) * 16 + (vcu >> 4)) * 48 + ((t) % 3) * 16 + (vcu & 15)) : (vcu + (t) * F.G))
    AUnit cur = aunit(ATT_UID(0));
    if (nsteps > 0) ATT_PREFETCH(cur);
    for (int t = 0; t < nsteps; ++t) {
        const int kt_lo = (cur.blk == 0) ? 8 : 0;
#pragma unroll
        for (int it = 0; it < 8; ++it) if (it * 2 >= kt_lo) {
            const int idx = it * 512 + tid, kj = idx >> 4, gr = idx & 15;
            *(LAS v4u*)(lds + ATT_K_OFF + kj * 256 + ((gr ^ (kj & 15)) << 4)) = kr[it];
            *(LAS v4u*)(lds + ATT_V_OFF + kj * 256 + ((gr ^ ((kj & 7) << 1)) << 4)) = vr[it];
        }
        bf16x8 qf[4];
#pragma unroll
        for (int ks = 0; ks < 4; ++ks) { qf[ks] = qn[ks]; asm volatile("" : "+v"(qf[ks])); }
        LDS_WAIT(); __builtin_amdgcn_s_barrier(); asm volatile("" ::: "memory");
        const AUnit me = cur;
        if (t + 1 < nsteps) { cur = aunit(ATT_UID(t + 1)); ATT_PREFETCH(cur); }
        const int qi = 16 * w + fr;
        const size_t qrow = (size_t)me.b * SEQ + me.r + me.d * (128 * me.blk + qi);
        const LAS float* BTp = BTl + (me.p * NH + me.h) * BT_PITCH;
        f32x4 st[9]; float mx = -1e30f;
#pragma unroll
        for (int t = 0; t < 9; ++t) {
            const int kt = w + t;
            if (kt >= kt_lo) {
                f32x4 a = (f32x4){0.f, 0.f, 0.f, 0.f};
                const int key = 16 * kt + fr;
#pragma unroll
                for (int ks = 0; ks < 4; ++ks) { const bf16x8 kf = *(const LAS bf16x8*)(lds + ATT_K_OFF + key * 256 + (((4 * ks + g) ^ fr) << 4));
                    a = __builtin_amdgcn_mfma_f32_16x16x32_bf16(kf, qf[ks], a, 0, 0, 0); }
#pragma unroll
                for (int e = 0; e < 4; ++e) { const int kj = 16 * kt + 4 * g + e, steps = 128 + qi - kj; const bool ok = (steps >= 0) && (steps <= 128);
                    const float v = ok ? a[e] + BTp[ok ? steps : 0] : -1e30f; a[e] = v; mx = fmaxf(mx, v); }
                st[t] = a;
            } else st[t] = (f32x4){-1e30f, -1e30f, -1e30f, -1e30f};
        }
        mx = fmaxf(mx, __shfl_xor(mx, 16)); mx = fmaxf(mx, __shfl_xor(mx, 32));
        float lsum = 0.f;
#pragma unroll
        for (int t = 0; t < 9; ++t)
#pragma unroll
            for (int e = 0; e < 4; ++e) { const float pv = pg8::fast_exp2(st[t][e] - mx); st[t][e] = pv; lsum += pv; }
        lsum += __shfl_xor(lsum, 16); lsum += __shfl_xor(lsum, 32);
        f32x4 o[8];
#pragma unroll
        for (int mt = 0; mt < 8; ++mt) o[mt] = (f32x4){0.f, 0.f, 0.f, 0.f};
#pragma unroll
        for (int a = 0; a < 5; ++a) {
            const int kt0 = w + 2 * a, kt1 = kt0 + 1; const bool v0 = kt0 >= kt_lo, v1 = (2 * a + 1 <= 8) && (kt1 >= kt_lo);
            if (v0 || v1) {
                v4u pw; pw.x = pg8::cvt_pk_bf16(st[2 * a][0], st[2 * a][1]); pw.y = pg8::cvt_pk_bf16(st[2 * a][2], st[2 * a][3]);
                if (2 * a + 1 <= 8) { pw.z = pg8::cvt_pk_bf16(st[(2 * a + 1 <= 8) ? 2 * a + 1 : 0][0], st[(2 * a + 1 <= 8) ? 2 * a + 1 : 0][1]); pw.w = pg8::cvt_pk_bf16(st[(2 * a + 1 <= 8) ? 2 * a + 1 : 0][2], st[(2 * a + 1 <= 8) ? 2 * a + 1 : 0][3]); }
                else { pw.z = 0u; pw.w = 0u; }
                if (!v0) { pw.x = 0u; pw.y = 0u; }
                if (!v1) { pw.z = 0u; pw.w = 0u; }
                const bf16x8 pf = __builtin_bit_cast(bf16x8, pw);
                const int krow = 4 * g + (fr >> 2), ksw = ((krow & 7) << 1);
                const LAS unsigned char* v0p = lds + ATT_V_OFF + (16 * kt0 + krow) * 256 + ((lane & 1) << 3);
                const LAS unsigned char* v1p = lds + ATT_V_OFF + (16 * kt1 + krow) * 256 + ((lane & 1) << 3);
#pragma unroll
                for (int mt = 0; mt < 8; ++mt) {
                    const int gsw = ((2 * mt + ((lane & 3) >> 1)) ^ ksw) << 4;
                    s16x4 lo = (s16x4){0, 0, 0, 0}, hi = (s16x4){0, 0, 0, 0};
                    if (v0) lo = tr_read(v0p + gsw);
                    if (v1) hi = tr_read(v1p + gsw);
                    const bf16x8 vf = (bf16x8){lo[0], lo[1], lo[2], lo[3], hi[0], hi[1], hi[2], hi[3]};
                    o[mt] = __builtin_amdgcn_mfma_f32_16x16x32_bf16(vf, pf, o[mt], 0, 0, 0);
                }
            }
        }
        const float inv = 1.0f / lsum;
        bf16* orow = (bf16*)Opart + (size_t)me.p * M * DA + qrow * DA + me.h * HD + 4 * g;
#pragma unroll
        for (int mt = 0; mt < 8; ++mt) { const f32x4 v = o[mt] * inv; *(GAS v2u*)(orow + 16 * mt) = (v2u){pg8::cvt_pk_bf16(v[0], v[1]), pg8::cvt_pk_bf16(v[2], v[3])}; }
        if (g == 0) LSE[((size_t)me.p * M + qrow) * NH + me.h] = mx + log2f(lsum);
        LDS_WAIT(); __builtin_amdgcn_s_barrier(); asm volatile("" ::: "memory");
    }
#undef ATT_PREFETCH
#undef ATT_UID
}

__device__ __forceinline__ void gmlp_unit(Frame& F, int uid) {
    const int gg = uid & 7, c = (uid >> 3) & 15, b = uid >> 7;
    const int tid = F.tid, lane = F.lane, w = F.wave, fr = lane & 15, g = lane >> 4;
    LAS unsigned char* lds = F.lds;
    LAS f32x2* STl = (LAS f32x2*)(lds + LDS_BT_OFF);
    const size_t R0 = (size_t)b * SEQ + 128 * c;
    const bf16* VBg = (const bf16*)(F.ws + WS_VB); const bf16* Ug = (const bf16*)(F.ws + WS_U); const bf16* WSP = (const bf16*)(F.ws + WS_WSP) + (size_t)gg * 128 * 128;
    const f32x2* VST = (const f32x2*)(F.ws + WS_VSTAT); bf16* AG = (bf16*)(F.ws + WS_AG);
    const float* gain = F.in[3]; const float* biasv = F.in[4]; const float* bsp = F.in[6];
    const int i = 16 * w + fr, nks = (w >> 1) + 1;
    v4u st8[8];
    if (tid < 128) {
#pragma unroll
        for (int k = 0; k < 8; ++k) st8[k] = *(const GAS v4u*)(VST + (R0 + tid) * 16 + 2 * k);
    }
    v4u raw[4];
#pragma unroll
    for (int it = 0; it < 4; ++it) { const int idx = it * 512 + tid, j = idx >> 4, gr = idx & 15; raw[it] = *(const GAS v4u*)(VBg + (R0 + j) * DB + gg * 128 + gr * 8); }
    const int gr0 = tid & 15;
    const f32x4 g0 = *(const GAS f32x4*)(gain + gg * 128 + gr0 * 8), g1 = *(const GAS f32x4*)(gain + gg * 128 + gr0 * 8 + 4);
    const f32x4 b0 = *(const GAS f32x4*)(biasv + gg * 128 + gr0 * 8), b1 = *(const GAS f32x4*)(biasv + gg * 128 + gr0 * 8 + 4);
    bf16x8 wf[4];
#pragma unroll
    for (int ks = 0; ks < 4; ++ks) wf[ks] = (ks < nks) ? *(const GAS bf16x8*)(WSP + (size_t)i * 128 + 32 * ks + 8 * g) : (bf16x8){0, 0, 0, 0, 0, 0, 0, 0};
    const bf16* urow = Ug + (R0 + i) * DB + gg * 128 + 4 * g;
    v2u uu[8];
#pragma unroll
    for (int mt = 0; mt < 8; ++mt) uu[mt] = *(const GAS v2u*)(urow + 16 * mt);
    const float bs = bsp[gg * 128 + i];
    if (tid < 128) { float s1 = 0.f, s2 = 0.f;
#pragma unroll
        for (int k = 0; k < 8; ++k) { s1 += __uint_as_float(st8[k].x) + __uint_as_float(st8[k].z); s2 += __uint_as_float(st8[k].y) + __uint_as_float(st8[k].w); }
        const float mean = s1 * (1.f / DB), var = fmaxf(s2 * (1.f / DB) - mean * mean, 0.f);
        STl[tid] = (f32x2){mean, 1.0f / sqrtf(var + LN_EPS)}; }
    LDS_WAIT(); __builtin_amdgcn_s_barrier(); asm volatile("" ::: "memory");
#pragma unroll
    for (int it = 0; it < 4; ++it) {
        const int idx = it * 512 + tid, j = idx >> 4, gr = idx & 15;
        const f32x2 st = STl[j]; const v4u r4 = raw[it];
        v4u o;
        o.x = pk2((pg8::bf_lo(r4.x) - st.x) * st.y * g0[0] + b0[0], (pg8::bf_hi(r4.x) - st.x) * st.y * g0[1] + b0[1]);
        o.y = pk2((pg8::bf_lo(r4.y) - st.x) * st.y * g0[2] + b0[2], (pg8::bf_hi(r4.y) - st.x) * st.y * g0[3] + b0[3]);
        o.z = pk2((pg8::bf_lo(r4.z) - st.x) * st.y * g1[0] + b1[0], (pg8::bf_hi(r4.z) - st.x) * st.y * g1[1] + b1[1]);
        o.w = pk2((pg8::bf_lo(r4.w) - st.x) * st.y * g1[2] + b1[2], (pg8::bf_hi(r4.w) - st.x) * st.y * g1[3] + b1[3]);
        *(LAS v4u*)(lds + j * 256 + ((gr ^ ((j & 7) << 1)) << 4)) = o;
    }
    LDS_WAIT(); __builtin_amdgcn_s_barrier(); asm volatile("" ::: "memory");
    f32x4 acc[8];
#pragma unroll
    for (int mt = 0; mt < 8; ++mt) acc[mt] = (f32x4){0.f, 0.f, 0.f, 0.f};
#pragma unroll
    for (int ks = 0; ks < 4; ++ks) if (ks < nks) {
        const int j0 = 32 * ks + 8 * g + (fr >> 2), j1 = j0 + 4;
        const LAS unsigned char* p0 = lds + j0 * 256 + ((lane & 1) << 3); const LAS unsigned char* p1 = lds + j1 * 256 + ((lane & 1) << 3);
        const int s0 = (j0 & 7) << 1, s1 = (j1 & 7) << 1;
#pragma unroll
        for (int mt = 0; mt < 8; ++mt) {
            const int gb = 2 * mt + ((lane & 3) >> 1);
            const s16x4 lo = tr_read(p0 + ((gb ^ s0) << 4)), hi = tr_read(p1 + ((gb ^ s1) << 4));
            const bf16x8 vf = (bf16x8){lo[0], lo[1], lo[2], lo[3], hi[0], hi[1], hi[2], hi[3]};
            acc[mt] = __builtin_amdgcn_mfma_f32_16x16x32_bf16(vf, wf[ks], acc[mt], 0, 0, 0);
        }
    }
    bf16* orow = AG + (R0 + i) * 2048 + 1024 + gg * 128 + 4 * g;
#pragma unroll
    for (int mt = 0; mt < 8; ++mt) {
        const float z0 = (acc[mt][0] + bs) * pg8::bf_lo(uu[mt].x), z1 = (acc[mt][1] + bs) * pg8::bf_hi(uu[mt].x), z2 = (acc[mt][2] + bs) * pg8::bf_lo(uu[mt].y), z3 = (acc[mt][3] + bs) * pg8::bf_hi(uu[mt].y);
        *(GAS v2u*)(orow + 16 * mt) = (v2u){pg8::cvt_pk_bf16(z0, z1), pg8::cvt_pk_bf16(z2, z3)}; }
    LDS_WAIT(); __builtin_amdgcn_s_barrier(); asm volatile("" ::: "memory");
}
__device__ __forceinline__ void phase_attn(Frame& F) {
    const int vcu = (F.G % 8 == 0) ? (F.bid & 7) * (F.G >> 3) + (F.bid >> 3) : F.bid;
    attn_units(F, vcu, F.out);
}
__device__ __forceinline__ void phase_gmlp(Frame& F) {
    for (int u = F.bid; u < BATCH * 16 * 8; u += F.G) gmlp_unit(F, u);
}

constexpr int N_PHASES = 11;
__global__ void __launch_bounds__(NWAVES * 64, 2) mk_fwd(Args args) {
    extern __shared__ __attribute__((aligned(16))) unsigned char lds_raw[];
    Frame F;
    F.lds = (LAS unsigned char*)lds_raw;
    F.tid = threadIdx.x; F.lane = F.tid & 63; F.wave = __builtin_amdgcn_readfirstlane(F.tid >> 6);
    F.G = gridDim.x; F.bid = blockIdx.x; F.in = args.in; F.out = args.out; F.ws = args.ws;
    for (int u = F.tid; u < (LDS_BYTES - LDSCTL_OFF) / 4; u += NWAVES * 64) ((LAS unsigned*)(F.lds + LDSCTL_OFF))[u] = 0u;
    __syncthreads();
    gu32* ctl = (gu32*)(args.ws + WS_CTL);
    const int lo = args.ph_lo, hi = args.ph_hi;
    XcdBarrier bar; bar.bar = (unsigned*)(ctl + CW_BAR); bar.x = 0; bar.st = nullptr;
    if (hi - lo > 1) bar = xcd_barrier_post((unsigned*)(ctl + CW_BAR), (volatile LAS unsigned*)(F.lds + MISC_OFF) + 8);
#define IN(k) (lo <= (k) && (k) < hi)
#define STAMP(k) do { if (MK_TPROBE && F.bid == 0 && F.tid == 0) ((unsigned long long*)(ctl + CW_TS))[k] = __builtin_amdgcn_s_memrealtime(); } while (0)
#define SEAM(k) do { if (IN(k) && IN((k) + 1)) xcd_barrier(bar); STAMP((k) + 1); } while (0)
    STAMP(0);
    unsigned char* ws = args.ws;
    if (IN(0)) { phase_prologue(F); SEAM(0); }
    if (IN(1)) {
        pg8::Gemm g{(const bf16*)(ws + WS_XB), (const bf16*)(ws + WS_WIN), DM, DM, 0}; pg8::StaticOrder S; S.init(M, DIN, F.G, F.bid);
        pg8::EpiProj E{(bf16*)(ws + WS_Q), (bf16*)(ws + WS_K), (bf16*)(ws + WS_V), (bf16*)(ws + WS_U), (bf16*)(ws + WS_VB), (bf16*)(ws + WS_GA), (bf16*)(ws + WS_GB), (pg8::f32x2*)(ws + WS_VSTAT), QSCALE};
        pg8::gemm_phase<pg8::EpiProj, pg8::StaticOrder, true>(F.lds + RING_OFF, g, S, E);
        SEAM(1);
    }
    if (IN(2)) { phase_attn(F); if (MK_TPROBE) SEAM(2); }
    if (IN(3)) { phase_gmlp(F); SEAM(3); }
    if (IN(4)) { phase_combine(F); SEAM(4); }
    if (IN(5)) {
        pg8::Gemm g{(const bf16*)(ws + WS_AG), (const bf16*)(ws + WS_WPAB), 1024, 2048, 2048}; pg8::PairOrder S; S.so.init(M, DM, F.G, F.bid);
        pg8::EpiGate E{(const bf16*)(ws + WS_GA), (const bf16*)(ws + WS_GB), (bf16*)(ws + WS_MRG)};
        pg8::gemm_phase<pg8::EpiGate, pg8::PairOrder, true>(F.lds + RING_OFF, g, S, E);
        SEAM(5);
    }
    if (IN(6)) {
        pg8::Gemm g{(const bf16*)(ws + WS_MRG), (const bf16*)(ws + WS_WOUT), DM, DM, 0}; pg8::StaticOrder S; S.init(M, DM, F.G, F.bid);
        pg8::EpiBiasAct<0> E{(bf16*)(ws + WS_MIX), DM, nullptr};
        pg8::gemm_phase<pg8::EpiBiasAct<0>, pg8::StaticOrder, true>(F.lds + RING_OFF, g, S, E);
        SEAM(6);
    }
    if (IN(7)) { phase_ln(F, args.in[0], (const bf16*)(ws + WS_MIX), args.out, args.in[10], args.in[11], (bf16*)(ws + WS_HB)); SEAM(7); }
    if (IN(8)) {
        pg8::Gemm g{(const bf16*)(ws + WS_HB), (const bf16*)(ws + WS_W1), DM, DM, 0}; pg8::StaticOrder S; S.init(M, DFF, F.G, F.bid);
        pg8::EpiBiasAct<1> E{(bf16*)(ws + WS_ACT), DFF, args.in[13]};
        pg8::gemm_phase<pg8::EpiBiasAct<1>, pg8::StaticOrder, true>(F.lds + RING_OFF, g, S, E);
        SEAM(8);
    }
    if (IN(9)) {
        pg8::Gemm g{(const bf16*)(ws + WS_ACT), (const bf16*)(ws + WS_W2), DFF, DFF, 0}; pg8::StaticOrder S; S.init(M, DM, F.G, F.bid);
        pg8::EpiBiasAct<0> E{(bf16*)(ws + WS_FF), DM, args.in[15]};
        pg8::gemm_phase<pg8::EpiBiasAct<0>, pg8::StaticOrder, true>(F.lds + RING_OFF, g, S, E);
        SEAM(9);
    }
    if (IN(10)) { phase_ln(F, args.out, (const bf16*)(ws + WS_FF), args.out, args.in[16], args.in[17], nullptr); }
#if MK_TPROBE
    if (hi - lo > 1) {
        xcd_barrier(bar); STAMP(11);
        if (F.bid == 0 && F.tid == 0) {
            const unsigned long long* ts = (const unsigned long long*)(ctl + CW_TS);
            const unsigned long long dt = (ts[MK_TPA + 1] - ts[MK_TPA]) * (unsigned long long)(MK_TPB), t0 = __builtin_amdgcn_s_memrealtime();
            while (__builtin_amdgcn_s_memrealtime() - t0 < dt) __builtin_amdgcn_s_sleep(20);
        }
    }
#endif
#undef IN
#undef SEAM
}

#if MK_DEBUG_CHECKS
__device__ __forceinline__ unsigned hsh(unsigned x) { x ^= x >> 16; x *= 0x7feb352dU; x ^= x >> 15; x *= 0x846ca68bU; x ^= x >> 16; return x; }
__device__ float dot_bf(const bf16* a, const bf16* b, int K) { float s = 0.f; for (int k = 0; k < K; ++k) s += bf2f(a[k]) * bf2f(b[k]); return s; }
__device__ __forceinline__ bool bad(float got, float ex, float rt, float at) { return !(fabsf(got - ex) <= at + rt * fabsf(ex)); }
__device__ float gelu_ref(float v) { return 0.5f * v * (1.0f + tanhf(0.7978845608028654f * (v + 0.044715f * v * v * v))); }
__global__ void mk_check(Args args, int stage) {
    const unsigned gid = blockIdx.x * blockDim.x + threadIdx.x; unsigned char* ws = args.ws; unsigned* flag = (unsigned*)(ws + WS_CTL) + CW_CHK + stage;
    const unsigned h1 = hsh(gid * 2654435761u + 17u * stage + 1u), h2 = hsh(h1 + 0x9e3779b9u), h3 = hsh(h2 + 0x85ebca6bu);
    bool fail = false;
    if (stage == 0) {
        const int sel = gid % 7;
        if (sel == 0) { const int n = h1 % DIN, k = h2 % DM; fail = ((const bf16*)(ws + WS_WIN))[(size_t)n * DM + k] != (bf16)f2bf(args.in[1][(size_t)k * DIN + n]); }
        else if (sel == 1) { const int n = h1 % DM, k = h2 % DA; fail = ((const bf16*)(ws + WS_WPAB))[(size_t)n * 2048 + k] != (bf16)f2bf(args.in[7][(size_t)k * DM + n]); }
        else if (sel == 2) { const int n = h1 % DM, k = h2 % DB; fail = ((const bf16*)(ws + WS_WPAB))[(size_t)n * 2048 + 1024 + k] != (bf16)f2bf(args.in[8][(size_t)k * DM + n]); }
        else if (sel == 3) { const int n = h1 % DM, k = h2 % DM; fail = ((const bf16*)(ws + WS_WOUT))[(size_t)n * DM + k] != (bf16)f2bf(args.in[9][(size_t)k * DM + n]); }
        else if (sel == 4) { const int m = h1 % M, k = h2 % DM; fail = ((const bf16*)(ws + WS_XB))[(size_t)m * DM + k] != (bf16)f2bf(args.in[0][(size_t)m * DM + k]); }
        else if (sel == 5) { const int e = h1 % (8 * 128 * 128), i = (e >> 7) & 127, j = e & 127; fail = ((const bf16*)(ws + WS_WSP))[e] != (bf16)(j <= i ? f2bf(args.in[5][e]) : 0u); }
        else { const int p = h1 % 3, h = h2 % 8, j = h3 % 129; const float ex = args.in[2][t5_bucket(j * pat_dil(p)) * NH + h] * LOG2E; fail = bad(((const float*)(ws + WS_BTAB))[(p * NH + h) * BT_PITCH + j], ex, 1e-5f, 1e-6f); }
    } else if (stage == 1) {
        const int row = h1 % M, col = h2 % DIN;
        if (gid < 7680) {
            const float dv = dot_bf((const bf16*)(ws + WS_XB) + (size_t)row * DM, (const bf16*)(ws + WS_WIN) + (size_t)col * DM, DM);
            float ex, got;
            if (col < 1024) { ex = dv * QSCALE; got = bf2f(((const bf16*)(ws + WS_Q))[(size_t)row * 1024 + col]); }
            else if (col < 2048) { ex = dv; got = bf2f(((const bf16*)(ws + WS_K))[(size_t)row * 1024 + col - 1024]); }
            else if (col < 3072) { ex = dv; got = bf2f(((const bf16*)(ws + WS_V))[(size_t)row * 1024 + col - 2048]); }
            else if (col < 4096) { ex = gelu_ref(dv); got = bf2f(((const bf16*)(ws + WS_U))[(size_t)row * 1024 + col - 3072]); }
            else if (col < 5120) { ex = gelu_ref(dv); got = bf2f(((const bf16*)(ws + WS_VB))[(size_t)row * 1024 + col - 4096]); }
            else if (col < 7168) { ex = dv; got = bf2f(((const bf16*)(ws + WS_GA))[(size_t)row * 2048 + col - 5120]); }
            else { ex = dv; got = bf2f(((const bf16*)(ws + WS_GB))[(size_t)row * 2048 + col - 7168]); }
            fail = bad(got, ex, 1.5e-2f, 1e-2f);
        } else {
            float s1 = 0.f, s2 = 0.f; for (int c = 0; c < 1024; ++c) { const float v = bf2f(((const bf16*)(ws + WS_VB))[(size_t)row * 1024 + c]); s1 += v; s2 += v * v; }
            float t1 = 0.f, t2 = 0.f; for (int k = 0; k < 16; ++k) { const f32x2 t = ((const f32x2*)(ws + WS_VSTAT))[(size_t)row * 16 + k]; t1 += t.x; t2 += t.y; }
            fail = bad(t1, s1, 1e-2f, 1.0f) || bad(t2, s2, 1e-2f, 1.0f);
        }
    } else if (stage == 2) {
        if (gid < 6144) {
            const int b = h1 % BATCH, s = h2 % SEQ, h = h3 % NH, p = (h3 >> 8) % 3, d = pat_dil(p);
            const bf16* Qg = (const bf16*)(ws + WS_Q); const bf16* Kg = (const bf16*)(ws + WS_K); const bf16* Vg = (const bf16*)(ws + WS_V);
            const bf16* Og = (const bf16*)(ws + (p == 0 ? WS_O0 : (p == 1 ? WS_O1 : WS_O2))); const float* BT = (const float*)(ws + WS_BTAB) + (p * NH + h) * BT_PITCH;
            const size_t qrow = (size_t)b * SEQ + s; float mx = -1e30f;
            for (int j = 0; j <= 128; ++j) { const int sk = s - j * d; if (sk < 0) break; const float sc = dot_bf(Qg + qrow * DA + h * HD, Kg + ((size_t)b * SEQ + sk) * DA + h * HD, HD) + BT[j]; mx = fmaxf(mx, sc); }
            float den = 0.f; for (int j = 0; j <= 128; ++j) { const int sk = s - j * d; if (sk < 0) break; const float sc = dot_bf(Qg + qrow * DA + h * HD, Kg + ((size_t)b * SEQ + sk) * DA + h * HD, HD) + BT[j]; den += exp2f(sc - mx); }
            const float l2 = mx + log2f(den);
            fail = bad(((const float*)(ws + WS_LSE))[((size_t)p * M + qrow) * NH + h], l2, 2e-3f, 2e-2f);
            for (int dd = 0; dd < HD; dd += 7) { float o = 0.f;
                for (int j = 0; j <= 128; ++j) { const int sk = s - j * d; if (sk < 0) break; const float sc = dot_bf(Qg + qrow * DA + h * HD, Kg + ((size_t)b * SEQ + sk) * DA + h * HD, HD) + BT[j]; o += exp2f(sc - mx) * bf2f(Vg[((size_t)b * SEQ + sk) * DA + h * HD + dd]); }
                o /= den; fail = fail || bad(bf2f(Og[qrow * DA + h * HD + dd]), o, 3e-2f, 1e-2f); }
        } else {
            const int row = h1 % M, ch = h2 % DB, gg = ch >> 7, i = row & 127; const size_t R0 = (size_t)(row - i);
            const bf16* WSP = (const bf16*)(ws + WS_WSP) + (size_t)gg * 128 * 128;
            float z = args.in[6][gg * 128 + i];
            for (int j = 0; j <= i; ++j) { float s1 = 0.f, s2 = 0.f; for (int k = 0; k < 16; ++k) { const f32x2 t = ((const f32x2*)(ws + WS_VSTAT))[(R0 + j) * 16 + k]; s1 += t.x; s2 += t.y; }
                const float mean = s1 / DB, var = fmaxf(s2 / DB - mean * mean, 0.f), rstd = 1.0f / sqrtf(var + LN_EPS);
                const float vn = (bf2f(((const bf16*)(ws + WS_VB))[(R0 + j) * DB + ch]) - mean) * rstd * args.in[3][ch] + args.in[4][ch];
                z += bf2f(WSP[i * 128 + j]) * bf2f((bf16)f2bf(vn)); }
            const float ex = z * bf2f(((const bf16*)(ws + WS_U))[(size_t)row * DB + ch]);
            fail = bad(bf2f(((const bf16*)(ws + WS_AG))[(size_t)row * 2048 + 1024 + ch]), ex, 2e-2f, 1e-2f);
        }
    } else if (stage == 3) {
        const int row = h1 % M, col = h2 % DA, h = col >> 7; const float* LSE = (const float*)(ws + WS_LSE);
        const float l0 = LSE[((size_t)0 * M + row) * NH + h], l1 = LSE[((size_t)1 * M + row) * NH + h], l2 = LSE[((size_t)2 * M + row) * NH + h], mx = fmaxf(l0, fmaxf(l1, l2));
        const float w0 = exp2f(l0 - mx), w1 = exp2f(l1 - mx), w2 = exp2f(l2 - mx);
        const float ex = (w0 * bf2f(((const bf16*)(ws + WS_O0))[(size_t)row * DA + col]) + w1 * bf2f(((const bf16*)(ws + WS_O1))[(size_t)row * DA + col]) + w2 * bf2f(((const bf16*)(ws + WS_O2))[(size_t)row * DA + col])) / (w0 + w1 + w2);
        fail = bad(bf2f(((const bf16*)(ws + WS_AG))[(size_t)row * 2048 + col]), ex, 1e-2f, 5e-3f);
    } else if (stage == 4) {
        const int row = h1 % M, col = h2 % DM; const bf16* AG = (const bf16*)(ws + WS_AG) + (size_t)row * 2048; const bf16* Wt = (const bf16*)(ws + WS_WPAB) + (size_t)col * 2048;
        const float ya = dot_bf(AG, Wt, 1024), yb = dot_bf(AG + 1024, Wt + 1024, 1024);
        const float ga = bf2f(((const bf16*)(ws + WS_GA))[(size_t)row * 2048 + col]), gb = bf2f(((const bf16*)(ws + WS_GB))[(size_t)row * 2048 + col]);
        const float ex = ya / (1.f + expf(-ga)) + yb / (1.f + expf(-gb));
        fail = bad(bf2f(((const bf16*)(ws + WS_MRG))[(size_t)row * 2048 + col]), ex, 2e-2f, 5e-3f);
    } else if (stage == 5) {
        const int row = h1 % M, col = h2 % DM;
        const float ex = ALPHA * args.in[0][(size_t)row * DM + col] + dot_bf((const bf16*)(ws + WS_MRG) + (size_t)row * 2048, (const bf16*)(ws + WS_WOUT) + (size_t)col * 2048, DM);
        fail = bad(args.out[(size_t)row * DM + col], ex, 2e-3f, 2e-3f);
    } else if (stage == 6 || stage == 9) {
        const float* gain = args.in[stage == 6 ? 10 : 16]; const float* bias = args.in[stage == 6 ? 11 : 17];
        if (gid < 2048) { const int row = h1 % M; float s1 = 0.f, s2 = 0.f;
            for (int c = 0; c < DM; ++c) { const float v = (args.out[(size_t)row * DM + c] - bias[c]) / gain[c]; s1 += v; s2 += v * v; }
            const float mean = s1 / DM, var = s2 / DM - mean * mean; fail = (fabsf(mean) > 2e-3f) || (fabsf(var - 1.f) > 1e-2f);
        } else if (stage == 6) {
            const int sel = gid % 3;
            if (sel == 0) { const int row = h1 % M, c = h2 % DM; fail = bad(bf2f(((const bf16*)(ws + WS_HB))[(size_t)row * DM + c]), args.out[(size_t)row * DM + c], 5e-3f, 1e-4f); }
            else if (sel == 1) { const int n = h1 % DFF, k = h2 % DM; fail = ((const bf16*)(ws + WS_W1))[(size_t)n * DM + k] != (bf16)f2bf(args.in[12][(size_t)k * DFF + n]); }
            else { const int n = h1 % DM, k = h2 % DFF; fail = ((const bf16*)(ws + WS_W2))[(size_t)n * DFF + k] != (bf16)f2bf(args.in[14][(size_t)k * DM + n]); }
        }
    } else if (stage == 7) {
        const int row = h1 % M, col = h2 % DFF;
        const float v = dot_bf((const bf16*)(ws + WS_HB) + (size_t)row * DM, (const bf16*)(ws + WS_W1) + (size_t)col * DM, DM) + args.in[13][col]; const float r = fmaxf(v, 0.f);
        fail = bad(bf2f(((const bf16*)(ws + WS_ACT))[(size_t)row * DFF + col]), r * r, 2e-2f, 5e-3f);
    } else if (stage == 8) {
        const int row = h1 % M, col = h2 % DM;
        const float ex = ALPHA * bf2f(((const bf16*)(ws + WS_HB))[(size_t)row * DM + col]) + dot_bf((const bf16*)(ws + WS_ACT) + (size_t)row * DFF, (const bf16*)(ws + WS_W2) + (size_t)col * DFF, DFF) + args.in[15][col];
        fail = bad(args.out[(size_t)row * DM + col], ex, 5e-3f, 3e-2f);
    }
    if (fail) atomicAdd(flag, 1u);
}
__global__ void mk_report(Args args) {
    const unsigned* flag = (const unsigned*)(args.ws + WS_CTL) + CW_CHK;
    if (threadIdx.x == 0 && blockIdx.x == 0) { for (int s = 0; s < N_PHASES; ++s) if (flag[s] != 0u) { args.out[0] = 1000.0f * (float)(s + 1); break; } }
}
#endif

extern "C" void kernel_launch(void* const* d_in, const int* in_sizes, int n_in, void* d_out, int out_size, void* d_ws, size_t ws_size, hipStream_t stream) {
    static int grid = 0;
    if (grid == 0) {
        if (n_in != 18 || in_sizes[0] != M * DM || out_size != M * DM || ws_size < WS_END) { fprintf(stderr, "kernel_launch: unexpected shapes (n_in %d, in0 %d, out %d, ws %zu); nothing launched\n", n_in, n_in > 0 ? in_sizes[0] : -1, out_size, ws_size); grid = -1; return; }
        int dev = 0, cus = 0, per_cu = 0;
        if (hipGetDevice(&dev) != hipSuccess || hipDeviceGetAttribute(&cus, hipDeviceAttributeMultiprocessorCount, dev) != hipSuccess) { grid = -1; return; }
        if (hipFuncSetAttribute((const void*)mk_fwd, hipFuncAttributeMaxDynamicSharedMemorySize, LDS_BYTES) != hipSuccess) { fprintf(stderr, "kernel_launch: hipFuncSetAttribute failed\n"); grid = -1; return; }
        if (hipOccupancyMaxActiveBlocksPerMultiprocessor(&per_cu, (const void*)mk_fwd, NWAVES * 64, LDS_BYTES) != hipSuccess || per_cu < 1) { fprintf(stderr, "kernel_launch: occupancy query reports %d blocks per CU\n", per_cu); (void)hipGetLastError(); grid = -1; return; }
        grid = cus;
    }
    if (grid < 0) return;
    (void)hipMemsetAsync((char*)d_ws + WS_CTL, 0, CTL_ZERO_BYTES, stream);
    Args a{};
    for (int i = 0; i < 18; ++i) a.in[i] = (const float*)d_in[i];
    a.out = (float*)d_out; a.ws = (unsigned char*)d_ws;
#if MK_ONE_LAUNCH
    a.ph_lo = 0; a.ph_hi = N_PHASES;
    hipLaunchKernelGGL(mk_fwd, dim3(grid), dim3(NWAVES * 64), LDS_BYTES, stream, a);
#else
    for (int ph = 0; ph < N_PHASES; ++ph) {
        a.ph_lo = ph; a.ph_hi = ph + 1;
        hipLaunchKernelGGL(mk_fwd, dim3(grid), dim3(NWAVES * 64), LDS_BYTES, stream, a);
        if (ph == (MK_REPEAT_PHASE)) hipLaunchKernelGGL(mk_fwd, dim3(grid), dim3(NWAVES * 64), LDS_BYTES, stream, a);
#if MK_DEBUG_CHECKS
        hipLaunchKernelGGL(mk_check, dim3(32), dim3(256), 0, stream, a, ph);
#endif
    }
#if MK_DEBUG_CHECKS
    hipLaunchKernelGGL(mk_report, dim3(1), dim3(64), 0, stream, a);
#endif
#endif
}
```

```cpp
#include <hip/hip_runtime.h>
#include <cstdio>
#include <cstdint>

#ifndef MK_DEBUG_CHECKS
#define MK_DEBUG_CHECKS 0
#endif
#ifndef MK_REPEAT_PHASE
#define MK_REPEAT_PHASE 3
#endif
#ifndef MK_TPROBE
#define MK_TPROBE 0
#endif
#ifndef MK_TPA
#define MK_TPA 0
#endif
#ifndef MK_TPB
#define MK_TPB 4
#endif
#ifndef MK_ONE_LAUNCH
#define MK_ONE_LAUNCH 1
#endif

namespace pg8 {
#define PG8_LAS __attribute__((address_space(3)))
typedef unsigned short bf16_t;
typedef short bf16x8 __attribute__((ext_vector_type(8)));
typedef float f32x4 __attribute__((ext_vector_type(4)));
typedef float f32x2 __attribute__((ext_vector_type(2)));
typedef unsigned u32x4 __attribute__((ext_vector_type(4)));
typedef unsigned u32x2 __attribute__((ext_vector_type(2)));
constexpr int BM = 256, BK = 64, HALF = 128, HTB = HALF * BK * 2, STAGE_BYTES = 8 * HTB, NXCD = 8, WGM = 8;

__host__ __device__ __forceinline__ int lds_byte(int r, int c) { const int st = (r >> 4) * 2 + (c >> 5), rr = r & 15, cc = c & 31, ob = rr * 64 + cc * 2; return st * 1024 + (ob ^ (((ob >> 9) & 1) << 5)); }
__host__ __device__ __forceinline__ void stage_rc(int b, int& R, int& C) { const int st = b / 1024, sb = b % 1024, swz = sb ^ (((sb >> 9) & 1) << 5); R = (st >> 1) * 16 + swz / 64; C = (st & 1) * 32 + (swz % 64) / 2; }
__host__ __device__ __forceinline__ int perm32(int rho) { const int n = rho >> 4, i = rho & 15; return 8 * (i >> 2) + 4 * n + (i & 3); }

struct Unit { int pm, pn, kh; };
struct Gemm { const bf16_t* A; const bf16_t* Bt; int K; int ld; int khstep; };

struct StaticOrder {
    int nM, nN, nwg, G, c;
    __host__ __device__ void init(int M, int N, int G_, int c_) { nM = M / BM; nN = N / BM; nwg = nM * nN; G = G_; c = c_; }
    __host__ __device__ bool next(int i, Unit& u) const {
        const long L = (long)i * G + c; if (L >= nwg) return false;
        int wgid = (int)L; { const int q = nwg / NXCD, r = nwg % NXCD, xcd = wgid % NXCD, off = wgid / NXCD; wgid = (xcd < r ? xcd * (q + 1) : r * (q + 1) + (xcd - r) * q) + off; }
        const int nig = WGM * nN, gid = wgid / nig, fm = gid * WGM, gsz = (nM - fm) < WGM ? (nM - fm) : WGM;
        u.pm = fm + ((wgid % nig) % gsz); u.pn = (wgid % nig) / gsz; u.kh = 0; return true;
    }
};
struct PairOrder {
    StaticOrder so;
    __host__ __device__ bool next(int i, Unit& u) const { if (!so.next(i >> 1, u)) return false; u.kh = i & 1; return true; }
};

__device__ __forceinline__ unsigned cvt_pk_bf16(float lo, float hi) { unsigned r; asm volatile("v_cvt_pk_bf16_f32 %0, %1, %2" : "=v"(r) : "v"(lo), "v"(hi)); return r; }
__device__ __forceinline__ float bf_lo(unsigned w) { return __uint_as_float(w << 16); }
__device__ __forceinline__ float bf_hi(unsigned w) { return __uint_as_float(w & 0xffff0000u); }
__device__ __forceinline__ float fast_exp2(float x) { return __builtin_amdgcn_exp2f(x); }
__device__ __forceinline__ float fast_rcp(float x) { return __builtin_amdgcn_rcpf(x); }
__device__ __forceinline__ float gelu_tanh(float v) {
    const float t = v * (1.0f + 0.044715f * v * v);
    const float e = fast_exp2(t * (-2.0f * 0.7978845608028654f * 1.4426950408889634f));
    return v * fast_rcp(1.0f + e);
}


struct EpiProj {
    static constexpr bool PERM = true, AFTER_DRAIN = false, KEEPS = false;
    bf16_t *Q, *Kb, *V, *U, *VB, *GA, *GB; f32x2* vstat; float qscale;
    __device__ __forceinline__ bool operator()(f32x4 (&acc)[2][2][4][2], const Unit& u, int wr, int wc, int fr, int fq) const {
        const int pn = 35 - u.pn; bf16_t* base; int ldc = 1024, colt, act = 0; float sc = 1.0f;
        if (pn < 4) { base = Q; colt = pn * BM; sc = qscale; }
        else if (pn < 8) { base = Kb; colt = (pn - 4) * BM; }
        else if (pn < 12) { base = V; colt = (pn - 8) * BM; }
        else if (pn < 16) { base = U; colt = (pn - 12) * BM; act = 1; }
        else if (pn < 20) { base = VB; colt = (pn - 16) * BM; act = 2; }
        else if (pn < 28) { base = GA; colt = (pn - 20) * BM; ldc = 2048; }
        else { base = GB; colt = (pn - 28) * BM; ldc = 2048; }
        const int row0 = u.pm * BM + wr * 64 + fr, col0 = colt + wc * 32 + 8 * fq;
        if (pn >= 20) {
            unsigned char* gbase = (unsigned char*)base + ((((size_t)u.pm * 8 + (pn >= 28 ? pn - 28 : pn - 20)) * 8 + (wr * 4 + wc)) * 16) * 512 + (fq * 16 + fr) * 8;
#pragma unroll
            for (int ai = 0; ai < 2; ++ai)
#pragma unroll
                for (int m = 0; m < 4; ++m)
#pragma unroll
                    for (int bj = 0; bj < 2; ++bj) { unsigned q[8];
#pragma unroll
                        for (int e = 0; e < 8; ++e) { const float v = e < 4 ? acc[ai][bj][m][0][e] : acc[ai][bj][m][1][e - 4];
                            q[e] = (unsigned)(255.0f * fast_rcp(1.0f + fast_exp2(v * -1.4426950408889634f)) + 0.5f); }
                        *(u32x2*)(gbase + ((ai * 4 + m) * 2 + bj) * 512) = (u32x2){q[0] | (q[1] << 8) | (q[2] << 16) | (q[3] << 24), q[4] | (q[5] << 8) | (q[6] << 16) | (q[7] << 24)}; }
            return false;
        }
#pragma unroll
        for (int ai = 0; ai < 2; ++ai)
#pragma unroll
            for (int m = 0; m < 4; ++m) {
                const int row = row0 + ai * HALF + m * 16; bf16_t* rowp = base + (size_t)row * ldc + col0; float s1 = 0.f, s2 = 0.f;
#pragma unroll
                for (int bj = 0; bj < 2; ++bj) { f32x4 v0 = acc[ai][bj][m][0], v1 = acc[ai][bj][m][1];
                    if (act != 0) {
#pragma unroll
                        for (int e = 0; e < 4; ++e) { v0[e] = gelu_tanh(v0[e]); v1[e] = gelu_tanh(v1[e]); }
                        s1 += (v0[0] + v0[1]) + (v0[2] + v0[3]) + (v1[0] + v1[1]) + (v1[2] + v1[3]);
                        s2 += (v0[0] * v0[0] + v0[1] * v0[1]) + (v0[2] * v0[2] + v0[3] * v0[3]) + (v1[0] * v1[0] + v1[1] * v1[1]) + (v1[2] * v1[2] + v1[3] * v1[3]);
                    }
                    v0 = v0 * sc; v1 = v1 * sc; u32x4 w; w.x = cvt_pk_bf16(v0[0], v0[1]); w.y = cvt_pk_bf16(v0[2], v0[3]); w.z = cvt_pk_bf16(v1[0], v1[1]); w.w = cvt_pk_bf16(v1[2], v1[3]);
                    *(u32x4*)(rowp + bj * HALF) = w; }
                if (act == 2) {
                    s1 += __shfl_xor(s1, 16); s1 += __shfl_xor(s1, 32); s2 += __shfl_xor(s2, 16); s2 += __shfl_xor(s2, 32);
                    if (fq == 0) vstat[(size_t)row * 16 + (pn - 16) * 4 + wc] = (f32x2){s1, s2};
                }
            }
        return false;
    }
};
struct EpiGate {
    static constexpr bool PERM = true, AFTER_DRAIN = false, KEEPS = true;
    const unsigned char *GA, *GB; bf16_t* O;
    __device__ __forceinline__ bool operator()(f32x4 (&acc)[2][2][4][2], const Unit& u, int wr, int wc, int fr, int fq) const {
        const int row0 = u.pm * BM + wr * 64 + fr, col0 = u.pn * BM + wc * 32 + 8 * fq;
        const size_t goff = ((((size_t)u.pm * 8 + u.pn) * 8 + (wr * 4 + wc)) * 16) * 512 + (fq * 16 + fr) * 8;
        u32x2 gb[16], ga[16];
#pragma unroll
        for (int i = 0; i < 16; ++i) gb[i] = *(const u32x2*)(GB + goff + i * 512);
        if (u.kh == 0) {
#pragma unroll
            for (int i = 0; i < 16; ++i) ga[i] = *(const u32x2*)(GA + goff + i * 512);
        }
#pragma unroll
        for (int ai = 0; ai < 2; ++ai)
#pragma unroll
            for (int m = 0; m < 4; ++m)
#pragma unroll
                for (int bj = 0; bj < 2; ++bj) { const int i = (ai * 4 + m) * 2 + bj; float qb[8];
#pragma unroll
                    for (int e = 0; e < 8; ++e) qb[e] = fmaxf((float)(((e < 4 ? gb[i].x : gb[i].y) >> (8 * (e & 3))) & 255u), 1.0f);
                    if (u.kh == 0) {
#pragma unroll
                        for (int e = 0; e < 8; ++e) { const float r = (float)(((e < 4 ? ga[i].x : ga[i].y) >> (8 * (e & 3))) & 255u) * fast_rcp(qb[e]);
                            if (e < 4) acc[ai][bj][m][0][e] *= r; else acc[ai][bj][m][1][e - 4] *= r; }
                    } else {
                        float o[8];
#pragma unroll
                        for (int e = 0; e < 8; ++e) o[e] = (e < 4 ? acc[ai][bj][m][0][e] : acc[ai][bj][m][1][e - 4]) * (qb[e] * (1.0f / 255.0f));
                        u32x4 w; w.x = cvt_pk_bf16(o[0], o[1]); w.y = cvt_pk_bf16(o[2], o[3]); w.z = cvt_pk_bf16(o[4], o[5]); w.w = cvt_pk_bf16(o[6], o[7]);
                        *(u32x4*)(O + (size_t)(row0 + ai * HALF + m * 16) * 2048 + col0 + bj * HALF) = w;
                    }
                }
        return u.kh == 0;
    }
};
template <int ACT> struct EpiBiasAct {
    static constexpr bool PERM = true, AFTER_DRAIN = false, KEEPS = false;
    bf16_t* O; int ldc; const float* bias;
    __device__ __forceinline__ bool operator()(f32x4 (&acc)[2][2][4][2], const Unit& u, int wr, int wc, int fr, int fq) const {
        const int row0 = u.pm * BM + wr * 64 + fr, col0 = u.pn * BM + wc * 32 + 8 * fq;
        f32x4 bv[2][2];
#pragma unroll
        for (int bj = 0; bj < 2; ++bj)
#pragma unroll
            for (int n = 0; n < 2; ++n) bv[bj][n] = bias ? *(const f32x4*)(bias + col0 + bj * HALF + 4 * n) : (f32x4){0.f, 0.f, 0.f, 0.f};
#pragma unroll
        for (int ai = 0; ai < 2; ++ai)
#pragma unroll
            for (int m = 0; m < 4; ++m) { bf16_t* rowp = O + (size_t)(row0 + ai * HALF + m * 16) * ldc + col0;
#pragma unroll
                for (int bj = 0; bj < 2; ++bj) { f32x4 v0 = acc[ai][bj][m][0] + bv[bj][0], v1 = acc[ai][bj][m][1] + bv[bj][1];
                    if (ACT == 1) {
#pragma unroll
                        for (int e = 0; e < 4; ++e) { const float a = fmaxf(v0[e], 0.f), b = fmaxf(v1[e], 0.f); v0[e] = a * a; v1[e] = b * b; } }
                    u32x4 w; w.x = cvt_pk_bf16(v0[0], v0[1]); w.y = cvt_pk_bf16(v0[2], v0[3]); w.z = cvt_pk_bf16(v1[0], v1[1]); w.w = cvt_pk_bf16(v1[2], v1[3]);
                    *(u32x4*)(rowp + bj * HALF) = w; } }
        return false;
    }
};
struct EpiResF32 {
    static constexpr bool PERM = false, AFTER_DRAIN = false, KEEPS = false;
    const float* base; float* out; const float* bias; float alpha;
    __device__ __forceinline__ bool operator()(f32x4 (&acc)[2][2][4][2], const Unit& u, int wr, int wc, int fr, int fq) const {
        const int row0 = u.pm * BM + wr * 64 + fr, col0 = u.pn * BM + wc * 32 + 4 * fq;
        f32x4 bv[2][2];
#pragma unroll
        for (int bj = 0; bj < 2; ++bj)
#pragma unroll
            for (int n = 0; n < 2; ++n) bv[bj][n] = bias ? *(const f32x4*)(bias + col0 + bj * HALF + n * 16) : (f32x4){0.f, 0.f, 0.f, 0.f};
#pragma unroll
        for (int ai = 0; ai < 2; ++ai)
#pragma unroll
            for (int m = 0; m < 4; ++m) { const size_t off = (size_t)(row0 + ai * HALF + m * 16) * 2048 + col0;
#pragma unroll
                for (int bj = 0; bj < 2; ++bj)
#pragma unroll
                    for (int n = 0; n < 2; ++n) { const f32x4 bs = *(const f32x4*)(base + off + bj * HALF + n * 16);
                        *(f32x4*)(out + off + bj * HALF + n * 16) = bs * alpha + (acc[ai][bj][m][n] + bv[bj][n]); }
                if (m & 1) asm volatile("" ::: "memory"); }
        return false;
    }
};

template <class Epi, class Sched, bool ALIGN_EPI = false>
__device__ __forceinline__ void gemm_phase(PG8_LAS unsigned char* lds, const Gemm g, const Sched& S, const Epi& E) {
    const int tid = threadIdx.x, wid = __builtin_amdgcn_readfirstlane(tid >> 6), lane = tid & 63, wr = wid >> 2, wc = wid & 3, fr = lane & 15, fq = lane >> 4;
    const int K = g.K, nt = K / BK, ld = g.ld;
    unsigned voffA[2], voffB[2];
#pragma unroll
    for (int i = 0; i < 2; ++i) { int R, C; stage_rc(tid * 16 + i * 8192, R, C); const int Rb = Epi::PERM ? ((R & ~31) + perm32(R & 31)) : R;
        voffA[i] = (unsigned)(R * ld + C) * 2u; voffB[i] = (unsigned)(Rb * ld + C) * 2u; }
    const size_t kstep = (size_t)(BK * 2);
    const size_t hstep = (size_t)HALF * ld * 2;
    const size_t tstep = 2 * hstep;
    const unsigned ldsw = (unsigned)wid * 1024u;
    const int aoff = lds_byte(wr * 64 + fr, fq * 8), boff = lds_byte(wc * 32 + fr, fq * 8);
#define PG8_SA(b, h) (((b) * 2 + (h)) * HTB)
#define PG8_SB(b, h) ((4 + (b) * 2 + (h)) * HTB)
#define PG8_STAGE(bufoff, gbase, voff) do { _Pragma("unroll") for (int _i = 0; _i < 2; ++_i) \
        __builtin_amdgcn_global_load_lds((const unsigned*)((const char*)(gbase) + (voff)[_i]), (PG8_LAS unsigned*)(lds + (bufoff) + ldsw + _i * 8192), 16, 0, 0); } while (0)
#define PG8_LDA(dst, b, h) do { _Pragma("unroll") for (int m = 0; m < 4; ++m) _Pragma("unroll") for (int k = 0; k < 2; ++k) dst[m][k] = *(const PG8_LAS bf16x8*)(lds + PG8_SA(b, h) + aoff + m * 2048 + k * 1024); } while (0)
#define PG8_LDB(dst, b, h) do { _Pragma("unroll") for (int n = 0; n < 2; ++n) _Pragma("unroll") for (int k = 0; k < 2; ++k) dst[n][k] = *(const PG8_LAS bf16x8*)(lds + PG8_SB(b, h) + boff + n * 2048 + k * 1024); } while (0)
#define PG8_MMA(ai, bj, At, Bt) do { __builtin_amdgcn_s_setprio(1); _Pragma("unroll") for (int m = 0; m < 4; ++m) _Pragma("unroll") for (int n = 0; n < 2; ++n) _Pragma("unroll") for (int k = 0; k < 2; ++k) \
        acc[ai][bj][m][n] = __builtin_amdgcn_mfma_f32_16x16x32_bf16(Bt[n][k], At[m][k], acc[ai][bj][m][n], 0, 0, 0); __builtin_amdgcn_s_setprio(0); } while (0)
#define PG8_WAIT_V(n) asm volatile("s_waitcnt vmcnt(" #n ")" ::: "memory")
#define PG8_WAIT_L(n) asm volatile("s_waitcnt lgkmcnt(" #n ")" ::: "memory")
#define PG8_BAR __builtin_amdgcn_s_barrier()
#define PG8_SCHED __builtin_amdgcn_sched_barrier(0)
    Unit cur, nxt; int ui = 0;
    if (!S.next(0, cur)) return;
    f32x4 acc[2][2][4][2];
#pragma unroll
    for (int a = 0; a < 2; ++a)
#pragma unroll
        for (int b = 0; b < 2; ++b)
#pragma unroll
            for (int m = 0; m < 4; ++m)
#pragma unroll
                for (int n = 0; n < 2; ++n) acc[a][b][m][n] = (f32x4){0.f, 0.f, 0.f, 0.f};
    bf16x8 At[4][2], B0[2][2], B1[2][2];
    const char* cA = (const char*)g.A + (size_t)cur.pm * tstep + (size_t)cur.kh * g.khstep; const char* cB = (const char*)g.Bt + (size_t)cur.pn * tstep + (size_t)cur.kh * g.khstep;
    PG8_STAGE(PG8_SB(0, 0), cB, voffB); PG8_STAGE(PG8_SB(0, 1), cB + hstep, voffB); PG8_STAGE(PG8_SA(0, 0), cA, voffA); PG8_STAGE(PG8_SA(0, 1), cA + hstep, voffA);
    if (wr == 1) PG8_BAR;
    PG8_WAIT_V(2); PG8_BAR;
    PG8_STAGE(PG8_SB(1, 0), cB + kstep, voffB); PG8_STAGE(PG8_SA(1, 0), cA + kstep, voffA); PG8_STAGE(PG8_SB(1, 1), cB + hstep + kstep, voffB);
    PG8_WAIT_V(6); PG8_BAR;
    for (;;) {
        const bool has_next = S.next(ui + 1, nxt);
        const char* nA = has_next ? (const char*)g.A + (size_t)nxt.pm * tstep + (size_t)nxt.kh * g.khstep : cA; const char* nB = has_next ? (const char*)g.Bt + (size_t)nxt.pn * tstep + (size_t)nxt.kh * g.khstep : cB;
        for (int t = 0; t < nt; t += 2) {
            const bool last = (t == nt - 2);
            const char* a1 = cA + (size_t)(t + 1) * kstep;
            const char* a2 = last ? nA : cA + (size_t)(t + 2) * kstep; const char* b2 = last ? nB : cB + (size_t)(t + 2) * kstep;
            const char* a3 = a2 + kstep; const char* b3 = b2 + kstep;
            PG8_LDB(B0, 0, 0); PG8_LDB(B1, 0, 1); PG8_SCHED; PG8_LDA(At, 0, 0); PG8_STAGE(PG8_SA(1, 1), a1 + hstep, voffA);
            PG8_WAIT_V(8); PG8_WAIT_L(0); PG8_BAR; PG8_MMA(0, 0, At, B0); PG8_MMA(0, 1, At, B1); PG8_BAR; PG8_SCHED;
            PG8_LDA(At, 0, 1); PG8_STAGE(PG8_SB(0, 0), b2, voffB); PG8_STAGE(PG8_SB(0, 1), b2 + hstep, voffB); PG8_STAGE(PG8_SA(0, 0), a2, voffA);
            PG8_WAIT_V(8); PG8_WAIT_L(0); PG8_BAR; PG8_MMA(1, 0, At, B0); PG8_MMA(1, 1, At, B1); PG8_BAR; PG8_SCHED;
            PG8_LDB(B0, 1, 0); PG8_LDB(B1, 1, 1); PG8_SCHED; PG8_LDA(At, 1, 0); PG8_STAGE(PG8_SA(0, 1), a2 + hstep, voffA);
            PG8_WAIT_V(8); PG8_WAIT_L(0); PG8_BAR; PG8_MMA(0, 0, At, B0); PG8_MMA(0, 1, At, B1); PG8_BAR; PG8_SCHED;
            PG8_LDA(At, 1, 1); PG8_STAGE(PG8_SB(1, 0), b3, voffB); PG8_STAGE(PG8_SB(1, 1), b3 + hstep, voffB); PG8_STAGE(PG8_SA(1, 0), a3, voffA);
            PG8_WAIT_V(8); PG8_WAIT_L(0); PG8_BAR; PG8_MMA(1, 0, At, B0); PG8_MMA(1, 1, At, B1); PG8_BAR; PG8_SCHED;
        }
        if constexpr (ALIGN_EPI) { if (wr == 0) PG8_BAR; }
        const bool keep = E(acc, cur, wr, wc, fr, fq);
        if (!has_next) break;
        if (!(Epi::KEEPS && keep)) {
#pragma unroll
            for (int a = 0; a < 2; ++a)
#pragma unroll
                for (int b = 0; b < 2; ++b)
#pragma unroll
                    for (int m = 0; m < 4; ++m)
#pragma unroll
                        for (int n = 0; n < 2; ++n) acc[a][b][m][n] = (f32x4){0.f, 0.f, 0.f, 0.f};
        }
        cur = nxt; cA = nA; cB = nB; ++ui;
        if constexpr (ALIGN_EPI) { if (wr == 1) PG8_BAR; }
    }
    PG8_WAIT_V(0);
    if constexpr (!ALIGN_EPI) { if (wr == 0) PG8_BAR; }
    PG8_BAR;
#undef PG8_SA
#undef PG8_SB
#undef PG8_STAGE
#undef PG8_LDA
#undef PG8_LDB
#undef PG8_MMA
#undef PG8_WAIT_V
#undef PG8_WAIT_L
#undef PG8_BAR
#undef PG8_SCHED
}
}

constexpr int NWAVES = 8;
constexpr int BATCH = 8, SEQ = 2048, DM = 2048, M = BATCH * SEQ;
constexpr int NH = 8, HD = 128, DA = 1024, DB = 1024, DFF = 8192, DIN = 9216;
constexpr int NPAT = 3;
constexpr float LN_EPS = 1e-5f;
constexpr float ALPHA = 1.189207115002721f;
constexpr float LOG2E = 1.4426950408889634f;
constexpr float QSCALE = 0.08838834764831845f * 1.4426950408889634f;

constexpr size_t MiB = 1u << 20;
constexpr size_t WS_CTL = 0, CTL_ZERO_BYTES = 256 * 1024;
constexpr size_t WS_VSTAT = 1 * MiB;
constexpr size_t WS_LSE = 3 * MiB;
constexpr size_t WS_WSP = 5 * MiB - 512 * 1024;
constexpr size_t WS_BTAB = 5 * MiB - 128 * 1024;
constexpr size_t WS_WIN = 5 * MiB;
constexpr size_t WS_O1 = 5 * MiB;
constexpr size_t WS_WPAB = 41 * MiB;
constexpr size_t WS_WOUT = 49 * MiB;
constexpr size_t WS_W1 = 57 * MiB;
constexpr size_t WS_W2 = 89 * MiB;
constexpr size_t WS_O0 = 57 * MiB, WS_O2 = 89 * MiB;
constexpr size_t WS_XB = 121 * MiB;
constexpr size_t WS_AG = WS_XB, WS_HB = WS_XB;
constexpr size_t WS_Q = 185 * MiB, WS_K = 217 * MiB, WS_V = 249 * MiB, WS_U = 281 * MiB, WS_VB = 313 * MiB;
constexpr size_t WS_GA = 345 * MiB, WS_GB = 409 * MiB;
constexpr size_t WS_MRG = WS_Q;
constexpr size_t WS_ACT = 185 * MiB;
constexpr size_t WS_MIX = WS_V;
constexpr size_t WS_FF = WS_XB;
constexpr size_t WS_END = 473 * MiB;
constexpr int BT_PITCH = 132;
constexpr int CW_BAR = 4096;
constexpr int CW_CHK = 1024;
constexpr int CW_TS = 2048;

constexpr int RING_OFF = 0, RING_BYTES = 131072;
constexpr int LDSCTL_OFF = RING_BYTES, MISC_OFF = LDSCTL_OFF + 320;
constexpr int LDS_BT_OFF = RING_BYTES + 1024;
constexpr int LDS_BYTES = 147456;

#define GAS __attribute__((address_space(1)))
#define LAS __attribute__((address_space(3)))
typedef unsigned short bf16;
typedef unsigned v4u __attribute__((ext_vector_type(4)));
typedef unsigned v2u __attribute__((ext_vector_type(2)));
typedef float f32x4 __attribute__((ext_vector_type(4)));
typedef float f32x2 __attribute__((ext_vector_type(2)));
typedef short bf16x8 __attribute__((ext_vector_type(8)));
typedef short s16x4 __attribute__((ext_vector_type(4)));
typedef GAS unsigned gu32;
#define RLX_AGENT __ATOMIC_RELAXED, __HIP_MEMORY_SCOPE_AGENT
#define LDS_WAIT() asm volatile("s_waitcnt lgkmcnt(0)" ::: "memory")
#define VM_WAIT() asm volatile("s_waitcnt vmcnt(0)" ::: "memory")
__device__ __forceinline__ unsigned f2bf(float f) { unsigned u = __builtin_bit_cast(unsigned, f); return (u + 0x7fffu + ((u >> 16) & 1u)) >> 16; }
__device__ __forceinline__ unsigned pk2(float lo, float hi) { return f2bf(lo) | (f2bf(hi) << 16); }
__device__ __forceinline__ float bf2f(bf16 v) { return __uint_as_float((unsigned)v << 16); }

#define XB_TMO      128
#define XB_XCNT(j)  (256  + 64 * (j))
#define XB_XSUB(j)  (1280 + 64 * (j))
#define XB_XGEN(j)  (2304 + 64 * (j))
#define XB_TOP      3328
#define XB_TOPGEN   3392
#define XCD_BAR_WORDS 3456
#define XB_SPIN_CAP (1u << 22)
__device__ __forceinline__ unsigned xb_ld(unsigned* p)              { return __hip_atomic_load(p, __ATOMIC_RELAXED, __HIP_MEMORY_SCOPE_AGENT); }
__device__ __forceinline__ unsigned xb_add(unsigned* p, unsigned v) { return __hip_atomic_fetch_add(p, v, __ATOMIC_RELAXED, __HIP_MEMORY_SCOPE_AGENT); }
__device__ __forceinline__ unsigned xb_xcc_id() { return (unsigned)__builtin_amdgcn_s_getreg((3 << 11) | 20) & 0xFu; }
#define XB_SPIN(cond, bar) do { unsigned _sp = 0; while (cond) { __builtin_amdgcn_s_sleep(1); \
    if ((++_sp & 255u) == 0u) { if (xb_ld(&(bar)[XB_TMO])) break; if (_sp > XB_SPIN_CAP) { atomicAdd(&(bar)[XB_TMO], 1u); break; } } } } while (0)
struct XcdBarrier { unsigned* bar; unsigned x; volatile LAS unsigned* st; };
__device__ __forceinline__ XcdBarrier xcd_barrier_post(unsigned* bar, volatile LAS unsigned* st) {
    XcdBarrier b; b.bar = bar; b.x = xb_xcc_id(); b.st = st;
    if (threadIdx.x == 0) (void)xb_add(&bar[XB_XCNT(b.x)], 1u);
    return b;
}
__device__ __forceinline__ void xcd_barrier_complete(unsigned* bar, unsigned x, unsigned& nloc, unsigned& nx) {
    const unsigned G = gridDim.x * gridDim.y * gridDim.z;
    unsigned sum, cnt, mine, sp = 0u;
    for (;;) {
        sum = 0u; cnt = 0u; mine = 0u;
#pragma unroll
        for (unsigned j = 0; j < 16; ++j) { const unsigned c = xb_ld(&bar[XB_XCNT(j)]); sum += c; cnt += (c > 0u) ? 1u : 0u; mine = (j == x) ? c : mine; }
        if (sum == G) break;
        __builtin_amdgcn_s_sleep(1);
        if ((++sp & 255u) == 0u) { if (xb_ld(&bar[XB_TMO])) break; if (sp > XB_SPIN_CAP) { atomicAdd(&bar[XB_TMO], 1u); break; } }
    }
    nloc = mine > 0u ? mine : 1u; nx = cnt > 0u ? cnt : 1u;
}
__device__ __forceinline__ void xcd_barrier(const XcdBarrier& b) {
    asm volatile("s_waitcnt vmcnt(0)" ::: "memory");
    __syncthreads();
    if (threadIdx.x == 0) {
        unsigned* bar = b.bar;
        __builtin_amdgcn_s_waitcnt(0);
        unsigned nloc = b.st[0], nx = b.st[1];
        if (nloc == 0u) { xcd_barrier_complete(bar, b.x, nloc, nx); b.st[0] = nloc; b.st[1] = nx; }
        const unsigned old = xb_add(&bar[XB_XSUB(b.x)], 1u);
        const unsigned gen = old / nloc;
        if (old + 1u == (gen + 1u) * nloc) {
            __builtin_amdgcn_fence(__ATOMIC_RELEASE, "agent");
            asm volatile("s_waitcnt vmcnt(0)" ::: "memory");
            const unsigned og = xb_add(&bar[XB_TOP], 1u);
            const unsigned tg = og / nx;
            if (og + 1u == (tg + 1u) * nx) xb_add(&bar[XB_TOPGEN], 1u);
            else XB_SPIN(xb_ld(&bar[XB_TOPGEN]) == tg, bar);
            __builtin_amdgcn_fence(__ATOMIC_ACQUIRE, "agent");
            xb_add(&bar[XB_XGEN(b.x)], 1u);
            asm volatile("s_waitcnt vmcnt(0)" ::: "memory");
        } else {
            XB_SPIN(xb_ld(&bar[XB_XGEN(b.x)]) == gen, bar);
            __builtin_amdgcn_fence(__ATOMIC_ACQUIRE, "agent");
            asm volatile("s_waitcnt vmcnt(0)" ::: "memory");
        }
    }
    __syncthreads();
}

struct Args { const float* in[18]; float* out; unsigned char* ws; int ph_lo, ph_hi; };
struct Frame {
    LAS unsigned char* lds;
    int tid, lane, wave, G, bid;
    const float* const* in; float* out; unsigned char* ws;
};
__device__ __forceinline__ float wave_sum(float v) {
#pragma unroll
    for (int o = 1; o < 64; o <<= 1) v += __shfl_xor(v, o);
    return v;
}

struct TrItem { const float* W; bf16* WT; int N, ldt, koff, k0, n0, n0d; };
__device__ __forceinline__ TrItem tr_decode(const float* const* in, unsigned char* ws, int it) {
    constexpr int I_IN = (DM / 64) * (DIN / 64), I_PA = (DA / 64) * (DM / 64), I_OUT = (DM / 64) * (DM / 64), I_1 = (DM / 64) * (DFF / 64);
    TrItem t; bool rev = false; int r = it;
    if (r < I_IN) { t.W = in[1]; t.N = DIN; t.WT = (bf16*)(ws + WS_WIN); t.ldt = DM; t.koff = 0; rev = true; }
    else if ((r -= I_IN) < I_PA) { t.W = in[7]; t.N = DM; t.WT = (bf16*)(ws + WS_WPAB); t.ldt = 2048; t.koff = 0; }
    else if ((r -= I_PA) < I_PA) { t.W = in[8]; t.N = DM; t.WT = (bf16*)(ws + WS_WPAB); t.ldt = 2048; t.koff = 1024; }
    else if ((r -= I_PA) < I_OUT) { t.W = in[9]; t.N = DM; t.WT = (bf16*)(ws + WS_WOUT); t.ldt = 2048; t.koff = 0; }
    else if ((r -= I_OUT) < I_1) { t.W = in[12]; t.N = DFF; t.WT = (bf16*)(ws + WS_W1); t.ldt = DM; t.koff = 0; }
    else { r -= I_1; t.W = in[14]; t.N = DM; t.WT = (bf16*)(ws + WS_W2); t.ldt = DFF; t.koff = 0; }
    const int nblk = t.N / 64, sub = r & 7, grp = r >> 3, nb = 2 * (grp % (nblk / 2)) + (sub & 1), kb = 4 * (grp / (nblk / 2)) + (sub >> 1);
    t.k0 = 64 * kb; t.n0 = 64 * nb; t.n0d = rev ? (t.N / 256 - 1 - t.n0 / 256) * 256 + (t.n0 & 255) : t.n0;
    return t;
}
__device__ __forceinline__ void tr_load(const TrItem& t, int lane, f32x4 (&va)[8], f32x4 (&vb)[8]) {
    const int cg = lane & 15, rg = lane >> 4;
#pragma unroll
    for (int i = 0; i < 8; ++i) { const GAS float* src = (const GAS float*)t.W + (size_t)(t.k0 + 8 * i + 2 * rg) * t.N + t.n0 + 4 * cg; va[i] = *(const GAS f32x4*)src; vb[i] = *(const GAS f32x4*)(src + t.N); }
}
__device__ __forceinline__ void tr_store(const TrItem& t, int lane, const f32x4 (&va)[8], const f32x4 (&vb)[8], LAS unsigned* scr) {
    const int cg = lane & 15, rg = lane >> 4;
#pragma unroll
    for (int i = 0; i < 8; ++i) { const int kp = 4 * i + rg;
        scr[(4 * cg + 0) * 33 + kp] = pk2(va[i].x, vb[i].x); scr[(4 * cg + 1) * 33 + kp] = pk2(va[i].y, vb[i].y);
        scr[(4 * cg + 2) * 33 + kp] = pk2(va[i].z, vb[i].z); scr[(4 * cg + 3) * 33 + kp] = pk2(va[i].w, vb[i].w); }
    LDS_WAIT(); asm volatile("" ::: "memory");
    const int c = lane & 7;
#pragma unroll
    for (int j = 0; j < 8; ++j) { const int n = (lane >> 3) + 8 * j; const LAS unsigned* sp = scr + n * 33 + 4 * c;
        v4u o; o.x = sp[0]; o.y = sp[1]; o.z = sp[2]; o.w = sp[3];
        *(GAS v4u*)(t.WT + (size_t)(t.n0d + n) * t.ldt + t.koff + t.k0 + 8 * c) = o; }
    LDS_WAIT(); asm volatile("" ::: "memory");
}
__device__ __forceinline__ int t5_bucket(int n) {
    if (n < 16) return n;
    const float nf = (float)n;
    int large = 16 + (int)(logf(nf / 16.0f) / 4.852030263919617f * 16.0f);
    return large < 31 ? large : 31;
}
__device__ __forceinline__ int pat_dil(int p) { return p == 0 ? 1 : (p == 1 ? 4 : 16); }

__device__ __forceinline__ void phase_prologue(Frame& F) {
    LAS unsigned* scr = (LAS unsigned*)(F.lds + RING_OFF + F.wave * 16384);
    const int gw = F.bid * NWAVES + F.wave, NGW = F.G * NWAVES;
    constexpr int NITEMS = (DM / 64) * (DIN / 64) + 2 * (DA / 64) * (DM / 64) + (DM / 64) * (DM / 64) + 2 * (DM / 64) * (DFF / 64);
    {   f32x4 a0[8], b0[8], a1[8], b1[8];
        TrItem t0 = tr_decode(F.in, F.ws, gw < NITEMS ? gw : 0), t1 = t0;
        if (gw < NITEMS) tr_load(t0, F.lane, a0, b0);
        for (int it = gw; it < NITEMS; it += 2 * NGW) {
            const bool h1 = it + NGW < NITEMS, h2 = it + 2 * NGW < NITEMS;
            if (h1) { t1 = tr_decode(F.in, F.ws, it + NGW); tr_load(t1, F.lane, a1, b1); }
            tr_store(t0, F.lane, a0, b0, scr);
            if (h2) { t0 = tr_decode(F.in, F.ws, it + 2 * NGW); tr_load(t0, F.lane, a0, b0); }
            if (h1) tr_store(t1, F.lane, a1, b1, scr);
        }
    }
    const float* x = F.in[0]; bf16* XB = (bf16*)(F.ws + WS_XB);
    {   f32x4 v0[8], v1[8];
        if (gw < M) {
#pragma unroll
            for (int j = 0; j < 8; ++j) v0[j] = ((const GAS f32x4*)(x + (size_t)gw * DM) + F.lane)[64 * j]; }
        for (int m = gw; m < M; m += 2 * NGW) {
            const bool h1 = m + NGW < M, h2 = m + 2 * NGW < M;
            if (h1) {
#pragma unroll
                for (int j = 0; j < 8; ++j) v1[j] = ((const GAS f32x4*)(x + (size_t)(m + NGW) * DM) + F.lane)[64 * j]; }
            { GAS v2u* o = (GAS v2u*)(XB + (size_t)m * DM) + F.lane;
#pragma unroll
              for (int j = 0; j < 8; ++j) o[64 * j] = (v2u){pk2(v0[j].x, v0[j].y), pk2(v0[j].z, v0[j].w)}; }
            if (h2) {
#pragma unroll
                for (int j = 0; j < 8; ++j) v0[j] = ((const GAS f32x4*)(x + (size_t)(m + 2 * NGW) * DM) + F.lane)[64 * j]; }
            if (h1) { GAS v2u* o = (GAS v2u*)(XB + (size_t)(m + NGW) * DM) + F.lane;
#pragma unroll
              for (int j = 0; j < 8; ++j) o[64 * j] = (v2u){pk2(v1[j].x, v1[j].y), pk2(v1[j].z, v1[j].w)}; }
        }
    }
    const int gt = F.bid * (NWAVES * 64) + F.tid, NGT = F.G * NWAVES * 64;
    const float* wsp = F.in[5]; bf16* WSP = (bf16*)(F.ws + WS_WSP);
    for (int e = gt; e < 8 * 128 * 128; e += NGT) { const int i = (e >> 7) & 127, j = e & 127; WSP[e] = (bf16)(j <= i ? f2bf(wsp[e]) : 0u); }
    const float* rb = F.in[2]; float* BT = (float*)(F.ws + WS_BTAB);
    for (int e = gt; e < NPAT * NH * BT_PITCH; e += NGT) { const int p = e / (NH * BT_PITCH), h = (e / BT_PITCH) % NH, j = e % BT_PITCH;
        BT[e] = (j <= 128) ? rb[t5_bucket(j * pat_dil(p)) * NH + h] * LOG2E : 0.f; }
}
__device__ __forceinline__ void phase_ln(Frame& F, const float* base, const bf16* add, float* outf, const float* gain, const float* bias, bf16* ob) {
    const int gw = F.bid * NWAVES + F.wave, NGW = F.G * NWAVES;
    for (int m = gw; m < M; m += NGW) {
        const GAS f32x4* xr = (const GAS f32x4*)(base + (size_t)m * DM) + F.lane; const GAS v2u* ar = (const GAS v2u*)(add + (size_t)m * DM) + F.lane;
        f32x4 v[8]; float s = 0.f;
#pragma unroll
        for (int j = 0; j < 8; ++j) { const f32x4 x = xr[64 * j]; const v2u a = ar[64 * j];
            v[j] = x * ALPHA + (f32x4){pg8::bf_lo(a.x), pg8::bf_hi(a.x), pg8::bf_lo(a.y), pg8::bf_hi(a.y)}; s += (v[j].x + v[j].y) + (v[j].z + v[j].w); }
        const float mean = wave_sum(s) * (1.f / DM); float s2 = 0.f;
#pragma unroll
        for (int j = 0; j < 8; ++j) { v[j] = v[j] - mean; s2 += (v[j].x * v[j].x + v[j].y * v[j].y) + (v[j].z * v[j].z + v[j].w * v[j].w); }
        const float rstd = 1.f / sqrtf(wave_sum(s2) * (1.f / DM) + LN_EPS);
        GAS f32x4* orow = (GAS f32x4*)(outf + (size_t)m * DM) + F.lane;
#pragma unroll
        for (int j = 0; j < 8; ++j) { const f32x4 g = ((const GAS f32x4*)gain)[64 * j + F.lane], b = ((const GAS f32x4*)bias)[64 * j + F.lane];
            const f32x4 o = v[j] * rstd * g + b; orow[64 * j] = o;
            if (ob) ((GAS v2u*)(ob + (size_t)m * DM))[64 * j + F.lane] = (v2u){pk2(o.x, o.y), pk2(o.z, o.w)}; }
    }
}
__device__ __forceinline__ void phase_combine(Frame& F) {
    const int gw = F.bid * NWAVES + F.wave, NGW = F.G * NWAVES;
    const bf16* O0 = (const bf16*)F.out; const bf16* O1 = O0 + (size_t)M * DA; const bf16* O2 = O1 + (size_t)M * DA;
    const float* LSE = (const float*)(F.ws + WS_LSE); bf16* AG = (bf16*)(F.ws + WS_AG);
    for (int m = gw; m < M; m += NGW) {
        const int h = F.lane >> 3;
        const float l0 = LSE[((size_t)0 * M + m) * NH + h], l1 = LSE[((size_t)1 * M + m) * NH + h], l2 = LSE[((size_t)2 * M + m) * NH + h];
        const float mx = fmaxf(l0, fmaxf(l1, l2)); float w0 = exp2f(l0 - mx), w1 = exp2f(l1 - mx), w2 = exp2f(l2 - mx); const float inv = 1.f / (w0 + w1 + w2); w0 *= inv; w1 *= inv; w2 *= inv;
        const size_t off = (size_t)m * DA + F.lane * 16;
#pragma unroll
        for (int c = 0; c < 2; ++c) {
            const v4u a = *(const GAS v4u*)(O0 + off + c * 8), b = *(const GAS v4u*)(O1 + off + c * 8), d = *(const GAS v4u*)(O2 + off + c * 8); v4u o;
#pragma unroll
            for (int e = 0; e < 4; ++e) { const float lo = w0 * pg8::bf_lo(a[e]) + w1 * pg8::bf_lo(b[e]) + w2 * pg8::bf_lo(d[e]); const float hi = w0 * pg8::bf_hi(a[e]) + w1 * pg8::bf_hi(b[e]) + w2 * pg8::bf_hi(d[e]); o[e] = pk2(lo, hi); }
            *(GAS v4u*)(AG + (size_t)m * 2048 + F.lane * 16 + c * 8) = o;
        }
    }
}

__device__ __forceinline__ s16x4 tr_read(const LAS unsigned char* p) { return __builtin_bit_cast(s16x4, __builtin_amdgcn_ds_read_tr16_b64_v4i16((LAS s16x4*)p)); }
constexpr int ATT_K_OFF = 0, ATT_V_OFF = 65536;

struct AUnit { int b, h, p, d, r, blk; };
__device__ __forceinline__ AUnit aunit(int uid) {
    AUnit u; const int bh = uid / 48, x = uid % 48; u.b = bh >> 3; u.h = bh & 7;
    if (x < 16) { u.p = 0; u.d = 1; u.r = 0; u.blk = x; } else if (x < 32) { u.p = 1; u.d = 4; u.r = (x - 16) >> 2; u.blk = (x - 16) & 3; } else { u.p = 2; u.d = 16; u.r = x - 32; u.blk = 0; }
    return u;
}
__device__ __forceinline__ void attn_units(Frame& F, int vcu, float* Opart) {
    const int tid = F.tid, lane = F.lane, w = F.wave, fr = lane & 15, g = lane >> 4;
    const bf16* Qg = (const bf16*)(F.ws + WS_Q); const bf16* Kg = (const bf16*)(F.ws + WS_K); const bf16* Vg = (const bf16*)(F.ws + WS_V);
    float* LSE = (float*)(F.ws + WS_LSE);
    LAS unsigned char* lds = F.lds;
    LAS float* BTl = (LAS float*)(lds + LDS_BT_OFF);
    constexpr int NU = BATCH * NH * 48;
    for (int e = tid; e < NPAT * NH * BT_PITCH; e += NWAVES * 64) BTl[e] = ((const float*)(F.ws + WS_BTAB))[e];
    v4u kr[8], vr[8]; bf16x8 qn[4];
#define ATT_PREFETCH(U) do { const size_t _rb = (size_t)(U).b * SEQ; const int _lo = ((U).blk == 0) ? 4 : 0; \
        _Pragma("unroll") for (int it = 0; it < 8; ++it) if (it >= _lo) { const int idx = it * 512 + tid, kj = idx >> 4, gr = idx & 15; \
            const size_t row = _rb + (U).r + (U).d * (128 * ((U).blk - 1) + kj); \
            kr[it] = *(const GAS v4u*)(Kg + row * DA + (U).h * HD + gr * 8); vr[it] = *(const GAS v4u*)(Vg + row * DA + (U).h * HD + gr * 8); } \
        const size_t _qrow = _rb + (U).r + (U).d * (128 * (U).blk + 16 * w + fr); \
        _Pragma("unroll") for (int ks = 0; ks < 4; ++ks) qn[ks] = *(const GAS bf16x8*)(Qg + _qrow * DA + (U).h * HD + 32 * ks + 8 * g); } while (0)
    const bool loc = false; const int nsteps = loc ? 12 : (NU - vcu + F.G - 1) / F.G;
#define ATT_UID(t) (loc ? ((((t) / 3) * 16 + (vcu >> 4)) * 48 + ((t) % 3) * 16 + (vcu & 15)) : (vcu + (t) * F.G))
    AUnit cur = aunit(ATT_UID(0));
    if (nsteps > 0) ATT_PREFETCH(cur);
    for (int t = 0; t < nsteps; ++t) {
        const int kt_lo = (cur.blk == 0) ? 8 : 0;
#pragma unroll
        for (int it = 0; it < 8; ++it) if (it * 2 >= kt_lo) {
            const int idx = it * 512 + tid, kj = idx >> 4, gr = idx & 15;
            *(LAS v4u*)(lds + ATT_K_OFF + kj * 256 + ((gr ^ (kj & 15)) << 4)) = kr[it];
            *(LAS v4u*)(lds + ATT_V_OFF + kj * 256 + ((gr ^ ((kj & 7) << 1)) << 4)) = vr[it];
        }
        bf16x8 qf[4];
#pragma unroll
        for (int ks = 0; ks < 4; ++ks) { qf[ks] = qn[ks]; asm volatile("" : "+v"(qf[ks])); }
        LDS_WAIT(); __builtin_amdgcn_s_barrier(); asm volatile("" ::: "memory");
        const AUnit me = cur;
        if (t + 1 < nsteps) { cur = aunit(ATT_UID(t + 1)); ATT_PREFETCH(cur); }
        const int qi = 16 * w + fr;
        const size_t qrow = (size_t)me.b * SEQ + me.r + me.d * (128 * me.blk + qi);
        const LAS float* BTp = BTl + (me.p * NH + me.h) * BT_PITCH;
        f32x4 st[9]; float mx = -1e30f;
#pragma unroll
        for (int t = 0; t < 9; ++t) {
            const int kt = w + t;
            if (kt >= kt_lo) {
                f32x4 a = (f32x4){0.f, 0.f, 0.f, 0.f};
                const int key = 16 * kt + fr;
#pragma unroll
                for (int ks = 0; ks < 4; ++ks) { const bf16x8 kf = *(const LAS bf16x8*)(lds + ATT_K_OFF + key * 256 + (((4 * ks + g) ^ fr) << 4));
                    a = __builtin_amdgcn_mfma_f32_16x16x32_bf16(kf, qf[ks], a, 0, 0, 0); }
#pragma unroll
                for (int e = 0; e < 4; ++e) { const int kj = 16 * kt + 4 * g + e, steps = 128 + qi - kj; const bool ok = (steps >= 0) && (steps <= 128);
                    const float v = ok ? a[e] + BTp[ok ? steps : 0] : -1e30f; a[e] = v; mx = fmaxf(mx, v); }
                st[t] = a;
            } else st[t] = (f32x4){-1e30f, -1e30f, -1e30f, -1e30f};
        }
        mx = fmaxf(mx, __shfl_xor(mx, 16)); mx = fmaxf(mx, __shfl_xor(mx, 32));
        float lsum = 0.f;
#pragma unroll
        for (int t = 0; t < 9; ++t)
#pragma unroll
            for (int e = 0; e < 4; ++e) { const float pv = pg8::fast_exp2(st[t][e] - mx); st[t][e] = pv; lsum += pv; }
        lsum += __shfl_xor(lsum, 16); lsum += __shfl_xor(lsum, 32);
        f32x4 o[8];
#pragma unroll
        for (int mt = 0; mt < 8; ++mt) o[mt] = (f32x4){0.f, 0.f, 0.f, 0.f};
#pragma unroll
        for (int a = 0; a < 5; ++a) {
            const int kt0 = w + 2 * a, kt1 = kt0 + 1; const bool v0 = kt0 >= kt_lo, v1 = (2 * a + 1 <= 8) && (kt1 >= kt_lo);
            if (v0 || v1) {
                v4u pw; pw.x = pg8::cvt_pk_bf16(st[2 * a][0], st[2 * a][1]); pw.y = pg8::cvt_pk_bf16(st[2 * a][2], st[2 * a][3]);
                if (2 * a + 1 <= 8) { pw.z = pg8::cvt_pk_bf16(st[(2 * a + 1 <= 8) ? 2 * a + 1 : 0][0], st[(2 * a + 1 <= 8) ? 2 * a + 1 : 0][1]); pw.w = pg8::cvt_pk_bf16(st[(2 * a + 1 <= 8) ? 2 * a + 1 : 0][2], st[(2 * a + 1 <= 8) ? 2 * a + 1 : 0][3]); }
                else { pw.z = 0u; pw.w = 0u; }
                if (!v0) { pw.x = 0u; pw.y = 0u; }
                if (!v1) { pw.z = 0u; pw.w = 0u; }
                const bf16x8 pf = __builtin_bit_cast(bf16x8, pw);
                const int krow = 4 * g + (fr >> 2), ksw = ((krow & 7) << 1);
                const LAS unsigned char* v0p = lds + ATT_V_OFF + (16 * kt0 + krow) * 256 + ((lane & 1) << 3);
                const LAS unsigned char* v1p = lds + ATT_V_OFF + (16 * kt1 + krow) * 256 + ((lane & 1) << 3);
#pragma unroll
                for (int mt = 0; mt < 8; ++mt) {
                    const int gsw = ((2 * mt + ((lane & 3) >> 1)) ^ ksw) << 4;
                    s16x4 lo = (s16x4){0, 0, 0, 0}, hi = (s16x4){0, 0, 0, 0};
                    if (v0) lo = tr_read(v0p + gsw);
                    if (v1) hi = tr_read(v1p + gsw);
                    const bf16x8 vf = (bf16x8){lo[0], lo[1], lo[2], lo[3], hi[0], hi[1], hi[2], hi[3]};
                    o[mt] = __builtin_amdgcn_mfma_f32_16x16x32_bf16(vf, pf, o[mt], 0, 0, 0);
                }
            }
        }
        const float inv = 1.0f / lsum;
        bf16* orow = (bf16*)Opart + (size_t)me.p * M * DA + qrow * DA + me.h * HD + 4 * g;
#pragma unroll
        for (int mt = 0; mt < 8; ++mt) { const f32x4 v = o[mt] * inv; *(GAS v2u*)(orow + 16 * mt) = (v2u){pg8::cvt_pk_bf16(v[0], v[1]), pg8::cvt_pk_bf16(v[2], v[3])}; }
        if (g == 0) LSE[((size_t)me.p * M + qrow) * NH + me.h] = mx + log2f(lsum);
        LDS_WAIT(); __builtin_amdgcn_s_barrier(); asm volatile("" ::: "memory");
    }
#undef ATT_PREFETCH
#undef ATT_UID
}

__device__ __forceinline__ void gmlp_unit(Frame& F, int uid) {
    const int gg = uid & 7, c = (uid >> 3) & 15, b = uid >> 7;
    const int tid = F.tid, lane = F.lane, w = F.wave, fr = lane & 15, g = lane >> 4;
    LAS unsigned char* lds = F.lds;
    LAS f32x2* STl = (LAS f32x2*)(lds + LDS_BT_OFF);
    const size_t R0 = (size_t)b * SEQ + 128 * c;
    const bf16* VBg = (const bf16*)(F.ws + WS_VB); const bf16* Ug = (const bf16*)(F.ws + WS_U); const bf16* WSP = (const bf16*)(F.ws + WS_WSP) + (size_t)gg * 128 * 128;
    const f32x2* VST = (const f32x2*)(F.ws + WS_VSTAT); bf16* AG = (bf16*)(F.ws + WS_AG);
    const float* gain = F.in[3]; const float* biasv = F.in[4]; const float* bsp = F.in[6];
    const int i = 16 * w + fr, nks = (w >> 1) + 1;
    v4u st8[8];
    if (tid < 128) {
#pragma unroll
        for (int k = 0; k < 8; ++k) st8[k] = *(const GAS v4u*)(VST + (R0 + tid) * 16 + 2 * k);
    }
    v4u raw[4];
#pragma unroll
    for (int it = 0; it < 4; ++it) { const int idx = it * 512 + tid, j = idx >> 4, gr = idx & 15; raw[it] = *(const GAS v4u*)(VBg + (R0 + j) * DB + gg * 128 + gr * 8); }
    const int gr0 = tid & 15;
    const f32x4 g0 = *(const GAS f32x4*)(gain + gg * 128 + gr0 * 8), g1 = *(const GAS f32x4*)(gain + gg * 128 + gr0 * 8 + 4);
    const f32x4 b0 = *(const GAS f32x4*)(biasv + gg * 128 + gr0 * 8), b1 = *(const GAS f32x4*)(biasv + gg * 128 + gr0 * 8 + 4);
    bf16x8 wf[4];
#pragma unroll
    for (int ks = 0; ks < 4; ++ks) wf[ks] = (ks < nks) ? *(const GAS bf16x8*)(WSP + (size_t)i * 128 + 32 * ks + 8 * g) : (bf16x8){0, 0, 0, 0, 0, 0, 0, 0};
    const bf16* urow = Ug + (R0 + i) * DB + gg * 128 + 4 * g;
    v2u uu[8];
#pragma unroll
    for (int mt = 0; mt < 8; ++mt) uu[mt] = *(const GAS v2u*)(urow + 16 * mt);
    const float bs = bsp[gg * 128 + i];
    if (tid < 128) { float s1 = 0.f, s2 = 0.f;
#pragma unroll
        for (int k = 0; k < 8; ++k) { s1 += __uint_as_float(st8[k].x) + __uint_as_float(st8[k].z); s2 += __uint_as_float(st8[k].y) + __uint_as_float(st8[k].w); }
        const float mean = s1 * (1.f / DB), var = fmaxf(s2 * (1.f / DB) - mean * mean, 0.f);
        STl[tid] = (f32x2){mean, 1.0f / sqrtf(var + LN_EPS)}; }
    LDS_WAIT(); __builtin_amdgcn_s_barrier(); asm volatile("" ::: "memory");
#pragma unroll
    for (int it = 0; it < 4; ++it) {
        const int idx = it * 512 + tid, j = idx >> 4, gr = idx & 15;
        const f32x2 st = STl[j]; const v4u r4 = raw[it];
        v4u o;
        o.x = pk2((pg8::bf_lo(r4.x) - st.x) * st.y * g0[0] + b0[0], (pg8::bf_hi(r4.x) - st.x) * st.y * g0[1] + b0[1]);
        o.y = pk2((pg8::bf_lo(r4.y) - st.x) * st.y * g0[2] + b0[2], (pg8::bf_hi(r4.y) - st.x) * st.y * g0[3] + b0[3]);
        o.z = pk2((pg8::bf_lo(r4.z) - st.x) * st.y * g1[0] + b1[0], (pg8::bf_hi(r4.z) - st.x) * st.y * g1[1] + b1[1]);
        o.w = pk2((pg8::bf_lo(r4.w) - st.x) * st.y * g1[2] + b1[2], (pg8::bf_hi(r4.w) - st.x) * st.y * g1[3] + b1[3]);
        *(LAS v4u*)(lds + j * 256 + ((gr ^ ((j & 7) << 1)) << 4)) = o;
    }
    LDS_WAIT(); __builtin_amdgcn_s_barrier(); asm volatile("" ::: "memory");
    f32x4 acc[8];
#pragma unroll
    for (int mt = 0; mt < 8; ++mt) acc[mt] = (f32x4){0.f, 0.f, 0.f, 0.f};
#pragma unroll
    for (int ks = 0; ks < 4; ++ks) if (ks < nks) {
        const int j0 = 32 * ks + 8 * g + (fr >> 2), j1 = j0 + 4;
        const LAS unsigned char* p0 = lds + j0 * 256 + ((lane & 1) << 3); const LAS unsigned char* p1 = lds + j1 * 256 + ((lane & 1) << 3);
        const int s0 = (j0 & 7) << 1, s1 = (j1 & 7) << 1;
#pragma unroll
        for (int mt = 0; mt < 8; ++mt) {
            const int gb = 2 * mt + ((lane & 3) >> 1);
            const s16x4 lo = tr_read(p0 + ((gb ^ s0) << 4)), hi = tr_read(p1 + ((gb ^ s1) << 4));
            const bf16x8 vf = (bf16x8){lo[0], lo[1], lo[2], lo[3], hi[0], hi[1], hi[2], hi[3]};
            acc[mt] = __builtin_amdgcn_mfma_f32_16x16x32_bf16(vf, wf[ks], acc[mt], 0, 0, 0);
        }
    }
    bf16* orow = AG + (R0 + i) * 2048 + 1024 + gg * 128 + 4 * g;
#pragma unroll
    for (int mt = 0; mt < 8; ++mt) {
        const float z0 = (acc[mt][0] + bs) * pg8::bf_lo(uu[mt].x), z1 = (acc[mt][1] + bs) * pg8::bf_hi(uu[mt].x), z2 = (acc[mt][2] + bs) * pg8::bf_lo(uu[mt].y), z3 = (acc[mt][3] + bs) * pg8::bf_hi(uu[mt].y);
        *(GAS v2u*)(orow + 16 * mt) = (v2u){pg8::cvt_pk_bf16(z0, z1), pg8::cvt_pk_bf16(z2, z3)}; }
    LDS_WAIT(); __builtin_amdgcn_s_barrier(); asm volatile("" ::: "memory");
}
__device__ __forceinline__ void phase_attn(Frame& F) {
    const int vcu = (F.G % 8 == 0) ? (F.bid & 7) * (F.G >> 3) + (F.bid >> 3) : F.bid;
    attn_units(F, vcu, F.out);
}
__device__ __forceinline__ void phase_gmlp(Frame& F) {
    for (int u = F.bid; u < BATCH * 16 * 8; u += F.G) gmlp_unit(F, u);
}

constexpr int N_PHASES = 11;
__global__ void __launch_bounds__(NWAVES * 64, 2) mk_fwd(Args args) {
    extern __shared__ __attribute__((aligned(16))) unsigned char lds_raw[];
    Frame F;
    F.lds = (LAS unsigned char*)lds_raw;
    F.tid = threadIdx.x; F.lane = F.tid & 63; F.wave = __builtin_amdgcn_readfirstlane(F.tid >> 6);
    F.G = gridDim.x; F.bid = blockIdx.x; F.in = args.in; F.out = args.out; F.ws = args.ws;
    for (int u = F.tid; u < (LDS_BYTES - LDSCTL_OFF) / 4; u += NWAVES * 64) ((LAS unsigned*)(F.lds + LDSCTL_OFF))[u] = 0u;
    __syncthreads();
    gu32* ctl = (gu32*)(args.ws + WS_CTL);
    const int lo = args.ph_lo, hi = args.ph_hi;
    XcdBarrier bar; bar.bar = (unsigned*)(ctl + CW_BAR); bar.x = 0; bar.st = nullptr;
    if (hi - lo > 1) bar = xcd_barrier_post((unsigned*)(ctl + CW_BAR), (volatile LAS unsigned*)(F.lds + MISC_OFF) + 8);
#define IN(k) (lo <= (k) && (k) < hi)
#define STAMP(k) do { if (MK_TPROBE && F.bid == 0 && F.tid == 0) ((unsigned long long*)(ctl + CW_TS))[k] = __builtin_amdgcn_s_memrealtime(); } while (0)
#define SEAM(k) do { if (IN(k) && IN((k) + 1)) xcd_barrier(bar); STAMP((k) + 1); } while (0)
    STAMP(0);
    unsigned char* ws = args.ws;
    if (IN(0)) { phase_prologue(F); SEAM(0); }
    if (IN(1)) {
        pg8::Gemm g{(const bf16*)(ws + WS_XB), (const bf16*)(ws + WS_WIN), DM, DM, 0}; pg8::StaticOrder S; S.init(M, DIN, F.G, F.bid);
        pg8::EpiProj E{(bf16*)(ws + WS_Q), (bf16*)(ws + WS_K), (bf16*)(ws + WS_V), (bf16*)(ws + WS_U), (bf16*)(ws + WS_VB), (bf16*)(ws + WS_GA), (bf16*)(ws + WS_GB), (pg8::f32x2*)(ws + WS_VSTAT), QSCALE};
        pg8::gemm_phase<pg8::EpiProj, pg8::StaticOrder, true>(F.lds + RING_OFF, g, S, E);
        SEAM(1);
    }
    if (IN(2)) { phase_attn(F); if (MK_TPROBE) SEAM(2); }
    if (IN(3)) { phase_gmlp(F); SEAM(3); }
    if (IN(4)) { phase_combine(F); SEAM(4); }
    if (IN(5)) {
        pg8::Gemm g{(const bf16*)(ws + WS_AG), (const bf16*)(ws + WS_WPAB), 1024, 2048, 2048}; pg8::PairOrder S; S.so.init(M, DM, F.G, F.bid);
        pg8::EpiGate E{(const unsigned char*)(ws + WS_GA), (const unsigned char*)(ws + WS_GB), (bf16*)(ws + WS_MRG)};
        pg8::gemm_phase<pg8::EpiGate, pg8::PairOrder, true>(F.lds + RING_OFF, g, S, E);
        SEAM(5);
    }
    if (IN(6)) {
        pg8::Gemm g{(const bf16*)(ws + WS_MRG), (const bf16*)(ws + WS_WOUT), DM, DM, 0}; pg8::StaticOrder S; S.init(M, DM, F.G, F.bid);
        pg8::EpiBiasAct<0> E{(bf16*)(ws + WS_MIX), DM, nullptr};
        pg8::gemm_phase<pg8::EpiBiasAct<0>, pg8::StaticOrder, true>(F.lds + RING_OFF, g, S, E);
        SEAM(6);
    }
    if (IN(7)) { phase_ln(F, args.in[0], (const bf16*)(ws + WS_MIX), args.out, args.in[10], args.in[11], (bf16*)(ws + WS_HB)); SEAM(7); }
    if (IN(8)) {
        pg8::Gemm g{(const bf16*)(ws + WS_HB), (const bf16*)(ws + WS_W1), DM, DM, 0}; pg8::StaticOrder S; S.init(M, DFF, F.G, F.bid);
        pg8::EpiBiasAct<1> E{(bf16*)(ws + WS_ACT), DFF, args.in[13]};
        pg8::gemm_phase<pg8::EpiBiasAct<1>, pg8::StaticOrder, true>(F.lds + RING_OFF, g, S, E);
        SEAM(8);
    }
    if (IN(9)) {
        pg8::Gemm g{(const bf16*)(ws + WS_ACT), (const bf16*)(ws + WS_W2), DFF, DFF, 0}; pg8::StaticOrder S; S.init(M, DM, F.G, F.bid);
        pg8::EpiBiasAct<0> E{(bf16*)(ws + WS_FF), DM, args.in[15]};
        pg8::gemm_phase<pg8::EpiBiasAct<0>, pg8::StaticOrder, true>(F.lds + RING_OFF, g, S, E);
        SEAM(9);
    }
    if (IN(10)) { phase_ln(F, args.out, (const bf16*)(ws + WS_FF), args.out, args.in[16], args.in[17], nullptr); }
#if MK_TPROBE
    if (hi - lo > 1) {
        xcd_barrier(bar); STAMP(11);
        if (F.bid == 0 && F.tid == 0) {
            const unsigned long long* ts = (const unsigned long long*)(ctl + CW_TS);
            const unsigned long long dt = (ts[MK_TPA + 1] - ts[MK_TPA]) * (unsigned long long)(MK_TPB), t0 = __builtin_amdgcn_s_memrealtime();
            while (__builtin_amdgcn_s_memrealtime() - t0 < dt) __builtin_amdgcn_s_sleep(20);
        }
    }
#endif
#undef IN
#undef SEAM
}

#if MK_DEBUG_CHECKS
__device__ __forceinline__ unsigned hsh(unsigned x) { x ^= x >> 16; x *= 0x7feb352dU; x ^= x >> 15; x *= 0x846ca68bU; x ^= x >> 16; return x; }
__device__ float dot_bf(const bf16* a, const bf16* b, int K) { float s = 0.f; for (int k = 0; k < K; ++k) s += bf2f(a[k]) * bf2f(b[k]); return s; }
__device__ __forceinline__ bool bad(float got, float ex, float rt, float at) { return !(fabsf(got - ex) <= at + rt * fabsf(ex)); }
__device__ float gelu_ref(float v) { return 0.5f * v * (1.0f + tanhf(0.7978845608028654f * (v + 0.044715f * v * v * v))); }
__global__ void mk_check(Args args, int stage) {
    const unsigned gid = blockIdx.x * blockDim.x + threadIdx.x; unsigned char* ws = args.ws; unsigned* flag = (unsigned*)(ws + WS_CTL) + CW_CHK + stage;
    const unsigned h1 = hsh(gid * 2654435761u + 17u * stage + 1u), h2 = hsh(h1 + 0x9e3779b9u), h3 = hsh(h2 + 0x85ebca6bu);
    bool fail = false;
    if (stage == 0) {
        const int sel = gid % 7;
        if (sel == 0) { const int n = h1 % DIN, k = h2 % DM; fail = ((const bf16*)(ws + WS_WIN))[(size_t)n * DM + k] != (bf16)f2bf(args.in[1][(size_t)k * DIN + n]); }
        else if (sel == 1) { const int n = h1 % DM, k = h2 % DA; fail = ((const bf16*)(ws + WS_WPAB))[(size_t)n * 2048 + k] != (bf16)f2bf(args.in[7][(size_t)k * DM + n]); }
        else if (sel == 2) { const int n = h1 % DM, k = h2 % DB; fail = ((const bf16*)(ws + WS_WPAB))[(size_t)n * 2048 + 1024 + k] != (bf16)f2bf(args.in[8][(size_t)k * DM + n]); }
        else if (sel == 3) { const int n = h1 % DM, k = h2 % DM; fail = ((const bf16*)(ws + WS_WOUT))[(size_t)n * DM + k] != (bf16)f2bf(args.in[9][(size_t)k * DM + n]); }
        else if (sel == 4) { const int m = h1 % M, k = h2 % DM; fail = ((const bf16*)(ws + WS_XB))[(size_t)m * DM + k] != (bf16)f2bf(args.in[0][(size_t)m * DM + k]); }
        else if (sel == 5) { const int e = h1 % (8 * 128 * 128), i = (e >> 7) & 127, j = e & 127; fail = ((const bf16*)(ws + WS_WSP))[e] != (bf16)(j <= i ? f2bf(args.in[5][e]) : 0u); }
        else { const int p = h1 % 3, h = h2 % 8, j = h3 % 129; const float ex = args.in[2][t5_bucket(j * pat_dil(p)) * NH + h] * LOG2E; fail = bad(((const float*)(ws + WS_BTAB))[(p * NH + h) * BT_PITCH + j], ex, 1e-5f, 1e-6f); }
    } else if (stage == 1) {
        const int row = h1 % M, col = h2 % DIN;
        if (gid < 7680) {
            const float dv = dot_bf((const bf16*)(ws + WS_XB) + (size_t)row * DM, (const bf16*)(ws + WS_WIN) + (size_t)col * DM, DM);
            float ex, got;
            if (col < 1024) { ex = dv * QSCALE; got = bf2f(((const bf16*)(ws + WS_Q))[(size_t)row * 1024 + col]); }
            else if (col < 2048) { ex = dv; got = bf2f(((const bf16*)(ws + WS_K))[(size_t)row * 1024 + col - 1024]); }
            else if (col < 3072) { ex = dv; got = bf2f(((const bf16*)(ws + WS_V))[(size_t)row * 1024 + col - 2048]); }
            else if (col < 4096) { ex = gelu_ref(dv); got = bf2f(((const bf16*)(ws + WS_U))[(size_t)row * 1024 + col - 3072]); }
            else if (col < 5120) { ex = gelu_ref(dv); got = bf2f(((const bf16*)(ws + WS_VB))[(size_t)row * 1024 + col - 4096]); }
            else if (col < 7168) { ex = dv; got = bf2f(((const bf16*)(ws + WS_GA))[(size_t)row * 2048 + col - 5120]); }
            else { ex = dv; got = bf2f(((const bf16*)(ws + WS_GB))[(size_t)row * 2048 + col - 7168]); }
            fail = bad(got, ex, 1.5e-2f, 1e-2f);
        } else {
            float s1 = 0.f, s2 = 0.f; for (int c = 0; c < 1024; ++c) { const float v = bf2f(((const bf16*)(ws + WS_VB))[(size_t)row * 1024 + c]); s1 += v; s2 += v * v; }
            float t1 = 0.f, t2 = 0.f; for (int k = 0; k < 16; ++k) { const f32x2 t = ((const f32x2*)(ws + WS_VSTAT))[(size_t)row * 16 + k]; t1 += t.x; t2 += t.y; }
            fail = bad(t1, s1, 1e-2f, 1.0f) || bad(t2, s2, 1e-2f, 1.0f);
        }
    } else if (stage == 2) {
        if (gid < 6144) {
            const int b = h1 % BATCH, s = h2 % SEQ, h = h3 % NH, p = (h3 >> 8) % 3, d = pat_dil(p);
            const bf16* Qg = (const bf16*)(ws + WS_Q); const bf16* Kg = (const bf16*)(ws + WS_K); const bf16* Vg = (const bf16*)(ws + WS_V);
            const bf16* Og = (const bf16*)(ws + (p == 0 ? WS_O0 : (p == 1 ? WS_O1 : WS_O2))); const float* BT = (const float*)(ws + WS_BTAB) + (p * NH + h) * BT_PITCH;
            const size_t qrow = (size_t)b * SEQ + s; float mx = -1e30f;
            for (int j = 0; j <= 128; ++j) { const int sk = s - j * d; if (sk < 0) break; const float sc = dot_bf(Qg + qrow * DA + h * HD, Kg + ((size_t)b * SEQ + sk) * DA + h * HD, HD) + BT[j]; mx = fmaxf(mx, sc); }
            float den = 0.f; for (int j = 0; j <= 128; ++j) { const int sk = s - j * d; if (sk < 0) break; const float sc = dot_bf(Qg + qrow * DA + h * HD, Kg + ((size_t)b * SEQ + sk) * DA + h * HD, HD) + BT[j]; den += exp2f(sc - mx); }
            const float l2 = mx + log2f(den);
            fail = bad(((const float*)(ws + WS_LSE))[((size_t)p * M + qrow) * NH + h], l2, 2e-3f, 2e-2f);
            for (int dd = 0; dd < HD; dd += 7) { float o = 0.f;
                for (int j = 0; j <= 128; ++j) { const int sk = s - j * d; if (sk < 0) break; const float sc = dot_bf(Qg + qrow * DA + h * HD, Kg + ((size_t)b * SEQ + sk) * DA + h * HD, HD) + BT[j]; o += exp2f(sc - mx) * bf2f(Vg[((size_t)b * SEQ + sk) * DA + h * HD + dd]); }
                o /= den; fail = fail || bad(bf2f(Og[qrow * DA + h * HD + dd]), o, 3e-2f, 1e-2f); }
        } else {
            const int row = h1 % M, ch = h2 % DB, gg = ch >> 7, i = row & 127; const size_t R0 = (size_t)(row - i);
            const bf16* WSP = (const bf16*)(ws + WS_WSP) + (size_t)gg * 128 * 128;
            float z = args.in[6][gg * 128 + i];
            for (int j = 0; j <= i; ++j) { float s1 = 0.f, s2 = 0.f; for (int k = 0; k < 16; ++k) { const f32x2 t = ((const f32x2*)(ws + WS_VSTAT))[(R0 + j) * 16 + k]; s1 += t.x; s2 += t.y; }
                const float mean = s1 / DB, var = fmaxf(s2 / DB - mean * mean, 0.f), rstd = 1.0f / sqrtf(var + LN_EPS);
                const float vn = (bf2f(((const bf16*)(ws + WS_VB))[(R0 + j) * DB + ch]) - mean) * rstd * args.in[3][ch] + args.in[4][ch];
                z += bf2f(WSP[i * 128 + j]) * bf2f((bf16)f2bf(vn)); }
            const float ex = z * bf2f(((const bf16*)(ws + WS_U))[(size_t)row * DB + ch]);
            fail = bad(bf2f(((const bf16*)(ws + WS_AG))[(size_t)row * 2048 + 1024 + ch]), ex, 2e-2f, 1e-2f);
        }
    } else if (stage == 3) {
        const int row = h1 % M, col = h2 % DA, h = col >> 7; const float* LSE = (const float*)(ws + WS_LSE);
        const float l0 = LSE[((size_t)0 * M + row) * NH + h], l1 = LSE[((size_t)1 * M + row) * NH + h], l2 = LSE[((size_t)2 * M + row) * NH + h], mx = fmaxf(l0, fmaxf(l1, l2));
        const float w0 = exp2f(l0 - mx), w1 = exp2f(l1 - mx), w2 = exp2f(l2 - mx);
        const float ex = (w0 * bf2f(((const bf16*)(ws + WS_O0))[(size_t)row * DA + col]) + w1 * bf2f(((const bf16*)(ws + WS_O1))[(size_t)row * DA + col]) + w2 * bf2f(((const bf16*)(ws + WS_O2))[(size_t)row * DA + col])) / (w0 + w1 + w2);
        fail = bad(bf2f(((const bf16*)(ws + WS_AG))[(size_t)row * 2048 + col]), ex, 1e-2f, 5e-3f);
    } else if (stage == 4) {
        const int row = h1 % M, col = h2 % DM; const bf16* AG = (const bf16*)(ws + WS_AG) + (size_t)row * 2048; const bf16* Wt = (const bf16*)(ws + WS_WPAB) + (size_t)col * 2048;
        const float ya = dot_bf(AG, Wt, 1024), yb = dot_bf(AG + 1024, Wt + 1024, 1024);
        const float ga = bf2f(((const bf16*)(ws + WS_GA))[(size_t)row * 2048 + col]), gb = bf2f(((const bf16*)(ws + WS_GB))[(size_t)row * 2048 + col]);
        const float ex = ya / (1.f + expf(-ga)) + yb / (1.f + expf(-gb));
        fail = bad(bf2f(((const bf16*)(ws + WS_MRG))[(size_t)row * 2048 + col]), ex, 2e-2f, 5e-3f);
    } else if (stage == 5) {
        const int row = h1 % M, col = h2 % DM;
        const float ex = ALPHA * args.in[0][(size_t)row * DM + col] + dot_bf((const bf16*)(ws + WS_MRG) + (size_t)row * 2048, (const bf16*)(ws + WS_WOUT) + (size_t)col * 2048, DM);
        fail = bad(args.out[(size_t)row * DM + col], ex, 2e-3f, 2e-3f);
    } else if (stage == 6 || stage == 9) {
        const float* gain = args.in[stage == 6 ? 10 : 16]; const float* bias = args.in[stage == 6 ? 11 : 17];
        if (gid < 2048) { const int row = h1 % M; float s1 = 0.f, s2 = 0.f;
            for (int c = 0; c < DM; ++c) { const float v = (args.out[(size_t)row * DM + c] - bias[c]) / gain[c]; s1 += v; s2 += v * v; }
            const float mean = s1 / DM, var = s2 / DM - mean * mean; fail = (fabsf(mean) > 2e-3f) || (fabsf(var - 1.f) > 1e-2f);
        } else if (stage == 6) {
            const int sel = gid % 3;
            if (sel == 0) { const int row = h1 % M, c = h2 % DM; fail = bad(bf2f(((const bf16*)(ws + WS_HB))[(size_t)row * DM + c]), args.out[(size_t)row * DM + c], 5e-3f, 1e-4f); }
            else if (sel == 1) { const int n = h1 % DFF, k = h2 % DM; fail = ((const bf16*)(ws + WS_W1))[(size_t)n * DM + k] != (bf16)f2bf(args.in[12][(size_t)k * DFF + n]); }
            else { const int n = h1 % DM, k = h2 % DFF; fail = ((const bf16*)(ws + WS_W2))[(size_t)n * DFF + k] != (bf16)f2bf(args.in[14][(size_t)k * DM + n]); }
        }
    } else if (stage == 7) {
        const int row = h1 % M, col = h2 % DFF;
        const float v = dot_bf((const bf16*)(ws + WS_HB) + (size_t)row * DM, (const bf16*)(ws + WS_W1) + (size_t)col * DM, DM) + args.in[13][col]; const float r = fmaxf(v, 0.f);
        fail = bad(bf2f(((const bf16*)(ws + WS_ACT))[(size_t)row * DFF + col]), r * r, 2e-2f, 5e-3f);
    } else if (stage == 8) {
        const int row = h1 % M, col = h2 % DM;
        const float ex = ALPHA * bf2f(((const bf16*)(ws + WS_HB))[(size_t)row * DM + col]) + dot_bf((const bf16*)(ws + WS_ACT) + (size_t)row * DFF, (const bf16*)(ws + WS_W2) + (size_t)col * DFF, DFF) + args.in[15][col];
        fail = bad(args.out[(size_t)row * DM + col], ex, 5e-3f, 3e-2f);
    }
    if (fail) atomicAdd(flag, 1u);
}
__global__ void mk_report(Args args) {
    const unsigned* flag = (const unsigned*)(args.ws + WS_CTL) + CW_CHK;
    if (threadIdx.x == 0 && blockIdx.x == 0) { for (int s = 0; s < N_PHASES; ++s) if (flag[s] != 0u) { args.out[0] = 1000.0f * (float)(s + 1); break; } }
}
#endif

extern "C" void kernel_launch(void* const* d_in, const int* in_sizes, int n_in, void* d_out, int out_size, void* d_ws, size_t ws_size, hipStream_t stream) {
    static int grid = 0;
    if (grid == 0) {
        if (n_in != 18 || in_sizes[0] != M * DM || out_size != M * DM || ws_size < WS_END) { fprintf(stderr, "kernel_launch: unexpected shapes (n_in %d, in0 %d, out %d, ws %zu); nothing launched\n", n_in, n_in > 0 ? in_sizes[0] : -1, out_size, ws_size); grid = -1; return; }
        int dev = 0, cus = 0, per_cu = 0;
        if (hipGetDevice(&dev) != hipSuccess || hipDeviceGetAttribute(&cus, hipDeviceAttributeMultiprocessorCount, dev) != hipSuccess) { grid = -1; return; }
        if (hipFuncSetAttribute((const void*)mk_fwd, hipFuncAttributeMaxDynamicSharedMemorySize, LDS_BYTES) != hipSuccess) { fprintf(stderr, "kernel_launch: hipFuncSetAttribute failed\n"); grid = -1; return; }
        if (hipOccupancyMaxActiveBlocksPerMultiprocessor(&per_cu, (const void*)mk_fwd, NWAVES * 64, LDS_BYTES) != hipSuccess || per_cu < 1) { fprintf(stderr, "kernel_launch: occupancy query reports %d blocks per CU\n", per_cu); (void)hipGetLastError(); grid = -1; return; }
        grid = cus;
    }
    if (grid < 0) return;
    (void)hipMemsetAsync((char*)d_ws + WS_CTL, 0, CTL_ZERO_BYTES, stream);
    Args a{};
    for (int i = 0; i < 18; ++i) a.in[i] = (const float*)d_in[i];
    a.out = (float*)d_out; a.ws = (unsigned char*)d_ws;
#if MK_ONE_LAUNCH
    a.ph_lo = 0; a.ph_hi = N_PHASES;
    hipLaunchKernelGGL(mk_fwd, dim3(grid), dim3(NWAVES * 64), LDS_BYTES, stream, a);
#else
    for (int ph = 0; ph < N_PHASES; ++ph) {
        a.ph_lo = ph; a.ph_hi = ph + 1;
        hipLaunchKernelGGL(mk_fwd, dim3(grid), dim3(NWAVES * 64), LDS_BYTES, stream, a);
        if (ph == (MK_REPEAT_PHASE)) hipLaunchKernelGGL(mk_fwd, dim3(grid), dim3(NWAVES * 64), LDS_BYTES, stream, a);
#if MK_DEBUG_CHECKS
        hipLaunchKernelGGL(mk_check, dim3(32), dim3(256), 0, stream, a, ph);
#endif
    }
#if MK_DEBUG_CHECKS
    hipLaunchKernelGGL(mk_report, dim3(1), dim3(64), 0, stream, a);
#endif
#endif
}
```

```cpp
#include <hip/hip_runtime.h>
#include <cstdio>
#include <cstdint>

#ifndef MK_DEBUG_CHECKS
#define MK_DEBUG_CHECKS 0
#endif
#ifndef MK_REPEAT_PHASE
#define MK_REPEAT_PHASE 3
#endif
#ifndef MK_TPROBE
#define MK_TPROBE 0
#endif
#ifndef MK_TPA
#define MK_TPA 0
#endif
#ifndef MK_TPB
#define MK_TPB 4
#endif
#ifndef MK_ONE_LAUNCH
#define MK_ONE_LAUNCH 1
#endif

namespace pg8 {
#define PG8_LAS __attribute__((address_space(3)))
typedef unsigned short bf16_t;
typedef short bf16x8 __attribute__((ext_vector_type(8)));
typedef float f32x4 __attribute__((ext_vector_type(4)));
typedef float f32x2 __attribute__((ext_vector_type(2)));
typedef unsigned u32x4 __attribute__((ext_vector_type(4)));
typedef unsigned u32x2 __attribute__((ext_vector_type(2)));
constexpr int BM = 256, BK = 64, HALF = 128, HTB = HALF * BK * 2, STAGE_BYTES = 8 * HTB, NXCD = 8, WGM = 8;

__host__ __device__ __forceinline__ int lds_byte(int r, int c) { const int st = (r >> 4) * 2 + (c >> 5), rr = r & 15, cc = c & 31, ob = rr * 64 + cc * 2; return st * 1024 + (ob ^ (((ob >> 9) & 1) << 5)); }
__host__ __device__ __forceinline__ void stage_rc(int b, int& R, int& C) { const int st = b / 1024, sb = b % 1024, swz = sb ^ (((sb >> 9) & 1) << 5); R = (st >> 1) * 16 + swz / 64; C = (st & 1) * 32 + (swz % 64) / 2; }
__host__ __device__ __forceinline__ int perm32(int rho) { const int n = rho >> 4, i = rho & 15; return 8 * (i >> 2) + 4 * n + (i & 3); }

struct Unit { int pm, pn, kh; };
struct Gemm { const bf16_t* A; const bf16_t* Bt; int K; int ld; int khstep; };

struct StaticOrder {
    int nM, nN, nwg, G, c;
    __host__ __device__ void init(int M, int N, int G_, int c_) { nM = M / BM; nN = N / BM; nwg = nM * nN; G = G_; c = c_; }
    __host__ __device__ bool next(int i, Unit& u) const {
        const long L = (long)i * G + c; if (L >= nwg) return false;
        int wgid = (int)L; { const int q = nwg / NXCD, r = nwg % NXCD, xcd = wgid % NXCD, off = wgid / NXCD; wgid = (xcd < r ? xcd * (q + 1) : r * (q + 1) + (xcd - r) * q) + off; }
        const int nig = WGM * nN, gid = wgid / nig, fm = gid * WGM, gsz = (nM - fm) < WGM ? (nM - fm) : WGM;
        u.pm = fm + ((wgid % nig) % gsz); u.pn = (wgid % nig) / gsz; u.kh = 0; return true;
    }
};
struct PairOrder {
    StaticOrder so;
    __host__ __device__ bool next(int i, Unit& u) const { if (!so.next(i >> 1, u)) return false; u.kh = i & 1; return true; }
};

__device__ __forceinline__ unsigned cvt_pk_bf16(float lo, float hi) { unsigned r; asm volatile("v_cvt_pk_bf16_f32 %0, %1, %2" : "=v"(r) : "v"(lo), "v"(hi)); return r; }
__device__ __forceinline__ float bf_lo(unsigned w) { return __uint_as_float(w << 16); }
__device__ __forceinline__ float bf_hi(unsigned w) { return __uint_as_float(w & 0xffff0000u); }
__device__ __forceinline__ float fast_exp2(float x) { return __builtin_amdgcn_exp2f(x); }
__device__ __forceinline__ float fast_rcp(float x) { return __builtin_amdgcn_rcpf(x); }
__device__ __forceinline__ float gelu_tanh(float v) {
    const float t = v * (1.0f + 0.044715f * v * v);
    const float e = fast_exp2(t * (-2.0f * 0.7978845608028654f * 1.4426950408889634f));
    return v * fast_rcp(1.0f + e);
}


struct EpiProj {
    static constexpr bool PERM = true, AFTER_DRAIN = false, KEEPS = false;
    bf16_t *Q, *Kb, *V, *U, *VB, *GA, *GB; f32x2* vstat; float qscale;
    __device__ __forceinline__ bool operator()(f32x4 (&acc)[2][2][4][2], const Unit& u, int wr, int wc, int fr, int fq) const {
        const int pn = 35 - u.pn; bf16_t* base; int ldc = 1024, colt, act = 0; float sc = 1.0f;
        if (pn < 4) { base = Q; colt = pn * BM; sc = qscale; }
        else if (pn < 8) { base = Kb; colt = (pn - 4) * BM; }
        else if (pn < 12) { base = V; colt = (pn - 8) * BM; }
        else if (pn < 16) { base = U; colt = (pn - 12) * BM; act = 1; }
        else if (pn < 20) { base = VB; colt = (pn - 16) * BM; act = 2; }
        else if (pn < 28) { base = GA; colt = (pn - 20) * BM; ldc = 2048; }
        else { base = GB; colt = (pn - 28) * BM; ldc = 2048; }
        const int row0 = u.pm * BM + wr * 64 + fr, col0 = colt + wc * 32 + 8 * fq;
        if (pn >= 20) {
            unsigned char* gbase = (unsigned char*)base + ((((size_t)u.pm * 8 + (pn >= 28 ? pn - 28 : pn - 20)) * 8 + (wr * 4 + wc)) * 16) * 512 + (fq * 16 + fr) * 8;
#pragma unroll
            for (int ai = 0; ai < 2; ++ai)
#pragma unroll
                for (int m = 0; m < 4; ++m)
#pragma unroll
                    for (int bj = 0; bj < 2; ++bj) { unsigned q[8];
#pragma unroll
                        for (int e = 0; e < 8; ++e) { const float v = e < 4 ? acc[ai][bj][m][0][e] : acc[ai][bj][m][1][e - 4];
                            q[e] = (unsigned)(255.0f * fast_rcp(1.0f + fast_exp2(v * -1.4426950408889634f)) + 0.5f); }
                        *(u32x2*)(gbase + ((ai * 4 + m) * 2 + bj) * 512) = (u32x2){q[0] | (q[1] << 8) | (q[2] << 16) | (q[3] << 24), q[4] | (q[5] << 8) | (q[6] << 16) | (q[7] << 24)}; }
            return false;
        }
#pragma unroll
        for (int ai = 0; ai < 2; ++ai)
#pragma unroll
            for (int m = 0; m < 4; ++m) {
                const int row = row0 + ai * HALF + m * 16; bf16_t* rowp = base + (size_t)row * ldc + col0; float s1 = 0.f, s2 = 0.f;
#pragma unroll
                for (int bj = 0; bj < 2; ++bj) { f32x4 v0 = acc[ai][bj][m][0], v1 = acc[ai][bj][m][1];
                    if (act != 0) {
#pragma unroll
                        for (int e = 0; e < 4; ++e) { v0[e] = gelu_tanh(v0[e]); v1[e] = gelu_tanh(v1[e]); }
                        s1 += (v0[0] + v0[1]) + (v0[2] + v0[3]) + (v1[0] + v1[1]) + (v1[2] + v1[3]);
                        s2 += (v0[0] * v0[0] + v0[1] * v0[1]) + (v0[2] * v0[2] + v0[3] * v0[3]) + (v1[0] * v1[0] + v1[1] * v1[1]) + (v1[2] * v1[2] + v1[3] * v1[3]);
                    }
                    v0 = v0 * sc; v1 = v1 * sc; u32x4 w; w.x = cvt_pk_bf16(v0[0], v0[1]); w.y = cvt_pk_bf16(v0[2], v0[3]); w.z = cvt_pk_bf16(v1[0], v1[1]); w.w = cvt_pk_bf16(v1[2], v1[3]);
                    *(u32x4*)(rowp + bj * HALF) = w; }
                if (act == 2) {
                    s1 += __shfl_xor(s1, 16); s1 += __shfl_xor(s1, 32); s2 += __shfl_xor(s2, 16); s2 += __shfl_xor(s2, 32);
                    if (fq == 0) vstat[(size_t)row * 16 + (pn - 16) * 4 + wc] = (f32x2){s1, s2};
                }
            }
        return false;
    }
};
struct EpiGate {
    static constexpr bool PERM = true, AFTER_DRAIN = false, KEEPS = true;
    const unsigned char *GA, *GB; bf16_t* O;
    __device__ __forceinline__ bool operator()(f32x4 (&acc)[2][2][4][2], const Unit& u, int wr, int wc, int fr, int fq) const {
        const int row0 = u.pm * BM + wr * 64 + fr, col0 = u.pn * BM + wc * 32 + 8 * fq;
        const size_t goff = ((((size_t)u.pm * 8 + u.pn) * 8 + (wr * 4 + wc)) * 16) * 512 + (fq * 16 + fr) * 8;
        u32x2 gb[16], ga[16];
#pragma unroll
        for (int i = 0; i < 16; ++i) gb[i] = *(const u32x2*)(GB + goff + i * 512);
        if (u.kh == 0) {
#pragma unroll
            for (int i = 0; i < 16; ++i) ga[i] = *(const u32x2*)(GA + goff + i * 512);
        }
#pragma unroll
        for (int ai = 0; ai < 2; ++ai)
#pragma unroll
            for (int m = 0; m < 4; ++m)
#pragma unroll
                for (int bj = 0; bj < 2; ++bj) { const int i = (ai * 4 + m) * 2 + bj; float qb[8];
#pragma unroll
                    for (int e = 0; e < 8; ++e) qb[e] = fmaxf((float)(((e < 4 ? gb[i].x : gb[i].y) >> (8 * (e & 3))) & 255u), 1.0f);
                    if (u.kh == 0) {
#pragma unroll
                        for (int e = 0; e < 8; ++e) { const float r = (float)(((e < 4 ? ga[i].x : ga[i].y) >> (8 * (e & 3))) & 255u) * fast_rcp(qb[e]);
                            if (e < 4) acc[ai][bj][m][0][e] *= r; else acc[ai][bj][m][1][e - 4] *= r; }
                    } else {
                        float o[8];
#pragma unroll
                        for (int e = 0; e < 8; ++e) o[e] = (e < 4 ? acc[ai][bj][m][0][e] : acc[ai][bj][m][1][e - 4]) * (qb[e] * (1.0f / 255.0f));
                        u32x4 w; w.x = cvt_pk_bf16(o[0], o[1]); w.y = cvt_pk_bf16(o[2], o[3]); w.z = cvt_pk_bf16(o[4], o[5]); w.w = cvt_pk_bf16(o[6], o[7]);
                        *(u32x4*)(O + (size_t)(row0 + ai * HALF + m * 16) * 2048 + col0 + bj * HALF) = w;
                    }
                }
        return u.kh == 0;
    }
};
template <int ACT> struct EpiBiasAct {
    static constexpr bool PERM = true, AFTER_DRAIN = false, KEEPS = false;
    bf16_t* O; int ldc; const float* bias;
    __device__ __forceinline__ bool operator()(f32x4 (&acc)[2][2][4][2], const Unit& u, int wr, int wc, int fr, int fq) const {
        const int row0 = u.pm * BM + wr * 64 + fr, col0 = u.pn * BM + wc * 32 + 8 * fq;
        f32x4 bv[2][2];
#pragma unroll
        for (int bj = 0; bj < 2; ++bj)
#pragma unroll
            for (int n = 0; n < 2; ++n) bv[bj][n] = bias ? *(const f32x4*)(bias + col0 + bj * HALF + 4 * n) : (f32x4){0.f, 0.f, 0.f, 0.f};
#pragma unroll
        for (int ai = 0; ai < 2; ++ai)
#pragma unroll
            for (int m = 0; m < 4; ++m) { bf16_t* rowp = O + (size_t)(row0 + ai * HALF + m * 16) * ldc + col0;
#pragma unroll
                for (int bj = 0; bj < 2; ++bj) { f32x4 v0 = acc[ai][bj][m][0] + bv[bj][0], v1 = acc[ai][bj][m][1] + bv[bj][1];
                    if (ACT == 1) {
#pragma unroll
                        for (int e = 0; e < 4; ++e) { const float a = fmaxf(v0[e], 0.f), b = fmaxf(v1[e], 0.f); v0[e] = a * a; v1[e] = b * b; } }
                    u32x4 w; w.x = cvt_pk_bf16(v0[0], v0[1]); w.y = cvt_pk_bf16(v0[2], v0[3]); w.z = cvt_pk_bf16(v1[0], v1[1]); w.w = cvt_pk_bf16(v1[2], v1[3]);
                    *(u32x4*)(rowp + bj * HALF) = w; } }
        return false;
    }
};
struct EpiResF32 {
    static constexpr bool PERM = false, AFTER_DRAIN = false, KEEPS = false;
    const float* base; float* out; const float* bias; float alpha;
    __device__ __forceinline__ bool operator()(f32x4 (&acc)[2][2][4][2], const Unit& u, int wr, int wc, int fr, int fq) const {
        const int row0 = u.pm * BM + wr * 64 + fr, col0 = u.pn * BM + wc * 32 + 4 * fq;
        f32x4 bv[2][2];
#pragma unroll
        for (int bj = 0; bj < 2; ++bj)
#pragma unroll
            for (int n = 0; n < 2; ++n) bv[bj][n] = bias ? *(const f32x4*)(bias + col0 + bj * HALF + n * 16) : (f32x4){0.f, 0.f, 0.f, 0.f};
#pragma unroll
        for (int ai = 0; ai < 2; ++ai)
#pragma unroll
            for (int m = 0; m < 4; ++m) { const size_t off = (size_t)(row0 + ai * HALF + m * 16) * 2048 + col0;
#pragma unroll
                for (int bj = 0; bj < 2; ++bj)
#pragma unroll
                    for (int n = 0; n < 2; ++n) { const f32x4 bs = *(const f32x4*)(base + off + bj * HALF + n * 16);
                        *(f32x4*)(out + off + bj * HALF + n * 16) = bs * alpha + (acc[ai][bj][m][n] + bv[bj][n]); }
                if (m & 1) asm volatile("" ::: "memory"); }
        return false;
    }
};

template <class Epi, class Sched, bool ALIGN_EPI = false>
__device__ __forceinline__ void gemm_phase(PG8_LAS unsigned char* lds, const Gemm g, const Sched& S, const Epi& E) {
    const int tid = threadIdx.x, wid = __builtin_amdgcn_readfirstlane(tid >> 6), lane = tid & 63, wr = wid >> 2, wc = wid & 3, fr = lane & 15, fq = lane >> 4;
    const int K = g.K, nt = K / BK, ld = g.ld;
    unsigned voffA[2], voffB[2];
#pragma unroll
    for (int i = 0; i < 2; ++i) { int R, C; stage_rc(tid * 16 + i * 8192, R, C); const int Rb = Epi::PERM ? ((R & ~31) + perm32(R & 31)) : R;
        voffA[i] = (unsigned)(R * ld + C) * 2u; voffB[i] = (unsigned)(Rb * ld + C) * 2u; }
    const size_t kstep = (size_t)(BK * 2);
    const size_t hstep = (size_t)HALF * ld * 2;
    const size_t tstep = 2 * hstep;
    const unsigned ldsw = (unsigned)wid * 1024u;
    const int aoff = lds_byte(wr * 64 + fr, fq * 8), boff = lds_byte(wc * 32 + fr, fq * 8);
#define PG8_SA(b, h) (((b) * 2 + (h)) * HTB)
#define PG8_SB(b, h) ((4 + (b) * 2 + (h)) * HTB)
#define PG8_STAGE(bufoff, gbase, voff) do { _Pragma("unroll") for (int _i = 0; _i < 2; ++_i) \
        __builtin_amdgcn_global_load_lds((const unsigned*)((const char*)(gbase) + (voff)[_i]), (PG8_LAS unsigned*)(lds + (bufoff) + ldsw + _i * 8192), 16, 0, 0); } while (0)
#define PG8_LDA(dst, b, h) do { _Pragma("unroll") for (int m = 0; m < 4; ++m) _Pragma("unroll") for (int k = 0; k < 2; ++k) dst[m][k] = *(const PG8_LAS bf16x8*)(lds + PG8_SA(b, h) + aoff + m * 2048 + k * 1024); } while (0)
#define PG8_LDB(dst, b, h) do { _Pragma("unroll") for (int n = 0; n < 2; ++n) _Pragma("unroll") for (int k = 0; k < 2; ++k) dst[n][k] = *(const PG8_LAS bf16x8*)(lds + PG8_SB(b, h) + boff + n * 2048 + k * 1024); } while (0)
#define PG8_MMA(ai, bj, At, Bt) do { __builtin_amdgcn_s_setprio(1); _Pragma("unroll") for (int m = 0; m < 4; ++m) _Pragma("unroll") for (int n = 0; n < 2; ++n) _Pragma("unroll") for (int k = 0; k < 2; ++k) \
        acc[ai][bj][m][n] = __builtin_amdgcn_mfma_f32_16x16x32_bf16(Bt[n][k], At[m][k], acc[ai][bj][m][n], 0, 0, 0); __builtin_amdgcn_s_setprio(0); } while (0)
#define PG8_WAIT_V(n) asm volatile("s_waitcnt vmcnt(" #n ")" ::: "memory")
#define PG8_WAIT_L(n) asm volatile("s_waitcnt lgkmcnt(" #n ")" ::: "memory")
#define PG8_BAR __builtin_amdgcn_s_barrier()
#define PG8_SCHED __builtin_amdgcn_sched_barrier(0)
    Unit cur, nxt; int ui = 0;
    if (!S.next(0, cur)) return;
    f32x4 acc[2][2][4][2];
#pragma unroll
    for (int a = 0; a < 2; ++a)
#pragma unroll
        for (int b = 0; b < 2; ++b)
#pragma unroll
            for (int m = 0; m < 4; ++m)
#pragma unroll
                for (int n = 0; n < 2; ++n) acc[a][b][m][n] = (f32x4){0.f, 0.f, 0.f, 0.f};
    bf16x8 At[4][2], B0[2][2], B1[2][2];
    const char* cA = (const char*)g.A + (size_t)cur.pm * tstep + (size_t)cur.kh * g.khstep; const char* cB = (const char*)g.Bt + (size_t)cur.pn * tstep + (size_t)cur.kh * g.khstep;
    PG8_STAGE(PG8_SB(0, 0), cB, voffB); PG8_STAGE(PG8_SB(0, 1), cB + hstep, voffB); PG8_STAGE(PG8_SA(0, 0), cA, voffA); PG8_STAGE(PG8_SA(0, 1), cA + hstep, voffA);
    if (wr == 1) PG8_BAR;
    PG8_WAIT_V(2); PG8_BAR;
    PG8_STAGE(PG8_SB(1, 0), cB + kstep, voffB); PG8_STAGE(PG8_SA(1, 0), cA + kstep, voffA); PG8_STAGE(PG8_SB(1, 1), cB + hstep + kstep, voffB);
    PG8_WAIT_V(6); PG8_BAR;
    for (;;) {
        const bool has_next = S.next(ui + 1, nxt);
        const char* nA = has_next ? (const char*)g.A + (size_t)nxt.pm * tstep + (size_t)nxt.kh * g.khstep : cA; const char* nB = has_next ? (const char*)g.Bt + (size_t)nxt.pn * tstep + (size_t)nxt.kh * g.khstep : cB;
        for (int t = 0; t < nt; t += 2) {
            const bool last = (t == nt - 2);
            const char* a1 = cA + (size_t)(t + 1) * kstep;
            const char* a2 = last ? nA : cA + (size_t)(t + 2) * kstep; const char* b2 = last ? nB : cB + (size_t)(t + 2) * kstep;
            const char* a3 = a2 + kstep; const char* b3 = b2 + kstep;
            PG8_LDB(B0, 0, 0); PG8_LDB(B1, 0, 1); PG8_SCHED; PG8_LDA(At, 0, 0); PG8_STAGE(PG8_SA(1, 1), a1 + hstep, voffA);
            PG8_WAIT_V(8); PG8_WAIT_L(0); PG8_BAR; PG8_MMA(0, 0, At, B0); PG8_MMA(0, 1, At, B1); PG8_BAR; PG8_SCHED;
            PG8_LDA(At, 0, 1); PG8_STAGE(PG8_SB(0, 0), b2, voffB); PG8_STAGE(PG8_SB(0, 1), b2 + hstep, voffB); PG8_STAGE(PG8_SA(0, 0), a2, voffA);
            PG8_WAIT_V(8); PG8_WAIT_L(0); PG8_BAR; PG8_MMA(1, 0, At, B0); PG8_MMA(1, 1, At, B1); PG8_BAR; PG8_SCHED;
            PG8_LDB(B0, 1, 0); PG8_LDB(B1, 1, 1); PG8_SCHED; PG8_LDA(At, 1, 0); PG8_STAGE(PG8_SA(0, 1), a2 + hstep, voffA);
            PG8_WAIT_V(8); PG8_WAIT_L(0); PG8_BAR; PG8_MMA(0, 0, At, B0); PG8_MMA(0, 1, At, B1); PG8_BAR; PG8_SCHED;
            PG8_LDA(At, 1, 1); PG8_STAGE(PG8_SB(1, 0), b3, voffB); PG8_STAGE(PG8_SB(1, 1), b3 + hstep, voffB); PG8_STAGE(PG8_SA(1, 0), a3, voffA);
            PG8_WAIT_V(8); PG8_WAIT_L(0); PG8_BAR; PG8_MMA(1, 0, At, B0); PG8_MMA(1, 1, At, B1); PG8_BAR; PG8_SCHED;
        }
        if constexpr (ALIGN_EPI) { if (wr == 0) PG8_BAR; }
        const bool keep = E(acc, cur, wr, wc, fr, fq);
        if (!has_next) break;
        if (!(Epi::KEEPS && keep)) {
#pragma unroll
            for (int a = 0; a < 2; ++a)
#pragma unroll
                for (int b = 0; b < 2; ++b)
#pragma unroll
                    for (int m = 0; m < 4; ++m)
#pragma unroll
                        for (int n = 0; n < 2; ++n) acc[a][b][m][n] = (f32x4){0.f, 0.f, 0.f, 0.f};
        }
        cur = nxt; cA = nA; cB = nB; ++ui;
        if constexpr (ALIGN_EPI) { if (wr == 1) PG8_BAR; }
    }
    PG8_WAIT_V(0);
    if constexpr (!ALIGN_EPI) { if (wr == 0) PG8_BAR; }
    PG8_BAR;
#undef PG8_SA
#undef PG8_SB
#undef PG8_STAGE
#undef PG8_LDA
#undef PG8_LDB
#undef PG8_MMA
#undef PG8_WAIT_V
#undef PG8_WAIT_L
#undef PG8_BAR
#undef PG8_SCHED
}
}

constexpr int NWAVES = 8;
constexpr int BATCH = 8, SEQ = 2048, DM = 2048, M = BATCH * SEQ;
constexpr int NH = 8, HD = 128, DA = 1024, DB = 1024, DFF = 8192, DIN = 9216;
constexpr int NPAT = 3;
constexpr float LN_EPS = 1e-5f;
constexpr float ALPHA = 1.189207115002721f;
constexpr float LOG2E = 1.4426950408889634f;
constexpr float QSCALE = 0.08838834764831845f * 1.4426950408889634f;

constexpr size_t MiB = 1u << 20;
constexpr size_t WS_CTL = 0, CTL_ZERO_BYTES = 256 * 1024;
constexpr size_t WS_VSTAT = 1 * MiB;
constexpr size_t WS_LSE = 3 * MiB;
constexpr size_t WS_WSP = 5 * MiB - 512 * 1024;
constexpr size_t WS_BTAB = 5 * MiB - 128 * 1024;
constexpr size_t WS_WIN = 5 * MiB;
constexpr size_t WS_O1 = 5 * MiB;
constexpr size_t WS_WPAB = 41 * MiB;
constexpr size_t WS_WOUT = 49 * MiB;
constexpr size_t WS_W1 = 57 * MiB;
constexpr size_t WS_W2 = 89 * MiB;
constexpr size_t WS_O0 = 57 * MiB, WS_O2 = 89 * MiB;
constexpr size_t WS_XB = 121 * MiB;
constexpr size_t WS_AG = WS_XB, WS_HB = WS_XB;
constexpr size_t WS_Q = 185 * MiB, WS_K = 217 * MiB, WS_V = 249 * MiB, WS_U = 281 * MiB, WS_VB = 313 * MiB;
constexpr size_t WS_GA = 345 * MiB, WS_GB = 409 * MiB;
constexpr size_t WS_MRG = WS_Q;
constexpr size_t WS_ACT = 185 * MiB;
constexpr size_t WS_MIX = WS_V;
constexpr size_t WS_FF = WS_WIN;
constexpr size_t WS_END = 473 * MiB;
constexpr int BT_PITCH = 132;
constexpr int CW_BAR = 4096;
constexpr int CW_CHK = 1024;
constexpr int CW_TS = 2048;

constexpr int RING_OFF = 0, RING_BYTES = 131072;
constexpr int LDSCTL_OFF = RING_BYTES, MISC_OFF = LDSCTL_OFF + 320;
constexpr int LDS_BT_OFF = RING_BYTES + 1024;
constexpr int LDS_BYTES = 147456;

#define GAS __attribute__((address_space(1)))
#define LAS __attribute__((address_space(3)))
typedef unsigned short bf16;
typedef unsigned v4u __attribute__((ext_vector_type(4)));
typedef unsigned v2u __attribute__((ext_vector_type(2)));
typedef float f32x4 __attribute__((ext_vector_type(4)));
typedef float f32x2 __attribute__((ext_vector_type(2)));
typedef short bf16x8 __attribute__((ext_vector_type(8)));
typedef short s16x4 __attribute__((ext_vector_type(4)));
typedef GAS unsigned gu32;
#define RLX_AGENT __ATOMIC_RELAXED, __HIP_MEMORY_SCOPE_AGENT
#define LDS_WAIT() asm volatile("s_waitcnt lgkmcnt(0)" ::: "memory")
#define VM_WAIT() asm volatile("s_waitcnt vmcnt(0)" ::: "memory")
__device__ __forceinline__ unsigned f2bf(float f) { unsigned u = __builtin_bit_cast(unsigned, f); return (u + 0x7fffu + ((u >> 16) & 1u)) >> 16; }
__device__ __forceinline__ unsigned pk2(float lo, float hi) { return f2bf(lo) | (f2bf(hi) << 16); }
__device__ __forceinline__ float bf2f(bf16 v) { return __uint_as_float((unsigned)v << 16); }

#define XB_TMO      128
#define XB_XCNT(j)  (256  + 64 * (j))
#define XB_XSUB(j)  (1280 + 64 * (j))
#define XB_XGEN(j)  (2304 + 64 * (j))
#define XB_TOP      3328
#define XB_TOPGEN   3392
#define XCD_BAR_WORDS 3456
#define XB_SPIN_CAP (1u << 22)
__device__ __forceinline__ unsigned xb_ld(unsigned* p)              { return __hip_atomic_load(p, __ATOMIC_RELAXED, __HIP_MEMORY_SCOPE_AGENT); }
__device__ __forceinline__ unsigned xb_add(unsigned* p, unsigned v) { return __hip_atomic_fetch_add(p, v, __ATOMIC_RELAXED, __HIP_MEMORY_SCOPE_AGENT); }
__device__ __forceinline__ unsigned xb_xcc_id() { return (unsigned)__builtin_amdgcn_s_getreg((3 << 11) | 20) & 0xFu; }
#define XB_SPIN(cond, bar) do { unsigned _sp = 0; while (cond) { __builtin_amdgcn_s_sleep(1); \
    if ((++_sp & 255u) == 0u) { if (xb_ld(&(bar)[XB_TMO])) break; if (_sp > XB_SPIN_CAP) { atomicAdd(&(bar)[XB_TMO], 1u); break; } } } } while (0)
struct XcdBarrier { unsigned* bar; unsigned x; volatile LAS unsigned* st; };
__device__ __forceinline__ XcdBarrier xcd_barrier_post(unsigned* bar, volatile LAS unsigned* st) {
    XcdBarrier b; b.bar = bar; b.x = xb_xcc_id(); b.st = st;
    if (threadIdx.x == 0) (void)xb_add(&bar[XB_XCNT(b.x)], 1u);
    return b;
}
__device__ __forceinline__ void xcd_barrier_complete(unsigned* bar, unsigned x, unsigned& nloc, unsigned& nx) {
    const unsigned G = gridDim.x * gridDim.y * gridDim.z;
    unsigned sum, cnt, mine, sp = 0u;
    for (;;) {
        sum = 0u; cnt = 0u; mine = 0u;
#pragma unroll
        for (unsigned j = 0; j < 16; ++j) { const unsigned c = xb_ld(&bar[XB_XCNT(j)]); sum += c; cnt += (c > 0u) ? 1u : 0u; mine = (j == x) ? c : mine; }
        if (sum == G) break;
        __builtin_amdgcn_s_sleep(1);
        if ((++sp & 255u) == 0u) { if (xb_ld(&bar[XB_TMO])) break; if (sp > XB_SPIN_CAP) { atomicAdd(&bar[XB_TMO], 1u); break; } }
    }
    nloc = mine > 0u ? mine : 1u; nx = cnt > 0u ? cnt : 1u;
}
__device__ __forceinline__ void xcd_barrier(const XcdBarrier& b) {
    asm volatile("s_waitcnt vmcnt(0)" ::: "memory");
    __syncthreads();
    if (threadIdx.x == 0) {
        unsigned* bar = b.bar;
        __builtin_amdgcn_s_waitcnt(0);
        unsigned nloc = b.st[0], nx = b.st[1];
        if (nloc == 0u) { xcd_barrier_complete(bar, b.x, nloc, nx); b.st[0] = nloc; b.st[1] = nx; }
        const unsigned old = xb_add(&bar[XB_XSUB(b.x)], 1u);
        const unsigned gen = old / nloc;
        if (old + 1u == (gen + 1u) * nloc) {
            __builtin_amdgcn_fence(__ATOMIC_RELEASE, "agent");
            asm volatile("s_waitcnt vmcnt(0)" ::: "memory");
            const unsigned og = xb_add(&bar[XB_TOP], 1u);
            const unsigned tg = og / nx;
            if (og + 1u == (tg + 1u) * nx) xb_add(&bar[XB_TOPGEN], 1u);
            else XB_SPIN(xb_ld(&bar[XB_TOPGEN]) == tg, bar);
            __builtin_amdgcn_fence(__ATOMIC_ACQUIRE, "agent");
            xb_add(&bar[XB_XGEN(b.x)], 1u);
            asm volatile("s_waitcnt vmcnt(0)" ::: "memory");
        } else {
            XB_SPIN(xb_ld(&bar[XB_XGEN(b.x)]) == gen, bar);
            __builtin_amdgcn_fence(__ATOMIC_ACQUIRE, "agent");
            asm volatile("s_waitcnt vmcnt(0)" ::: "memory");
        }
    }
    __syncthreads();
}

struct Args { const float* in[18]; float* out; unsigned char* ws; int ph_lo, ph_hi; };
struct Frame {
    LAS unsigned char* lds;
    int tid, lane, wave, G, bid;
    const float* const* in; float* out; unsigned char* ws;
};
__device__ __forceinline__ float wave_sum(float v) {
#pragma unroll
    for (int o = 1; o < 64; o <<= 1) v += __shfl_xor(v, o);
    return v;
}

struct TrItem { const float* W; bf16* WT; int N, ldt, koff, k0, n0, n0d; };
__device__ __forceinline__ TrItem tr_decode(const float* const* in, unsigned char* ws, int it) {
    constexpr int I_IN = (DM / 64) * (DIN / 64), I_PA = (DA / 64) * (DM / 64), I_OUT = (DM / 64) * (DM / 64), I_1 = (DM / 64) * (DFF / 64);
    TrItem t; bool rev = false; int r = it;
    if (r < I_IN) { t.W = in[1]; t.N = DIN; t.WT = (bf16*)(ws + WS_WIN); t.ldt = DM; t.koff = 0; rev = true; }
    else if ((r -= I_IN) < I_PA) { t.W = in[7]; t.N = DM; t.WT = (bf16*)(ws + WS_WPAB); t.ldt = 2048; t.koff = 0; }
    else if ((r -= I_PA) < I_PA) { t.W = in[8]; t.N = DM; t.WT = (bf16*)(ws + WS_WPAB); t.ldt = 2048; t.koff = 1024; }
    else if ((r -= I_PA) < I_OUT) { t.W = in[9]; t.N = DM; t.WT = (bf16*)(ws + WS_WOUT); t.ldt = 2048; t.koff = 0; }
    else if ((r -= I_OUT) < I_1) { t.W = in[12]; t.N = DFF; t.WT = (bf16*)(ws + WS_W1); t.ldt = DM; t.koff = 0; }
    else { r -= I_1; t.W = in[14]; t.N = DM; t.WT = (bf16*)(ws + WS_W2); t.ldt = DFF; t.koff = 0; }
    const int nblk = t.N / 64, sub = r & 7, grp = r >> 3, nb = 2 * (grp % (nblk / 2)) + (sub & 1), kb = 4 * (grp / (nblk / 2)) + (sub >> 1);
    t.k0 = 64 * kb; t.n0 = 64 * nb; t.n0d = rev ? (t.N / 256 - 1 - t.n0 / 256) * 256 + (t.n0 & 255) : t.n0;
    return t;
}
__device__ __forceinline__ void tr_load(const TrItem& t, int lane, f32x4 (&va)[8], f32x4 (&vb)[8]) {
    const int cg = lane & 15, rg = lane >> 4;
#pragma unroll
    for (int i = 0; i < 8; ++i) { const GAS float* src = (const GAS float*)t.W + (size_t)(t.k0 + 8 * i + 2 * rg) * t.N + t.n0 + 4 * cg; va[i] = *(const GAS f32x4*)src; vb[i] = *(const GAS f32x4*)(src + t.N); }
}
__device__ __forceinline__ void tr_store(const TrItem& t, int lane, const f32x4 (&va)[8], const f32x4 (&vb)[8], LAS unsigned* scr) {
    const int cg = lane & 15, rg = lane >> 4;
#pragma unroll
    for (int i = 0; i < 8; ++i) { const int kp = 4 * i + rg;
        scr[(4 * cg + 0) * 33 + kp] = pk2(va[i].x, vb[i].x); scr[(4 * cg + 1) * 33 + kp] = pk2(va[i].y, vb[i].y);
        scr[(4 * cg + 2) * 33 + kp] = pk2(va[i].z, vb[i].z); scr[(4 * cg + 3) * 33 + kp] = pk2(va[i].w, vb[i].w); }
    LDS_WAIT(); asm volatile("" ::: "memory");
    const int c = lane & 7;
#pragma unroll
    for (int j = 0; j < 8; ++j) { const int n = (lane >> 3) + 8 * j; const LAS unsigned* sp = scr + n * 33 + 4 * c;
        v4u o; o.x = sp[0]; o.y = sp[1]; o.z = sp[2]; o.w = sp[3];
        *(GAS v4u*)(t.WT + (size_t)(t.n0d + n) * t.ldt + t.koff + t.k0 + 8 * c) = o; }
    LDS_WAIT(); asm volatile("" ::: "memory");
}
__device__ __forceinline__ int t5_bucket(int n) {
    if (n < 16) return n;
    const float nf = (float)n;
    int large = 16 + (int)(logf(nf / 16.0f) / 4.852030263919617f * 16.0f);
    return large < 31 ? large : 31;
}
__device__ __forceinline__ int pat_dil(int p) { return p == 0 ? 1 : (p == 1 ? 4 : 16); }

__device__ __forceinline__ void phase_prologue(Frame& F) {
    LAS unsigned* scr = (LAS unsigned*)(F.lds + RING_OFF + F.wave * 16384);
    const int gw = F.bid * NWAVES + F.wave, NGW = F.G * NWAVES;
    constexpr int NITEMS = (DM / 64) * (DIN / 64) + 2 * (DA / 64) * (DM / 64) + (DM / 64) * (DM / 64) + 2 * (DM / 64) * (DFF / 64);
    {   f32x4 a0[8], b0[8], a1[8], b1[8];
        TrItem t0 = tr_decode(F.in, F.ws, gw < NITEMS ? gw : 0), t1 = t0;
        if (gw < NITEMS) tr_load(t0, F.lane, a0, b0);
        for (int it = gw; it < NITEMS; it += 2 * NGW) {
            const bool h1 = it + NGW < NITEMS, h2 = it + 2 * NGW < NITEMS;
            if (h1) { t1 = tr_decode(F.in, F.ws, it + NGW); tr_load(t1, F.lane, a1, b1); }
            tr_store(t0, F.lane, a0, b0, scr);
            if (h2) { t0 = tr_decode(F.in, F.ws, it + 2 * NGW); tr_load(t0, F.lane, a0, b0); }
            if (h1) tr_store(t1, F.lane, a1, b1, scr);
        }
    }
    const float* x = F.in[0]; bf16* XB = (bf16*)(F.ws + WS_XB);
    {   f32x4 v0[8], v1[8];
        if (gw < M) {
#pragma unroll
            for (int j = 0; j < 8; ++j) v0[j] = ((const GAS f32x4*)(x + (size_t)gw * DM) + F.lane)[64 * j]; }
        for (int m = gw; m < M; m += 2 * NGW) {
            const bool h1 = m + NGW < M, h2 = m + 2 * NGW < M;
            if (h1) {
#pragma unroll
                for (int j = 0; j < 8; ++j) v1[j] = ((const GAS f32x4*)(x + (size_t)(m + NGW) * DM) + F.lane)[64 * j]; }
            { GAS v2u* o = (GAS v2u*)(XB + (size_t)m * DM) + F.lane;
#pragma unroll
              for (int j = 0; j < 8; ++j) o[64 * j] = (v2u){pk2(v0[j].x, v0[j].y), pk2(v0[j].z, v0[j].w)}; }
            if (h2) {
#pragma unroll
                for (int j = 0; j < 8; ++j) v0[j] = ((const GAS f32x4*)(x + (size_t)(m + 2 * NGW) * DM) + F.lane)[64 * j]; }
            if (h1) { GAS v2u* o = (GAS v2u*)(XB + (size_t)(m + NGW) * DM) + F.lane;
#pragma unroll
              for (int j = 0; j < 8; ++j) o[64 * j] = (v2u){pk2(v1[j].x, v1[j].y), pk2(v1[j].z, v1[j].w)}; }
        }
    }
    const int gt = F.bid * (NWAVES * 64) + F.tid, NGT = F.G * NWAVES * 64;
    const float* wsp = F.in[5]; bf16* WSP = (bf16*)(F.ws + WS_WSP);
    for (int e = gt; e < 8 * 128 * 128; e += NGT) { const int i = (e >> 7) & 127, j = e & 127; WSP[e] = (bf16)(j <= i ? f2bf(wsp[e]) : 0u); }
    const float* rb = F.in[2]; float* BT = (float*)(F.ws + WS_BTAB);
    for (int e = gt; e < NPAT * NH * BT_PITCH; e += NGT) { const int p = e / (NH * BT_PITCH), h = (e / BT_PITCH) % NH, j = e % BT_PITCH;
        BT[e] = (j <= 128) ? rb[t5_bucket(j * pat_dil(p)) * NH + h] * LOG2E : 0.f; }
}
template <bool BASE_BF16>
__device__ __forceinline__ void phase_ln(Frame& F, const float* base, const bf16* baseb, const bf16* add, float* outf, const float* gain, const float* bias, bf16* ob) {
    const int gw = F.bid * NWAVES + F.wave, NGW = F.G * NWAVES;
    for (int m = gw; m < M; m += NGW) {
        const GAS v2u* ar = (const GAS v2u*)(add + (size_t)m * DM) + F.lane;
        f32x4 v[8]; float s = 0.f;
#pragma unroll
        for (int j = 0; j < 8; ++j) { f32x4 x;
            if constexpr (BASE_BF16) { const v2u xb = ((const GAS v2u*)(baseb + (size_t)m * DM) + F.lane)[64 * j]; x = (f32x4){pg8::bf_lo(xb.x), pg8::bf_hi(xb.x), pg8::bf_lo(xb.y), pg8::bf_hi(xb.y)}; }
            else x = ((const GAS f32x4*)(base + (size_t)m * DM) + F.lane)[64 * j];
            const v2u a = ar[64 * j];
            v[j] = x * ALPHA + (f32x4){pg8::bf_lo(a.x), pg8::bf_hi(a.x), pg8::bf_lo(a.y), pg8::bf_hi(a.y)}; s += (v[j].x + v[j].y) + (v[j].z + v[j].w); }
        const float mean = wave_sum(s) * (1.f / DM); float s2 = 0.f;
#pragma unroll
        for (int j = 0; j < 8; ++j) { v[j] = v[j] - mean; s2 += (v[j].x * v[j].x + v[j].y * v[j].y) + (v[j].z * v[j].z + v[j].w * v[j].w); }
        const float rstd = 1.f / sqrtf(wave_sum(s2) * (1.f / DM) + LN_EPS);
        GAS f32x4* orow = (GAS f32x4*)(outf + (size_t)m * DM) + F.lane;
#pragma unroll
        for (int j = 0; j < 8; ++j) { const f32x4 g = ((const GAS f32x4*)gain)[64 * j + F.lane], b = ((const GAS f32x4*)bias)[64 * j + F.lane];
            const f32x4 o = v[j] * rstd * g + b; if (outf) orow[64 * j] = o;
            if (ob) ((GAS v2u*)(ob + (size_t)m * DM))[64 * j + F.lane] = (v2u){pk2(o.x, o.y), pk2(o.z, o.w)}; }
    }
}
__device__ __forceinline__ void phase_combine(Frame& F) {
    const int gw = F.bid * NWAVES + F.wave, NGW = F.G * NWAVES;
    const bf16* O0 = (const bf16*)F.out; const bf16* O1 = O0 + (size_t)M * DA; const bf16* O2 = O1 + (size_t)M * DA;
    const float* LSE = (const float*)(F.ws + WS_LSE); bf16* AG = (bf16*)(F.ws + WS_AG);
    for (int m = gw; m < M; m += NGW) {
        const int h = F.lane >> 3;
        const float l0 = LSE[((size_t)0 * M + m) * NH + h], l1 = LSE[((size_t)1 * M + m) * NH + h], l2 = LSE[((size_t)2 * M + m) * NH + h];
        const float mx = fmaxf(l0, fmaxf(l1, l2)); float w0 = exp2f(l0 - mx), w1 = exp2f(l1 - mx), w2 = exp2f(l2 - mx); const float inv = 1.f / (w0 + w1 + w2); w0 *= inv; w1 *= inv; w2 *= inv;
        const size_t off = (size_t)m * DA + F.lane * 16;
#pragma unroll
        for (int c = 0; c < 2; ++c) {
            const v4u a = *(const GAS v4u*)(O0 + off + c * 8), b = *(const GAS v4u*)(O1 + off + c * 8), d = *(const GAS v4u*)(O2 + off + c * 8); v4u o;
#pragma unroll
            for (int e = 0; e < 4; ++e) { const float lo = w0 * pg8::bf_lo(a[e]) + w1 * pg8::bf_lo(b[e]) + w2 * pg8::bf_lo(d[e]); const float hi = w0 * pg8::bf_hi(a[e]) + w1 * pg8::bf_hi(b[e]) + w2 * pg8::bf_hi(d[e]); o[e] = pk2(lo, hi); }
            *(GAS v4u*)(AG + (size_t)m * 2048 + F.lane * 16 + c * 8) = o;
        }
    }
}

__device__ __forceinline__ s16x4 tr_read(const LAS unsigned char* p) { return __builtin_bit_cast(s16x4, __builtin_amdgcn_ds_read_tr16_b64_v4i16((LAS s16x4*)p)); }
constexpr int ATT_K_OFF = 0, ATT_V_OFF = 65536;

struct AUnit { int b, h, p, d, r, blk; };
__device__ __forceinline__ AUnit aunit(int uid) {
    AUnit u; const int bh = uid / 48, x = uid % 48; u.b = bh >> 3; u.h = bh & 7;
    if (x < 16) { u.p = 0; u.d = 1; u.r = 0; u.blk = x; } else if (x < 32) { u.p = 1; u.d = 4; u.r = (x - 16) >> 2; u.blk = (x - 16) & 3; } else { u.p = 2; u.d = 16; u.r = x - 32; u.blk = 0; }
    return u;
}
__device__ __forceinline__ void attn_units(Frame& F, int vcu, float* Opart) {
    const int tid = F.tid, lane = F.lane, w = F.wave, fr = lane & 15, g = lane >> 4;
    const bf16* Qg = (const bf16*)(F.ws + WS_Q); const bf16* Kg = (const bf16*)(F.ws + WS_K); const bf16* Vg = (const bf16*)(F.ws + WS_V);
    float* LSE = (float*)(F.ws + WS_LSE);
    LAS unsigned char* lds = F.lds;
    LAS float* BTl = (LAS float*)(lds + LDS_BT_OFF);
    constexpr int NU = BATCH * NH * 48;
    for (int e = tid; e < NPAT * NH * BT_PITCH; e += NWAVES * 64) BTl[e] = ((const float*)(F.ws + WS_BTAB))[e];
    v4u kr[8], vr[8]; bf16x8 qn[4];
#define ATT_PREFETCH(U) do { const size_t _rb = (size_t)(U).b * SEQ; const int _lo = ((U).blk == 0) ? 4 : 0; \
        _Pragma("unroll") for (int it = 0; it < 8; ++it) if (it >= _lo) { const int idx = it * 512 + tid, kj = idx >> 4, gr = idx & 15; \
            const size_t row = _rb + (U).r + (U).d * (128 * ((U).blk - 1) + kj); \
            kr[it] = *(const GAS v4u*)(Kg + row * DA + (U).h * HD + gr * 8); vr[it] = *(const GAS v4u*)(Vg + row * DA + (U).h * HD + gr * 8); } \
        const size_t _qrow = _rb + (U).r + (U).d * (128 * (U).blk + 16 * w + fr); \
        _Pragma("unroll") for (int ks = 0; ks < 4; ++ks) qn[ks] = *(const GAS bf16x8*)(Qg + _qrow * DA + (U).h * HD + 32 * ks + 8 * g); } while (0)
    const bool loc = false; const int nsteps = loc ? 12 : (NU - vcu + F.G - 1) / F.G;
#define ATT_UID(t) (loc ? ((((t) / 3) * 16 + (vcu >> 4)) * 48 + ((t) % 3) * 16 + (vcu & 15)) : (vcu + (t) * F.G))
    AUnit cur = aunit(ATT_UID(0));
    if (nsteps > 0) ATT_PREFETCH(cur);
    for (int t = 0; t < nsteps; ++t) {
        const int kt_lo = (cur.blk == 0) ? 8 : 0;
#pragma unroll
        for (int it = 0; it < 8; ++it) if (it * 2 >= kt_lo) {
            const int idx = it * 512 + tid, kj = idx >> 4, gr = idx & 15;
            *(LAS v4u*)(lds + ATT_K_OFF + kj * 256 + ((gr ^ (kj & 15)) << 4)) = kr[it];
            *(LAS v4u*)(lds + ATT_V_OFF + kj * 256 + ((gr ^ ((kj & 7) << 1)) << 4)) = vr[it];
        }
        bf16x8 qf[4];
#pragma unroll
        for (int ks = 0; ks < 4; ++ks) { qf[ks] = qn[ks]; asm volatile("" : "+v"(qf[ks])); }
        LDS_WAIT(); __builtin_amdgcn_s_barrier(); asm volatile("" ::: "memory");
        const AUnit me = cur;
        if (t + 1 < nsteps) { cur = aunit(ATT_UID(t + 1)); ATT_PREFETCH(cur); }
        const int qi = 16 * w + fr;
        const size_t qrow = (size_t)me.b * SEQ + me.r + me.d * (128 * me.blk + qi);
        const LAS float* BTp = BTl + (me.p * NH + me.h) * BT_PITCH;
        f32x4 st[9]; float mx = -1e30f;
#pragma unroll
        for (int t = 0; t < 9; ++t) {
            const int kt = w + t;
            if (kt >= kt_lo) {
                f32x4 a = (f32x4){0.f, 0.f, 0.f, 0.f};
                const int key = 16 * kt + fr;
#pragma unroll
                for (int ks = 0; ks < 4; ++ks) { const bf16x8 kf = *(const LAS bf16x8*)(lds + ATT_K_OFF + key * 256 + (((4 * ks + g) ^ fr) << 4));
                    a = __builtin_amdgcn_mfma_f32_16x16x32_bf16(kf, qf[ks], a, 0, 0, 0); }
#pragma unroll
                for (int e = 0; e < 4; ++e) { const int kj = 16 * kt + 4 * g + e, steps = 128 + qi - kj; const bool ok = (steps >= 0) && (steps <= 128);
                    const float v = ok ? a[e] + BTp[ok ? steps : 0] : -1e30f; a[e] = v; mx = fmaxf(mx, v); }
                st[t] = a;
            } else st[t] = (f32x4){-1e30f, -1e30f, -1e30f, -1e30f};
        }
        mx = fmaxf(mx, __shfl_xor(mx, 16)); mx = fmaxf(mx, __shfl_xor(mx, 32));
        float lsum = 0.f;
#pragma unroll
        for (int t = 0; t < 9; ++t)
#pragma unroll
            for (int e = 0; e < 4; ++e) { const float pv = pg8::fast_exp2(st[t][e] - mx); st[t][e] = pv; lsum += pv; }
        lsum += __shfl_xor(lsum, 16); lsum += __shfl_xor(lsum, 32);
        f32x4 o[8];
#pragma unroll
        for (int mt = 0; mt < 8; ++mt) o[mt] = (f32x4){0.f, 0.f, 0.f, 0.f};
#pragma unroll
        for (int a = 0; a < 5; ++a) {
            const int kt0 = w + 2 * a, kt1 = kt0 + 1; const bool v0 = kt0 >= kt_lo, v1 = (2 * a + 1 <= 8) && (kt1 >= kt_lo);
            if (v0 || v1) {
                v4u pw; pw.x = pg8::cvt_pk_bf16(st[2 * a][0], st[2 * a][1]); pw.y = pg8::cvt_pk_bf16(st[2 * a][2], st[2 * a][3]);
                if (2 * a + 1 <= 8) { pw.z = pg8::cvt_pk_bf16(st[(2 * a + 1 <= 8) ? 2 * a + 1 : 0][0], st[(2 * a + 1 <= 8) ? 2 * a + 1 : 0][1]); pw.w = pg8::cvt_pk_bf16(st[(2 * a + 1 <= 8) ? 2 * a + 1 : 0][2], st[(2 * a + 1 <= 8) ? 2 * a + 1 : 0][3]); }
                else { pw.z = 0u; pw.w = 0u; }
                if (!v0) { pw.x = 0u; pw.y = 0u; }
                if (!v1) { pw.z = 0u; pw.w = 0u; }
                const bf16x8 pf = __builtin_bit_cast(bf16x8, pw);
                const int krow = 4 * g + (fr >> 2), ksw = ((krow & 7) << 1);
                const LAS unsigned char* v0p = lds + ATT_V_OFF + (16 * kt0 + krow) * 256 + ((lane & 1) << 3);
                const LAS unsigned char* v1p = lds + ATT_V_OFF + (16 * kt1 + krow) * 256 + ((lane & 1) << 3);
#pragma unroll
                for (int mt = 0; mt < 8; ++mt) {
                    const int gsw = ((2 * mt + ((lane & 3) >> 1)) ^ ksw) << 4;
                    s16x4 lo = (s16x4){0, 0, 0, 0}, hi = (s16x4){0, 0, 0, 0};
                    if (v0) lo = tr_read(v0p + gsw);
                    if (v1) hi = tr_read(v1p + gsw);
                    const bf16x8 vf = (bf16x8){lo[0], lo[1], lo[2], lo[3], hi[0], hi[1], hi[2], hi[3]};
                    o[mt] = __builtin_amdgcn_mfma_f32_16x16x32_bf16(vf, pf, o[mt], 0, 0, 0);
                }
            }
        }
        const float inv = 1.0f / lsum;
        bf16* orow = (bf16*)Opart + (size_t)me.p * M * DA + qrow * DA + me.h * HD + 4 * g;
#pragma unroll
        for (int mt = 0; mt < 8; ++mt) { const f32x4 v = o[mt] * inv; *(GAS v2u*)(orow + 16 * mt) = (v2u){pg8::cvt_pk_bf16(v[0], v[1]), pg8::cvt_pk_bf16(v[2], v[3])}; }
        if (g == 0) LSE[((size_t)me.p * M + qrow) * NH + me.h] = mx + log2f(lsum);
        LDS_WAIT(); __builtin_amdgcn_s_barrier(); asm volatile("" ::: "memory");
    }
#undef ATT_PREFETCH
#undef ATT_UID
}

__device__ __forceinline__ void gmlp_unit(Frame& F, int uid) {
    const int gg = uid & 7, c = (uid >> 3) & 15, b = uid >> 7;
    const int tid = F.tid, lane = F.lane, w = F.wave, fr = lane & 15, g = lane >> 4;
    LAS unsigned char* lds = F.lds;
    LAS f32x2* STl = (LAS f32x2*)(lds + LDS_BT_OFF);
    const size_t R0 = (size_t)b * SEQ + 128 * c;
    const bf16* VBg = (const bf16*)(F.ws + WS_VB); const bf16* Ug = (const bf16*)(F.ws + WS_U); const bf16* WSP = (const bf16*)(F.ws + WS_WSP) + (size_t)gg * 128 * 128;
    const f32x2* VST = (const f32x2*)(F.ws + WS_VSTAT); bf16* AG = (bf16*)(F.ws + WS_AG);
    const float* gain = F.in[3]; const float* biasv = F.in[4]; const float* bsp = F.in[6];
    const int i = 16 * w + fr, nks = (w >> 1) + 1;
    v4u st8[8];
    if (tid < 128) {
#pragma unroll
        for (int k = 0; k < 8; ++k) st8[k] = *(const GAS v4u*)(VST + (R0 + tid) * 16 + 2 * k);
    }
    v4u raw[4];
#pragma unroll
    for (int it = 0; it < 4; ++it) { const int idx = it * 512 + tid, j = idx >> 4, gr = idx & 15; raw[it] = *(const GAS v4u*)(VBg + (R0 + j) * DB + gg * 128 + gr * 8); }
    const int gr0 = tid & 15;
    const f32x4 g0 = *(const GAS f32x4*)(gain + gg * 128 + gr0 * 8), g1 = *(const GAS f32x4*)(gain + gg * 128 + gr0 * 8 + 4);
    const f32x4 b0 = *(const GAS f32x4*)(biasv + gg * 128 + gr0 * 8), b1 = *(const GAS f32x4*)(biasv + gg * 128 + gr0 * 8 + 4);
    bf16x8 wf[4];
#pragma unroll
    for (int ks = 0; ks < 4; ++ks) wf[ks] = (ks < nks) ? *(const GAS bf16x8*)(WSP + (size_t)i * 128 + 32 * ks + 8 * g) : (bf16x8){0, 0, 0, 0, 0, 0, 0, 0};
    const bf16* urow = Ug + (R0 + i) * DB + gg * 128 + 4 * g;
    v2u uu[8];
#pragma unroll
    for (int mt = 0; mt < 8; ++mt) uu[mt] = *(const GAS v2u*)(urow + 16 * mt);
    const float bs = bsp[gg * 128 + i];
    if (tid < 128) { float s1 = 0.f, s2 = 0.f;
#pragma unroll
        for (int k = 0; k < 8; ++k) { s1 += __uint_as_float(st8[k].x) + __uint_as_float(st8[k].z); s2 += __uint_as_float(st8[k].y) + __uint_as_float(st8[k].w); }
        const float mean = s1 * (1.f / DB), var = fmaxf(s2 * (1.f / DB) - mean * mean, 0.f);
        STl[tid] = (f32x2){mean, 1.0f / sqrtf(var + LN_EPS)}; }
    LDS_WAIT(); __builtin_amdgcn_s_barrier(); asm volatile("" ::: "memory");
#pragma unroll
    for (int it = 0; it < 4; ++it) {
        const int idx = it * 512 + tid, j = idx >> 4, gr = idx & 15;
        const f32x2 st = STl[j]; const v4u r4 = raw[it];
        v4u o;
        o.x = pk2((pg8::bf_lo(r4.x) - st.x) * st.y * g0[0] + b0[0], (pg8::bf_hi(r4.x) - st.x) * st.y * g0[1] + b0[1]);
        o.y = pk2((pg8::bf_lo(r4.y) - st.x) * st.y * g0[2] + b0[2], (pg8::bf_hi(r4.y) - st.x) * st.y * g0[3] + b0[3]);
        o.z = pk2((pg8::bf_lo(r4.z) - st.x) * st.y * g1[0] + b1[0], (pg8::bf_hi(r4.z) - st.x) * st.y * g1[1] + b1[1]);
        o.w = pk2((pg8::bf_lo(r4.w) - st.x) * st.y * g1[2] + b1[2], (pg8::bf_hi(r4.w) - st.x) * st.y * g1[3] + b1[3]);
        *(LAS v4u*)(lds + j * 256 + ((gr ^ ((j & 7) << 1)) << 4)) = o;
    }
    LDS_WAIT(); __builtin_amdgcn_s_barrier(); asm volatile("" ::: "memory");
    f32x4 acc[8];
#pragma unroll
    for (int mt = 0; mt < 8; ++mt) acc[mt] = (f32x4){0.f, 0.f, 0.f, 0.f};
#pragma unroll
    for (int ks = 0; ks < 4; ++ks) if (ks < nks) {
        const int j0 = 32 * ks + 8 * g + (fr >> 2), j1 = j0 + 4;
        const LAS unsigned char* p0 = lds + j0 * 256 + ((lane & 1) << 3); const LAS unsigned char* p1 = lds + j1 * 256 + ((lane & 1) << 3);
        const int s0 = (j0 & 7) << 1, s1 = (j1 & 7) << 1;
#pragma unroll
        for (int mt = 0; mt < 8; ++mt) {
            const int gb = 2 * mt + ((lane & 3) >> 1);
            const s16x4 lo = tr_read(p0 + ((gb ^ s0) << 4)), hi = tr_read(p1 + ((gb ^ s1) << 4));
            const bf16x8 vf = (bf16x8){lo[0], lo[1], lo[2], lo[3], hi[0], hi[1], hi[2], hi[3]};
            acc[mt] = __builtin_amdgcn_mfma_f32_16x16x32_bf16(vf, wf[ks], acc[mt], 0, 0, 0);
        }
    }
    bf16* orow = AG + (R0 + i) * 2048 + 1024 + gg * 128 + 4 * g;
#pragma unroll
    for (int mt = 0; mt < 8; ++mt) {
        const float z0 = (acc[mt][0] + bs) * pg8::bf_lo(uu[mt].x), z1 = (acc[mt][1] + bs) * pg8::bf_hi(uu[mt].x), z2 = (acc[mt][2] + bs) * pg8::bf_lo(uu[mt].y), z3 = (acc[mt][3] + bs) * pg8::bf_hi(uu[mt].y);
        *(GAS v2u*)(orow + 16 * mt) = (v2u){pg8::cvt_pk_bf16(z0, z1), pg8::cvt_pk_bf16(z2, z3)}; }
    LDS_WAIT(); __builtin_amdgcn_s_barrier(); asm volatile("" ::: "memory");
}
__device__ __forceinline__ void phase_attn(Frame& F) {
    const int vcu = (F.G % 8 == 0) ? (F.bid & 7) * (F.G >> 3) + (F.bid >> 3) : F.bid;
    attn_units(F, vcu, F.out);
}
__device__ __forceinline__ void phase_gmlp(Frame& F) {
    for (int u = F.bid; u < BATCH * 16 * 8; u += F.G) gmlp_unit(F, u);
}

constexpr int N_PHASES = 11;
__global__ void __launch_bounds__(NWAVES * 64, 2) mk_fwd(Args args) {
    extern __shared__ __attribute__((aligned(16))) unsigned char lds_raw[];
    Frame F;
    F.lds = (LAS unsigned char*)lds_raw;
    F.tid = threadIdx.x; F.lane = F.tid & 63; F.wave = __builtin_amdgcn_readfirstlane(F.tid >> 6);
    F.G = gridDim.x; F.bid = blockIdx.x; F.in = args.in; F.out = args.out; F.ws = args.ws;
    for (int u = F.tid; u < (LDS_BYTES - LDSCTL_OFF) / 4; u += NWAVES * 64) ((LAS unsigned*)(F.lds + LDSCTL_OFF))[u] = 0u;
    __syncthreads();
    gu32* ctl = (gu32*)(args.ws + WS_CTL);
    const int lo = args.ph_lo, hi = args.ph_hi;
    XcdBarrier bar; bar.bar = (unsigned*)(ctl + CW_BAR); bar.x = 0; bar.st = nullptr;
    if (hi - lo > 1) bar = xcd_barrier_post((unsigned*)(ctl + CW_BAR), (volatile LAS unsigned*)(F.lds + MISC_OFF) + 8);
#define IN(k) (lo <= (k) && (k) < hi)
#define STAMP(k) do { if (MK_TPROBE && F.bid == 0 && F.tid == 0) ((unsigned long long*)(ctl + CW_TS))[k] = __builtin_amdgcn_s_memrealtime(); } while (0)
#define SEAM(k) do { if (IN(k) && IN((k) + 1)) xcd_barrier(bar); STAMP((k) + 1); } while (0)
    STAMP(0);
    unsigned char* ws = args.ws;
    if (IN(0)) { phase_prologue(F); SEAM(0); }
    if (IN(1)) {
        pg8::Gemm g{(const bf16*)(ws + WS_XB), (const bf16*)(ws + WS_WIN), DM, DM, 0}; pg8::StaticOrder S; S.init(M, DIN, F.G, F.bid);
        pg8::EpiProj E{(bf16*)(ws + WS_Q), (bf16*)(ws + WS_K), (bf16*)(ws + WS_V), (bf16*)(ws + WS_U), (bf16*)(ws + WS_VB), (bf16*)(ws + WS_GA), (bf16*)(ws + WS_GB), (pg8::f32x2*)(ws + WS_VSTAT), QSCALE};
        pg8::gemm_phase<pg8::EpiProj, pg8::StaticOrder, true>(F.lds + RING_OFF, g, S, E);
        SEAM(1);
    }
    if (IN(2)) { phase_attn(F); if (MK_TPROBE) SEAM(2); }
    if (IN(3)) { phase_gmlp(F); SEAM(3); }
    if (IN(4)) { phase_combine(F); SEAM(4); }
    if (IN(5)) {
        pg8::Gemm g{(const bf16*)(ws + WS_AG), (const bf16*)(ws + WS_WPAB), 1024, 2048, 2048}; pg8::PairOrder S; S.so.init(M, DM, F.G, F.bid);
        pg8::EpiGate E{(const unsigned char*)(ws + WS_GA), (const unsigned char*)(ws + WS_GB), (bf16*)(ws + WS_MRG)};
        pg8::gemm_phase<pg8::EpiGate, pg8::PairOrder, true>(F.lds + RING_OFF, g, S, E);
        SEAM(5);
    }
    if (IN(6)) {
        pg8::Gemm g{(const bf16*)(ws + WS_MRG), (const bf16*)(ws + WS_WOUT), DM, DM, 0}; pg8::StaticOrder S; S.init(M, DM, F.G, F.bid);
        pg8::EpiBiasAct<0> E{(bf16*)(ws + WS_MIX), DM, nullptr};
        pg8::gemm_phase<pg8::EpiBiasAct<0>, pg8::StaticOrder, true>(F.lds + RING_OFF, g, S, E);
        SEAM(6);
    }
    if (IN(7)) { phase_ln<false>(F, args.in[0], nullptr, (const bf16*)(ws + WS_MIX), nullptr, args.in[10], args.in[11], (bf16*)(ws + WS_HB)); SEAM(7); }
    if (IN(8)) {
        pg8::Gemm g{(const bf16*)(ws + WS_HB), (const bf16*)(ws + WS_W1), DM, DM, 0}; pg8::StaticOrder S; S.init(M, DFF, F.G, F.bid);
        pg8::EpiBiasAct<1> E{(bf16*)(ws + WS_ACT), DFF, args.in[13]};
        pg8::gemm_phase<pg8::EpiBiasAct<1>, pg8::StaticOrder, true>(F.lds + RING_OFF, g, S, E);
        SEAM(8);
    }
    if (IN(9)) {
        pg8::Gemm g{(const bf16*)(ws + WS_ACT), (const bf16*)(ws + WS_W2), DFF, DFF, 0}; pg8::StaticOrder S; S.init(M, DM, F.G, F.bid);
        pg8::EpiBiasAct<0> E{(bf16*)(ws + WS_FF), DM, args.in[15]};
        pg8::gemm_phase<pg8::EpiBiasAct<0>, pg8::StaticOrder, true>(F.lds + RING_OFF, g, S, E);
        SEAM(9);
    }
    if (IN(10)) { phase_ln<true>(F, nullptr, (const bf16*)(ws + WS_HB), (const bf16*)(ws + WS_FF), args.out, args.in[16], args.in[17], nullptr); }
#if MK_TPROBE
    if (hi - lo > 1) {
        xcd_barrier(bar); STAMP(11);
        if (F.bid == 0 && F.tid == 0) {
            const unsigned long long* ts = (const unsigned long long*)(ctl + CW_TS);
            const unsigned long long dt = (ts[MK_TPA + 1] - ts[MK_TPA]) * (unsigned long long)(MK_TPB), t0 = __builtin_amdgcn_s_memrealtime();
            while (__builtin_amdgcn_s_memrealtime() - t0 < dt) __builtin_amdgcn_s_sleep(20);
        }
    }
#endif
#undef IN
#undef SEAM
}

#if MK_DEBUG_CHECKS
__device__ __forceinline__ unsigned hsh(unsigned x) { x ^= x >> 16; x *= 0x7feb352dU; x ^= x >> 15; x *= 0x846ca68bU; x ^= x >> 16; return x; }
__device__ float dot_bf(const bf16* a, const bf16* b, int K) { float s = 0.f; for (int k = 0; k < K; ++k) s += bf2f(a[k]) * bf2f(b[k]); return s; }
__device__ __forceinline__ bool bad(float got, float ex, float rt, float at) { return !(fabsf(got - ex) <= at + rt * fabsf(ex)); }
__device__ float gelu_ref(float v) { return 0.5f * v * (1.0f + tanhf(0.7978845608028654f * (v + 0.044715f * v * v * v))); }
__global__ void mk_check(Args args, int stage) {
    const unsigned gid = blockIdx.x * blockDim.x + threadIdx.x; unsigned char* ws = args.ws; unsigned* flag = (unsigned*)(ws + WS_CTL) + CW_CHK + stage;
    const unsigned h1 = hsh(gid * 2654435761u + 17u * stage + 1u), h2 = hsh(h1 + 0x9e3779b9u), h3 = hsh(h2 + 0x85ebca6bu);
    bool fail = false;
    if (stage == 0) {
        const int sel = gid % 7;
        if (sel == 0) { const int n = h1 % DIN, k = h2 % DM; fail = ((const bf16*)(ws + WS_WIN))[(size_t)n * DM + k] != (bf16)f2bf(args.in[1][(size_t)k * DIN + n]); }
        else if (sel == 1) { const int n = h1 % DM, k = h2 % DA; fail = ((const bf16*)(ws + WS_WPAB))[(size_t)n * 2048 + k] != (bf16)f2bf(args.in[7][(size_t)k * DM + n]); }
        else if (sel == 2) { const int n = h1 % DM, k = h2 % DB; fail = ((const bf16*)(ws + WS_WPAB))[(size_t)n * 2048 + 1024 + k] != (bf16)f2bf(args.in[8][(size_t)k * DM + n]); }
        else if (sel == 3) { const int n = h1 % DM, k = h2 % DM; fail = ((const bf16*)(ws + WS_WOUT))[(size_t)n * DM + k] != (bf16)f2bf(args.in[9][(size_t)k * DM + n]); }
        else if (sel == 4) { const int m = h1 % M, k = h2 % DM; fail = ((const bf16*)(ws + WS_XB))[(size_t)m * DM + k] != (bf16)f2bf(args.in[0][(size_t)m * DM + k]); }
        else if (sel == 5) { const int e = h1 % (8 * 128 * 128), i = (e >> 7) & 127, j = e & 127; fail = ((const bf16*)(ws + WS_WSP))[e] != (bf16)(j <= i ? f2bf(args.in[5][e]) : 0u); }
        else { const int p = h1 % 3, h = h2 % 8, j = h3 % 129; const float ex = args.in[2][t5_bucket(j * pat_dil(p)) * NH + h] * LOG2E; fail = bad(((const float*)(ws + WS_BTAB))[(p * NH + h) * BT_PITCH + j], ex, 1e-5f, 1e-6f); }
    } else if (stage == 1) {
        const int row = h1 % M, col = h2 % DIN;
        if (gid < 7680) {
            const float dv = dot_bf((const bf16*)(ws + WS_XB) + (size_t)row * DM, (const bf16*)(ws + WS_WIN) + (size_t)col * DM, DM);
            float ex, got;
            if (col < 1024) { ex = dv * QSCALE; got = bf2f(((const bf16*)(ws + WS_Q))[(size_t)row * 1024 + col]); }
            else if (col < 2048) { ex = dv; got = bf2f(((const bf16*)(ws + WS_K))[(size_t)row * 1024 + col - 1024]); }
            else if (col < 3072) { ex = dv; got = bf2f(((const bf16*)(ws + WS_V))[(size_t)row * 1024 + col - 2048]); }
            else if (col < 4096) { ex = gelu_ref(dv); got = bf2f(((const bf16*)(ws + WS_U))[(size_t)row * 1024 + col - 3072]); }
            else if (col < 5120) { ex = gelu_ref(dv); got = bf2f(((const bf16*)(ws + WS_VB))[(size_t)row * 1024 + col - 4096]); }
            else if (col < 7168) { ex = dv; got = bf2f(((const bf16*)(ws + WS_GA))[(size_t)row * 2048 + col - 5120]); }
            else { ex = dv; got = bf2f(((const bf16*)(ws + WS_GB))[(size_t)row * 2048 + col - 7168]); }
            fail = bad(got, ex, 1.5e-2f, 1e-2f);
        } else {
            float s1 = 0.f, s2 = 0.f; for (int c = 0; c < 1024; ++c) { const float v = bf2f(((const bf16*)(ws + WS_VB))[(size_t)row * 1024 + c]); s1 += v; s2 += v * v; }
            float t1 = 0.f, t2 = 0.f; for (int k = 0; k < 16; ++k) { const f32x2 t = ((const f32x2*)(ws + WS_VSTAT))[(size_t)row * 16 + k]; t1 += t.x; t2 += t.y; }
            fail = bad(t1, s1, 1e-2f, 1.0f) || bad(t2, s2, 1e-2f, 1.0f);
        }
    } else if (stage == 2) {
        if (gid < 6144) {
            const int b = h1 % BATCH, s = h2 % SEQ, h = h3 % NH, p = (h3 >> 8) % 3, d = pat_dil(p);
            const bf16* Qg = (const bf16*)(ws + WS_Q); const bf16* Kg = (const bf16*)(ws + WS_K); const bf16* Vg = (const bf16*)(ws + WS_V);
            const bf16* Og = (const bf16*)(ws + (p == 0 ? WS_O0 : (p == 1 ? WS_O1 : WS_O2))); const float* BT = (const float*)(ws + WS_BTAB) + (p * NH + h) * BT_PITCH;
            const size_t qrow = (size_t)b * SEQ + s; float mx = -1e30f;
            for (int j = 0; j <= 128; ++j) { const int sk = s - j * d; if (sk < 0) break; const float sc = dot_bf(Qg + qrow * DA + h * HD, Kg + ((size_t)b * SEQ + sk) * DA + h * HD, HD) + BT[j]; mx = fmaxf(mx, sc); }
            float den = 0.f; for (int j = 0; j <= 128; ++j) { const int sk = s - j * d; if (sk < 0) break; const float sc = dot_bf(Qg + qrow * DA + h * HD, Kg + ((size_t)b * SEQ + sk) * DA + h * HD, HD) + BT[j]; den += exp2f(sc - mx); }
            const float l2 = mx + log2f(den);
            fail = bad(((const float*)(ws + WS_LSE))[((size_t)p * M + qrow) * NH + h], l2, 2e-3f, 2e-2f);
            for (int dd = 0; dd < HD; dd += 7) { float o = 0.f;
                for (int j = 0; j <= 128; ++j) { const int sk = s - j * d; if (sk < 0) break; const float sc = dot_bf(Qg + qrow * DA + h * HD, Kg + ((size_t)b * SEQ + sk) * DA + h * HD, HD) + BT[j]; o += exp2f(sc - mx) * bf2f(Vg[((size_t)b * SEQ + sk) * DA + h * HD + dd]); }
                o /= den; fail = fail || bad(bf2f(Og[qrow * DA + h * HD + dd]), o, 3e-2f, 1e-2f); }
        } else {
            const int row = h1 % M, ch = h2 % DB, gg = ch >> 7, i = row & 127; const size_t R0 = (size_t)(row - i);
            const bf16* WSP = (const bf16*)(ws + WS_WSP) + (size_t)gg * 128 * 128;
            float z = args.in[6][gg * 128 + i];
            for (int j = 0; j <= i; ++j) { float s1 = 0.f, s2 = 0.f; for (int k = 0; k < 16; ++k) { const f32x2 t = ((const f32x2*)(ws + WS_VSTAT))[(R0 + j) * 16 + k]; s1 += t.x; s2 += t.y; }
                const float mean = s1 / DB, var = fmaxf(s2 / DB - mean * mean, 0.f), rstd = 1.0f / sqrtf(var + LN_EPS);
                const float vn = (bf2f(((const bf16*)(ws + WS_VB))[(R0 + j) * DB + ch]) - mean) * rstd * args.in[3][ch] + args.in[4][ch];
                z += bf2f(WSP[i * 128 + j]) * bf2f((bf16)f2bf(vn)); }
            const float ex = z * bf2f(((const bf16*)(ws + WS_U))[(size_t)row * DB + ch]);
            fail = bad(bf2f(((const bf16*)(ws + WS_AG))[(size_t)row * 2048 + 1024 + ch]), ex, 2e-2f, 1e-2f);
        }
    } else if (stage == 3) {
        const int row = h1 % M, col = h2 % DA, h = col >> 7; const float* LSE = (const float*)(ws + WS_LSE);
        const float l0 = LSE[((size_t)0 * M + row) * NH + h], l1 = LSE[((size_t)1 * M + row) * NH + h], l2 = LSE[((size_t)2 * M + row) * NH + h], mx = fmaxf(l0, fmaxf(l1, l2));
        const float w0 = exp2f(l0 - mx), w1 = exp2f(l1 - mx), w2 = exp2f(l2 - mx);
        const float ex = (w0 * bf2f(((const bf16*)(ws + WS_O0))[(size_t)row * DA + col]) + w1 * bf2f(((const bf16*)(ws + WS_O1))[(size_t)row * DA + col]) + w2 * bf2f(((const bf16*)(ws + WS_O2))[(size_t)row * DA + col])) / (w0 + w1 + w2);
        fail = bad(bf2f(((const bf16*)(ws + WS_AG))[(size_t)row * 2048 + col]), ex, 1e-2f, 5e-3f);
    } else if (stage == 4) {
        const int row = h1 % M, col = h2 % DM; const bf16* AG = (const bf16*)(ws + WS_AG) + (size_t)row * 2048; const bf16* Wt = (const bf16*)(ws + WS_WPAB) + (size_t)col * 2048;
        const float ya = dot_bf(AG, Wt, 1024), yb = dot_bf(AG + 1024, Wt + 1024, 1024);
        const float ga = bf2f(((const bf16*)(ws + WS_GA))[(size_t)row * 2048 + col]), gb = bf2f(((const bf16*)(ws + WS_GB))[(size_t)row * 2048 + col]);
        const float ex = ya / (1.f + expf(-ga)) + yb / (1.f + expf(-gb));
        fail = bad(bf2f(((const bf16*)(ws + WS_MRG))[(size_t)row * 2048 + col]), ex, 2e-2f, 5e-3f);
    } else if (stage == 5) {
        const int row = h1 % M, col = h2 % DM;
        const float ex = ALPHA * args.in[0][(size_t)row * DM + col] + dot_bf((const bf16*)(ws + WS_MRG) + (size_t)row * 2048, (const bf16*)(ws + WS_WOUT) + (size_t)col * 2048, DM);
        fail = bad(args.out[(size_t)row * DM + col], ex, 2e-3f, 2e-3f);
    } else if (stage == 6 || stage == 9) {
        const float* gain = args.in[stage == 6 ? 10 : 16]; const float* bias = args.in[stage == 6 ? 11 : 17];
        if (gid < 2048) { const int row = h1 % M; float s1 = 0.f, s2 = 0.f;
            for (int c = 0; c < DM; ++c) { const float v = (args.out[(size_t)row * DM + c] - bias[c]) / gain[c]; s1 += v; s2 += v * v; }
            const float mean = s1 / DM, var = s2 / DM - mean * mean; fail = (fabsf(mean) > 2e-3f) || (fabsf(var - 1.f) > 1e-2f);
        } else if (stage == 6) {
            const int sel = gid % 3;
            if (sel == 0) { const int row = h1 % M, c = h2 % DM; fail = bad(bf2f(((const bf16*)(ws + WS_HB))[(size_t)row * DM + c]), args.out[(size_t)row * DM + c], 5e-3f, 1e-4f); }
            else if (sel == 1) { const int n = h1 % DFF, k = h2 % DM; fail = ((const bf16*)(ws + WS_W1))[(size_t)n * DM + k] != (bf16)f2bf(args.in[12][(size_t)k * DFF + n]); }
            else { const int n = h1 % DM, k = h2 % DFF; fail = ((const bf16*)(ws + WS_W2))[(size_t)n * DFF + k] != (bf16)f2bf(args.in[14][(size_t)k * DM + n]); }
        }
    } else if (stage == 7) {
        const int row = h1 % M, col = h2 % DFF;
        const float v = dot_bf((const bf16*)(ws + WS_HB) + (size_t)row * DM, (const bf16*)(ws + WS_W1) + (size_t)col * DM, DM) + args.in[13][col]; const float r = fmaxf(v, 0.f);
        fail = bad(bf2f(((const bf16*)(ws + WS_ACT))[(size_t)row * DFF + col]), r * r, 2e-2f, 5e-3f);
    } else if (stage == 8) {
        const int row = h1 % M, col = h2 % DM;
        const float ex = ALPHA * bf2f(((const bf16*)(ws + WS_HB))[(size_t)row * DM + col]) + dot_bf((const bf16*)(ws + WS_ACT) + (size_t)row * DFF, (const bf16*)(ws + WS_W2) + (size_t)col * DFF, DFF) + args.in[15][col];
        fail = bad(args.out[(size_t)row * DM + col], ex, 5e-3f, 3e-2f);
    }
    if (fail) atomicAdd(flag, 1u);
}
__global__ void mk_report(Args args) {
    const unsigned* flag = (const unsigned*)(args.ws + WS_CTL) + CW_CHK;
    if (threadIdx.x == 0 && blockIdx.x == 0) { for (int s = 0; s < N_PHASES; ++s) if (flag[s] != 0u) { args.out[0] = 1000.0f * (float)(s + 1); break; } }
}
#endif

extern "C" void kernel_launch(void* const* d_in, const int* in_sizes, int n_in, void* d_out, int out_size, void* d_ws, size_t ws_size, hipStream_t stream) {
    static int grid = 0;
    if (grid == 0) {
        if (n_in != 18 || in_sizes[0] != M * DM || out_size != M * DM || ws_size < WS_END) { fprintf(stderr, "kernel_launch: unexpected shapes (n_in %d, in0 %d, out %d, ws %zu); nothing launched\n", n_in, n_in > 0 ? in_sizes[0] : -1, out_size, ws_size); grid = -1; return; }
        int dev = 0, cus = 0, per_cu = 0;
        if (hipGetDevice(&dev) != hipSuccess || hipDeviceGetAttribute(&cus, hipDeviceAttributeMultiprocessorCount, dev) != hipSuccess) { grid = -1; return; }
        if (hipFuncSetAttribute((const void*)mk_fwd, hipFuncAttributeMaxDynamicSharedMemorySize, LDS_BYTES) != hipSuccess) { fprintf(stderr, "kernel_launch: hipFuncSetAttribute failed\n"); grid = -1; return; }
        if (hipOccupancyMaxActiveBlocksPerMultiprocessor(&per_cu, (const void*)mk_fwd, NWAVES * 64, LDS_BYTES) != hipSuccess || per_cu < 1) { fprintf(stderr, "kernel_launch: occupancy query reports %d blocks per CU\n", per_cu); (void)hipGetLastError(); grid = -1; return; }
        grid = cus;
    }
    if (grid < 0) return;
    (void)hipMemsetAsync((char*)d_ws + WS_CTL, 0, CTL_ZERO_BYTES, stream);
    Args a{};
    for (int i = 0; i < 18; ++i) a.in[i] = (const float*)d_in[i];
    a.out = (float*)d_out; a.ws = (unsigned char*)d_ws;
#if MK_ONE_LAUNCH
    a.ph_lo = 0; a.ph_hi = N_PHASES;
    hipLaunchKernelGGL(mk_fwd, dim3(grid), dim3(NWAVES * 64), LDS_BYTES, stream, a);
#else
    for (int ph = 0; ph < N_PHASES; ++ph) {
        a.ph_lo = ph; a.ph_hi = ph + 1;
        hipLaunchKernelGGL(mk_fwd, dim3(grid), dim3(NWAVES * 64), LDS_BYTES, stream, a);
        if (ph == (MK_REPEAT_PHASE)) hipLaunchKernelGGL(mk_fwd, dim3(grid), dim3(NWAVES * 64), LDS_BYTES, stream, a);
#if MK_DEBUG_CHECKS
        hipLaunchKernelGGL(mk_check, dim3(32), dim3(256), 0, stream, a, ph);
#endif
    }
#if MK_DEBUG_CHECKS
    hipLaunchKernelGGL(mk_report, dim3(1), dim3(64), 0, stream, a);
#endif
#endif
}
```

```cpp
#include <hip/hip_runtime.h>
#include <cstdio>
#include <cstdint>

#ifndef MK_DEBUG_CHECKS
#define MK_DEBUG_CHECKS 0
#endif
#ifndef MK_REPEAT_PHASE
#define MK_REPEAT_PHASE 3
#endif
#ifndef MK_TPROBE
#define MK_TPROBE 0
#endif
#ifndef MK_TPA
#define MK_TPA 0
#endif
#ifndef MK_TPB
#define MK_TPB 4
#endif
#ifndef MK_ONE_LAUNCH
#define MK_ONE_LAUNCH 1
#endif

namespace pg8 {
#define PG8_LAS __attribute__((address_space(3)))
typedef unsigned short bf16_t;
typedef short bf16x8 __attribute__((ext_vector_type(8)));
typedef float f32x4 __attribute__((ext_vector_type(4)));
typedef float f32x2 __attribute__((ext_vector_type(2)));
typedef unsigned u32x4 __attribute__((ext_vector_type(4)));
typedef unsigned u32x2 __attribute__((ext_vector_type(2)));
constexpr int BM = 256, BK = 64, HALF = 128, HTB = HALF * BK * 2, STAGE_BYTES = 8 * HTB, NXCD = 8, WGM = 8;

__host__ __device__ __forceinline__ int lds_byte(int r, int c) { const int st = (r >> 4) * 2 + (c >> 5), rr = r & 15, cc = c & 31, ob = rr * 64 + cc * 2; return st * 1024 + (ob ^ (((ob >> 9) & 1) << 5)); }
__host__ __device__ __forceinline__ void stage_rc(int b, int& R, int& C) { const int st = b / 1024, sb = b % 1024, swz = sb ^ (((sb >> 9) & 1) << 5); R = (st >> 1) * 16 + swz / 64; C = (st & 1) * 32 + (swz % 64) / 2; }
__host__ __device__ __forceinline__ int perm32(int rho) { const int n = rho >> 4, i = rho & 15; return 8 * (i >> 2) + 4 * n + (i & 3); }

struct Unit { int pm, pn, kh; };
struct Gemm { const bf16_t* A; const bf16_t* Bt; int K; int ld; int khstep; };

struct StaticOrder {
    int nM, nN, nwg, G, c;
    __host__ __device__ void init(int M, int N, int G_, int c_) { nM = M / BM; nN = N / BM; nwg = nM * nN; G = G_; c = c_; }
    __host__ __device__ bool next(int i, Unit& u) const {
        const long L = (long)i * G + c; if (L >= nwg) return false;
        int wgid = (int)L; { const int q = nwg / NXCD, r = nwg % NXCD, xcd = wgid % NXCD, off = wgid / NXCD; wgid = (xcd < r ? xcd * (q + 1) : r * (q + 1) + (xcd - r) * q) + off; }
        const int nig = WGM * nN, gid = wgid / nig, fm = gid * WGM, gsz = (nM - fm) < WGM ? (nM - fm) : WGM;
        u.pm = fm + ((wgid % nig) % gsz); u.pn = (wgid % nig) / gsz; u.kh = 0; return true;
    }
};
struct PairOrder {
    StaticOrder so;
    __host__ __device__ bool next(int i, Unit& u) const { if (!so.next(i >> 1, u)) return false; u.kh = i & 1; return true; }
};

__device__ __forceinline__ unsigned cvt_pk_bf16(float lo, float hi) { unsigned r; asm volatile("v_cvt_pk_bf16_f32 %0, %1, %2" : "=v"(r) : "v"(lo), "v"(hi)); return r; }
__device__ __forceinline__ float bf_lo(unsigned w) { return __uint_as_float(w << 16); }
__device__ __forceinline__ float bf_hi(unsigned w) { return __uint_as_float(w & 0xffff0000u); }
__device__ __forceinline__ float fast_exp2(float x) { return __builtin_amdgcn_exp2f(x); }
__device__ __forceinline__ float fast_rcp(float x) { return __builtin_amdgcn_rcpf(x); }
__device__ __forceinline__ float gelu_tanh(float v) {
    const float t = v * (1.0f + 0.044715f * v * v);
    const float e = fast_exp2(t * (-2.0f * 0.7978845608028654f * 1.4426950408889634f));
    return v * fast_rcp(1.0f + e);
}


struct EpiProj {
    static constexpr bool PERM = true, AFTER_DRAIN = false, KEEPS = false;
    bf16_t *Q, *Kb, *V, *U, *VB, *GA, *GB; f32x2* vstat; float qscale;
    __device__ __forceinline__ bool operator()(f32x4 (&acc)[2][2][4][2], const Unit& u, int wr, int wc, int fr, int fq) const {
        const int pn = 35 - u.pn; bf16_t* base; int ldc = 1024, colt, act = 0; float sc = 1.0f;
        if (pn < 4) { base = Q; colt = pn * BM; sc = qscale; }
        else if (pn < 8) { base = Kb; colt = (pn - 4) * BM; }
        else if (pn < 12) { base = V; colt = (pn - 8) * BM; }
        else if (pn < 16) { base = U; colt = (pn - 12) * BM; act = 1; }
        else if (pn < 20) { base = VB; colt = (pn - 16) * BM; act = 2; }
        else if (pn < 28) { base = GA; colt = (pn - 20) * BM; ldc = 2048; }
        else { base = GB; colt = (pn - 28) * BM; ldc = 2048; }
        const int row0 = u.pm * BM + wr * 64 + fr, col0 = colt + wc * 32 + 8 * fq;
        if (pn >= 20) {
            unsigned char* gbase = (unsigned char*)base + ((((size_t)u.pm * 8 + (pn >= 28 ? pn - 28 : pn - 20)) * 8 + (wr * 4 + wc)) * 16) * 512 + (fq * 16 + fr) * 8;
#pragma unroll
            for (int ai = 0; ai < 2; ++ai)
#pragma unroll
                for (int m = 0; m < 4; ++m)
#pragma unroll
                    for (int bj = 0; bj < 2; ++bj) { unsigned q[8];
#pragma unroll
                        for (int e = 0; e < 8; ++e) { const float v = e < 4 ? acc[ai][bj][m][0][e] : acc[ai][bj][m][1][e - 4];
                            q[e] = (unsigned)(255.0f * fast_rcp(1.0f + fast_exp2(v * -1.4426950408889634f)) + 0.5f); }
                        *(u32x2*)(gbase + ((ai * 4 + m) * 2 + bj) * 512) = (u32x2){q[0] | (q[1] << 8) | (q[2] << 16) | (q[3] << 24), q[4] | (q[5] << 8) | (q[6] << 16) | (q[7] << 24)}; }
            return false;
        }
#pragma unroll
        for (int ai = 0; ai < 2; ++ai)
#pragma unroll
            for (int m = 0; m < 4; ++m) {
                const int row = row0 + ai * HALF + m * 16; bf16_t* rowp = base + (size_t)row * ldc + col0; float s1 = 0.f, s2 = 0.f;
#pragma unroll
                for (int bj = 0; bj < 2; ++bj) { f32x4 v0 = acc[ai][bj][m][0], v1 = acc[ai][bj][m][1];
                    if (act != 0) {
#pragma unroll
                        for (int e = 0; e < 4; ++e) { v0[e] = gelu_tanh(v0[e]); v1[e] = gelu_tanh(v1[e]); }
                        s1 += (v0[0] + v0[1]) + (v0[2] + v0[3]) + (v1[0] + v1[1]) + (v1[2] + v1[3]);
                        s2 += (v0[0] * v0[0] + v0[1] * v0[1]) + (v0[2] * v0[2] + v0[3] * v0[3]) + (v1[0] * v1[0] + v1[1] * v1[1]) + (v1[2] * v1[2] + v1[3] * v1[3]);
                    }
                    v0 = v0 * sc; v1 = v1 * sc; u32x4 w; w.x = cvt_pk_bf16(v0[0], v0[1]); w.y = cvt_pk_bf16(v0[2], v0[3]); w.z = cvt_pk_bf16(v1[0], v1[1]); w.w = cvt_pk_bf16(v1[2], v1[3]);
                    *(u32x4*)(rowp + bj * HALF) = w; }
                if (act == 2) {
                    s1 += __shfl_xor(s1, 16); s1 += __shfl_xor(s1, 32); s2 += __shfl_xor(s2, 16); s2 += __shfl_xor(s2, 32);
                    if (fq == 0) vstat[(size_t)row * 16 + (pn - 16) * 4 + wc] = (f32x2){s1, s2};
                }
            }
        return false;
    }
};
struct EpiGate {
    static constexpr bool PERM = true, AFTER_DRAIN = false, KEEPS = true;
    const unsigned char *GA, *GB; bf16_t* O;
    __device__ __forceinline__ bool operator()(f32x4 (&acc)[2][2][4][2], const Unit& u, int wr, int wc, int fr, int fq) const {
        const int row0 = u.pm * BM + wr * 64 + fr, col0 = u.pn * BM + wc * 32 + 8 * fq;
        const size_t goff = ((((size_t)u.pm * 8 + u.pn) * 8 + (wr * 4 + wc)) * 16) * 512 + (fq * 16 + fr) * 8;
        u32x2 gb[16], ga[16];
#pragma unroll
        for (int i = 0; i < 16; ++i) gb[i] = *(const u32x2*)(GB + goff + i * 512);
        if (u.kh == 0) {
#pragma unroll
            for (int i = 0; i < 16; ++i) ga[i] = *(const u32x2*)(GA + goff + i * 512);
        }
#pragma unroll
        for (int ai = 0; ai < 2; ++ai)
#pragma unroll
            for (int m = 0; m < 4; ++m)
#pragma unroll
                for (int bj = 0; bj < 2; ++bj) { const int i = (ai * 4 + m) * 2 + bj; float qb[8];
#pragma unroll
                    for (int e = 0; e < 8; ++e) qb[e] = fmaxf((float)(((e < 4 ? gb[i].x : gb[i].y) >> (8 * (e & 3))) & 255u), 1.0f);
                    if (u.kh == 0) {
#pragma unroll
                        for (int e = 0; e < 8; ++e) { const float r = (float)(((e < 4 ? ga[i].x : ga[i].y) >> (8 * (e & 3))) & 255u) * fast_rcp(qb[e]);
                            if (e < 4) acc[ai][bj][m][0][e] *= r; else acc[ai][bj][m][1][e - 4] *= r; }
                    } else {
                        float o[8];
#pragma unroll
                        for (int e = 0; e < 8; ++e) o[e] = (e < 4 ? acc[ai][bj][m][0][e] : acc[ai][bj][m][1][e - 4]) * (qb[e] * (1.0f / 255.0f));
                        u32x4 w; w.x = cvt_pk_bf16(o[0], o[1]); w.y = cvt_pk_bf16(o[2], o[3]); w.z = cvt_pk_bf16(o[4], o[5]); w.w = cvt_pk_bf16(o[6], o[7]);
                        *(u32x4*)(O + (size_t)(row0 + ai * HALF + m * 16) * 2048 + col0 + bj * HALF) = w;
                    }
                }
        return u.kh == 0;
    }
};
template <int ACT> struct EpiBiasAct {
    static constexpr bool PERM = true, AFTER_DRAIN = false, KEEPS = false;
    bf16_t* O; int ldc; const float* bias;
    __device__ __forceinline__ bool operator()(f32x4 (&acc)[2][2][4][2], const Unit& u, int wr, int wc, int fr, int fq) const {
        const int row0 = u.pm * BM + wr * 64 + fr, col0 = u.pn * BM + wc * 32 + 8 * fq;
        f32x4 bv[2][2];
#pragma unroll
        for (int bj = 0; bj < 2; ++bj)
#pragma unroll
            for (int n = 0; n < 2; ++n) bv[bj][n] = bias ? *(const f32x4*)(bias + col0 + bj * HALF + 4 * n) : (f32x4){0.f, 0.f, 0.f, 0.f};
#pragma unroll
        for (int ai = 0; ai < 2; ++ai)
#pragma unroll
            for (int m = 0; m < 4; ++m) { bf16_t* rowp = O + (size_t)(row0 + ai * HALF + m * 16) * ldc + col0;
#pragma unroll
                for (int bj = 0; bj < 2; ++bj) { f32x4 v0 = acc[ai][bj][m][0] + bv[bj][0], v1 = acc[ai][bj][m][1] + bv[bj][1];
                    if (ACT == 1) {
#pragma unroll
                        for (int e = 0; e < 4; ++e) { const float a = fmaxf(v0[e], 0.f), b = fmaxf(v1[e], 0.f); v0[e] = a * a; v1[e] = b * b; } }
                    u32x4 w; w.x = cvt_pk_bf16(v0[0], v0[1]); w.y = cvt_pk_bf16(v0[2], v0[3]); w.z = cvt_pk_bf16(v1[0], v1[1]); w.w = cvt_pk_bf16(v1[2], v1[3]);
                    *(u32x4*)(rowp + bj * HALF) = w; } }
        return false;
    }
};
struct EpiResF32 {
    static constexpr bool PERM = false, AFTER_DRAIN = false, KEEPS = false;
    const float* base; float* out; const float* bias; float alpha;
    __device__ __forceinline__ bool operator()(f32x4 (&acc)[2][2][4][2], const Unit& u, int wr, int wc, int fr, int fq) const {
        const int row0 = u.pm * BM + wr * 64 + fr, col0 = u.pn * BM + wc * 32 + 4 * fq;
        f32x4 bv[2][2];
#pragma unroll
        for (int bj = 0; bj < 2; ++bj)
#pragma unroll
            for (int n = 0; n < 2; ++n) bv[bj][n] = bias ? *(const f32x4*)(bias + col0 + bj * HALF + n * 16) : (f32x4){0.f, 0.f, 0.f, 0.f};
#pragma unroll
        for (int ai = 0; ai < 2; ++ai)
#pragma unroll
            for (int m = 0; m < 4; ++m) { const size_t off = (size_t)(row0 + ai * HALF + m * 16) * 2048 + col0;
#pragma unroll
                for (int bj = 0; bj < 2; ++bj)
#pragma unroll
                    for (int n = 0; n < 2; ++n) { const f32x4 bs = *(const f32x4*)(base + off + bj * HALF + n * 16);
                        *(f32x4*)(out + off + bj * HALF + n * 16) = bs * alpha + (acc[ai][bj][m][n] + bv[bj][n]); }
                if (m & 1) asm volatile("" ::: "memory"); }
        return false;
    }
};

template <class Epi, class Sched, bool ALIGN_EPI = false>
__device__ __forceinline__ void gemm_phase(PG8_LAS unsigned char* lds, const Gemm g, const Sched& S, const Epi& E) {
    const int tid = threadIdx.x, wid = __builtin_amdgcn_readfirstlane(tid >> 6), lane = tid & 63, wr = wid >> 2, wc = wid & 3, fr = lane & 15, fq = lane >> 4;
    const int K = g.K, nt = K / BK, ld = g.ld;
    unsigned voffA[2], voffB[2];
#pragma unroll
    for (int i = 0; i < 2; ++i) { int R, C; stage_rc(tid * 16 + i * 8192, R, C); const int Rb = Epi::PERM ? ((R & ~31) + perm32(R & 31)) : R;
        voffA[i] = (unsigned)(R * ld + C) * 2u; voffB[i] = (unsigned)(Rb * ld + C) * 2u; }
    const size_t kstep = (size_t)(BK * 2);
    const size_t hstep = (size_t)HALF * ld * 2;
    const size_t tstep = 2 * hstep;
    const unsigned ldsw = (unsigned)wid * 1024u;
    const int aoff = lds_byte(wr * 64 + fr, fq * 8), boff = lds_byte(wc * 32 + fr, fq * 8);
#define PG8_SA(b, h) (((b) * 2 + (h)) * HTB)
#define PG8_SB(b, h) ((4 + (b) * 2 + (h)) * HTB)
#define PG8_STAGE(bufoff, gbase, voff) do { _Pragma("unroll") for (int _i = 0; _i < 2; ++_i) \
        __builtin_amdgcn_global_load_lds((const unsigned*)((const char*)(gbase) + (voff)[_i]), (PG8_LAS unsigned*)(lds + (bufoff) + ldsw + _i * 8192), 16, 0, 0); } while (0)
#define PG8_LDA(dst, b, h) do { _Pragma("unroll") for (int m = 0; m < 4; ++m) _Pragma("unroll") for (int k = 0; k < 2; ++k) dst[m][k] = *(const PG8_LAS bf16x8*)(lds + PG8_SA(b, h) + aoff + m * 2048 + k * 1024); } while (0)
#define PG8_LDB(dst, b, h) do { _Pragma("unroll") for (int n = 0; n < 2; ++n) _Pragma("unroll") for (int k = 0; k < 2; ++k) dst[n][k] = *(const PG8_LAS bf16x8*)(lds + PG8_SB(b, h) + boff + n * 2048 + k * 1024); } while (0)
#define PG8_MMA(ai, bj, At, Bt) do { __builtin_amdgcn_s_setprio(1); _Pragma("unroll") for (int m = 0; m < 4; ++m) _Pragma("unroll") for (int n = 0; n < 2; ++n) _Pragma("unroll") for (int k = 0; k < 2; ++k) \
        acc[ai][bj][m][n] = __builtin_amdgcn_mfma_f32_16x16x32_bf16(Bt[n][k], At[m][k], acc[ai][bj][m][n], 0, 0, 0); __builtin_amdgcn_s_setprio(0); } while (0)
#define PG8_WAIT_V(n) asm volatile("s_waitcnt vmcnt(" #n ")" ::: "memory")
#define PG8_WAIT_L(n) asm volatile("s_waitcnt lgkmcnt(" #n ")" ::: "memory")
#define PG8_BAR __builtin_amdgcn_s_barrier()
#define PG8_SCHED __builtin_amdgcn_sched_barrier(0)
    Unit cur, nxt; int ui = 0;
    if (!S.next(0, cur)) return;
    f32x4 acc[2][2][4][2];
#pragma unroll
    for (int a = 0; a < 2; ++a)
#pragma unroll
        for (int b = 0; b < 2; ++b)
#pragma unroll
            for (int m = 0; m < 4; ++m)
#pragma unroll
                for (int n = 0; n < 2; ++n) acc[a][b][m][n] = (f32x4){0.f, 0.f, 0.f, 0.f};
    bf16x8 At[4][2], B0[2][2], B1[2][2];
    const char* cA = (const char*)g.A + (size_t)cur.pm * tstep + (size_t)cur.kh * g.khstep; const char* cB = (const char*)g.Bt + (size_t)cur.pn * tstep + (size_t)cur.kh * g.khstep;
    PG8_STAGE(PG8_SB(0, 0), cB, voffB); PG8_STAGE(PG8_SB(0, 1), cB + hstep, voffB); PG8_STAGE(PG8_SA(0, 0), cA, voffA); PG8_STAGE(PG8_SA(0, 1), cA + hstep, voffA);
    if (wr == 1) PG8_BAR;
    PG8_WAIT_V(2); PG8_BAR;
    PG8_STAGE(PG8_SB(1, 0), cB + kstep, voffB); PG8_STAGE(PG8_SA(1, 0), cA + kstep, voffA); PG8_STAGE(PG8_SB(1, 1), cB + hstep + kstep, voffB);
    PG8_WAIT_V(6); PG8_BAR;
    for (;;) {
        const bool has_next = S.next(ui + 1, nxt);
        const char* nA = has_next ? (const char*)g.A + (size_t)nxt.pm * tstep + (size_t)nxt.kh * g.khstep : cA; const char* nB = has_next ? (const char*)g.Bt + (size_t)nxt.pn * tstep + (size_t)nxt.kh * g.khstep : cB;
        for (int t = 0; t < nt; t += 2) {
            const bool last = (t == nt - 2);
            const char* a1 = cA + (size_t)(t + 1) * kstep;
            const char* a2 = last ? nA : cA + (size_t)(t + 2) * kstep; const char* b2 = last ? nB : cB + (size_t)(t + 2) * kstep;
            const char* a3 = a2 + kstep; const char* b3 = b2 + kstep;
            PG8_LDB(B0, 0, 0); PG8_LDB(B1, 0, 1); PG8_SCHED; PG8_LDA(At, 0, 0); PG8_STAGE(PG8_SA(1, 1), a1 + hstep, voffA);
            PG8_WAIT_V(8); PG8_WAIT_L(0); PG8_BAR; PG8_MMA(0, 0, At, B0); PG8_MMA(0, 1, At, B1); PG8_BAR; PG8_SCHED;
            PG8_LDA(At, 0, 1); PG8_STAGE(PG8_SB(0, 0), b2, voffB); PG8_STAGE(PG8_SB(0, 1), b2 + hstep, voffB); PG8_STAGE(PG8_SA(0, 0), a2, voffA);
            PG8_WAIT_V(8); PG8_WAIT_L(0); PG8_BAR; PG8_MMA(1, 0, At, B0); PG8_MMA(1, 1, At, B1); PG8_BAR; PG8_SCHED;
            PG8_LDB(B0, 1, 0); PG8_LDB(B1, 1, 1); PG8_SCHED; PG8_LDA(At, 1, 0); PG8_STAGE(PG8_SA(0, 1), a2 + hstep, voffA);
            PG8_WAIT_V(8); PG8_WAIT_L(0); PG8_BAR; PG8_MMA(0, 0, At, B0); PG8_MMA(0, 1, At, B1); PG8_BAR; PG8_SCHED;
            PG8_LDA(At, 1, 1); PG8_STAGE(PG8_SB(1, 0), b3, voffB); PG8_STAGE(PG8_SB(1, 1), b3 + hstep, voffB); PG8_STAGE(PG8_SA(1, 0), a3, voffA);
            PG8_WAIT_V(8); PG8_WAIT_L(0); PG8_BAR; PG8_MMA(1, 0, At, B0); PG8_MMA(1, 1, At, B1); PG8_BAR; PG8_SCHED;
        }
        if constexpr (ALIGN_EPI) { if (wr == 0) PG8_BAR; }
        const bool keep = E(acc, cur, wr, wc, fr, fq);
        if (!has_next) break;
        if (!(Epi::KEEPS && keep)) {
#pragma unroll
            for (int a = 0; a < 2; ++a)
#pragma unroll
                for (int b = 0; b < 2; ++b)
#pragma unroll
                    for (int m = 0; m < 4; ++m)
#pragma unroll
                        for (int n = 0; n < 2; ++n) acc[a][b][m][n] = (f32x4){0.f, 0.f, 0.f, 0.f};
        }
        cur = nxt; cA = nA; cB = nB; ++ui;
        if constexpr (ALIGN_EPI) { if (wr == 1) PG8_BAR; }
    }
    PG8_WAIT_V(0);
    if constexpr (!ALIGN_EPI) { if (wr == 0) PG8_BAR; }
    PG8_BAR;
#undef PG8_SA
#undef PG8_SB
#undef PG8_STAGE
#undef PG8_LDA
#undef PG8_LDB
#undef PG8_MMA
#undef PG8_WAIT_V
#undef PG8_WAIT_L
#undef PG8_BAR
#undef PG8_SCHED
}
}

constexpr int NWAVES = 8;
constexpr int BATCH = 8, SEQ = 2048, DM = 2048, M = BATCH * SEQ;
constexpr int NH = 8, HD = 128, DA = 1024, DB = 1024, DFF = 8192, DIN = 9216;
constexpr int NPAT = 3;
constexpr float LN_EPS = 1e-5f;
constexpr float ALPHA = 1.189207115002721f;
constexpr float LOG2E = 1.4426950408889634f;
constexpr float QSCALE = 0.08838834764831845f * 1.4426950408889634f;

constexpr size_t MiB = 1u << 20;
constexpr size_t WS_CTL = 0, CTL_ZERO_BYTES = 256 * 1024;
constexpr size_t WS_VSTAT = 1 * MiB;
constexpr size_t WS_LSE = 3 * MiB;
constexpr size_t WS_WSP = 5 * MiB - 512 * 1024;
constexpr size_t WS_BTAB = 5 * MiB - 128 * 1024;
constexpr size_t WS_WIN = 5 * MiB;
constexpr size_t WS_O1 = 5 * MiB;
constexpr size_t WS_WPAB = 41 * MiB;
constexpr size_t WS_WOUT = 49 * MiB;
constexpr size_t WS_W1 = 57 * MiB;
constexpr size_t WS_W2 = 89 * MiB;
constexpr size_t WS_O0 = 57 * MiB, WS_O2 = 89 * MiB;
constexpr size_t WS_XB = 121 * MiB;
constexpr size_t WS_AG = WS_XB, WS_HB = WS_XB;
constexpr size_t WS_Q = 185 * MiB, WS_K = 217 * MiB, WS_V = 249 * MiB, WS_U = 281 * MiB, WS_VB = 313 * MiB;
constexpr size_t WS_GA = 345 * MiB, WS_GB = 409 * MiB;
constexpr size_t WS_MRG = WS_Q;
constexpr size_t WS_ACT = 185 * MiB;
constexpr size_t WS_MIX = WS_V;
constexpr size_t WS_FF = WS_WIN;
constexpr size_t WS_END = 473 * MiB;
constexpr int BT_PITCH = 132;
constexpr int CW_BAR = 4096;
constexpr int CW_CHK = 1024;
constexpr int CW_TS = 2048;

constexpr int RING_OFF = 0, RING_BYTES = 131072;
constexpr int LDSCTL_OFF = RING_BYTES, MISC_OFF = LDSCTL_OFF + 320;
constexpr int LDS_BT_OFF = RING_BYTES + 1024;
constexpr int LDS_BYTES = 147456;

#define GAS __attribute__((address_space(1)))
#define LAS __attribute__((address_space(3)))
typedef unsigned short bf16;
typedef unsigned v4u __attribute__((ext_vector_type(4)));
typedef unsigned v2u __attribute__((ext_vector_type(2)));
typedef float f32x4 __attribute__((ext_vector_type(4)));
typedef float f32x2 __attribute__((ext_vector_type(2)));
typedef short bf16x8 __attribute__((ext_vector_type(8)));
typedef short s16x4 __attribute__((ext_vector_type(4)));
typedef GAS unsigned gu32;
#define RLX_AGENT __ATOMIC_RELAXED, __HIP_MEMORY_SCOPE_AGENT
#define LDS_WAIT() asm volatile("s_waitcnt lgkmcnt(0)" ::: "memory")
#define VM_WAIT() asm volatile("s_waitcnt vmcnt(0)" ::: "memory")
__device__ __forceinline__ unsigned f2bf(float f) { unsigned u = __builtin_bit_cast(unsigned, f); return (u + 0x7fffu + ((u >> 16) & 1u)) >> 16; }
__device__ __forceinline__ unsigned pk2(float lo, float hi) { return f2bf(lo) | (f2bf(hi) << 16); }
__device__ __forceinline__ float bf2f(bf16 v) { return __uint_as_float((unsigned)v << 16); }

#define XB_TMO      128
#define XB_XCNT(j)  (256  + 64 * (j))
#define XB_XSUB(j)  (1280 + 64 * (j))
#define XB_XGEN(j)  (2304 + 64 * (j))
#define XB_TOP      3328
#define XB_TOPGEN   3392
#define XCD_BAR_WORDS 3456
#define XB_SPIN_CAP (1u << 22)
__device__ __forceinline__ unsigned xb_ld(unsigned* p)              { return __hip_atomic_load(p, __ATOMIC_RELAXED, __HIP_MEMORY_SCOPE_AGENT); }
__device__ __forceinline__ unsigned xb_add(unsigned* p, unsigned v) { return __hip_atomic_fetch_add(p, v, __ATOMIC_RELAXED, __HIP_MEMORY_SCOPE_AGENT); }
__device__ __forceinline__ unsigned xb_xcc_id() { return (unsigned)__builtin_amdgcn_s_getreg((3 << 11) | 20) & 0xFu; }
#define XB_SPIN(cond, bar) do { unsigned _sp = 0; while (cond) { __builtin_amdgcn_s_sleep(1); \
    if ((++_sp & 255u) == 0u) { if (xb_ld(&(bar)[XB_TMO])) break; if (_sp > XB_SPIN_CAP) { atomicAdd(&(bar)[XB_TMO], 1u); break; } } } } while (0)
struct XcdBarrier { unsigned* bar; unsigned x; volatile LAS unsigned* st; };
__device__ __forceinline__ XcdBarrier xcd_barrier_post(unsigned* bar, volatile LAS unsigned* st) {
    XcdBarrier b; b.bar = bar; b.x = xb_xcc_id(); b.st = st;
    if (threadIdx.x == 0) (void)xb_add(&bar[XB_XCNT(b.x)], 1u);
    return b;
}
__device__ __forceinline__ void xcd_barrier_complete(unsigned* bar, unsigned x, unsigned& nloc, unsigned& nx) {
    const unsigned G = gridDim.x * gridDim.y * gridDim.z;
    unsigned sum, cnt, mine, sp = 0u;
    for (;;) {
        sum = 0u; cnt = 0u; mine = 0u;
#pragma unroll
        for (unsigned j = 0; j < 16; ++j) { const unsigned c = xb_ld(&bar[XB_XCNT(j)]); sum += c; cnt += (c > 0u) ? 1u : 0u; mine = (j == x) ? c : mine; }
        if (sum == G) break;
        __builtin_amdgcn_s_sleep(1);
        if ((++sp & 255u) == 0u) { if (xb_ld(&bar[XB_TMO])) break; if (sp > XB_SPIN_CAP) { atomicAdd(&bar[XB_TMO], 1u); break; } }
    }
    nloc = mine > 0u ? mine : 1u; nx = cnt > 0u ? cnt : 1u;
}
__device__ __forceinline__ void xcd_barrier(const XcdBarrier& b) {
    asm volatile("s_waitcnt vmcnt(0)" ::: "memory");
    __syncthreads();
    if (threadIdx.x == 0) {
        unsigned* bar = b.bar;
        __builtin_amdgcn_s_waitcnt(0);
        unsigned nloc = b.st[0], nx = b.st[1];
        if (nloc == 0u) { xcd_barrier_complete(bar, b.x, nloc, nx); b.st[0] = nloc; b.st[1] = nx; }
        const unsigned old = xb_add(&bar[XB_XSUB(b.x)], 1u);
        const unsigned gen = old / nloc;
        if (old + 1u == (gen + 1u) * nloc) {
            __builtin_amdgcn_fence(__ATOMIC_RELEASE, "agent");
            asm volatile("s_waitcnt vmcnt(0)" ::: "memory");
            const unsigned og = xb_add(&bar[XB_TOP], 1u);
            const unsigned tg = og / nx;
            if (og + 1u == (tg + 1u) * nx) xb_add(&bar[XB_TOPGEN], 1u);
            else XB_SPIN(xb_ld(&bar[XB_TOPGEN]) == tg, bar);
            __builtin_amdgcn_fence(__ATOMIC_ACQUIRE, "agent");
            xb_add(&bar[XB_XGEN(b.x)], 1u);
            asm volatile("s_waitcnt vmcnt(0)" ::: "memory");
        } else {
            XB_SPIN(xb_ld(&bar[XB_XGEN(b.x)]) == gen, bar);
            __builtin_amdgcn_fence(__ATOMIC_ACQUIRE, "agent");
            asm volatile("s_waitcnt vmcnt(0)" ::: "memory");
        }
    }
    __syncthreads();
}

struct Args { const float* in[18]; float* out; unsigned char* ws; int ph_lo, ph_hi; };
struct Frame {
    LAS unsigned char* lds;
    int tid, lane, wave, G, bid;
    const float* const* in; float* out; unsigned char* ws;
};
__device__ __forceinline__ float wave_sum(float v) {
#pragma unroll
    for (int o = 1; o < 64; o <<= 1) v += __shfl_xor(v, o);
    return v;
}

struct TrItem { const float* W; bf16* WT; int N, ldt, koff, k0, n0, n0d; };
__device__ __forceinline__ TrItem tr_decode(const float* const* in, unsigned char* ws, int it) {
    constexpr int I_IN = (DM / 64) * (DIN / 64), I_PA = (DA / 64) * (DM / 64), I_OUT = (DM / 64) * (DM / 64), I_1 = (DM / 64) * (DFF / 64);
    TrItem t; bool rev = false; int r = it;
    if (r < I_IN) { t.W = in[1]; t.N = DIN; t.WT = (bf16*)(ws + WS_WIN); t.ldt = DM; t.koff = 0; rev = true; }
    else if ((r -= I_IN) < I_PA) { t.W = in[7]; t.N = DM; t.WT = (bf16*)(ws + WS_WPAB); t.ldt = 2048; t.koff = 0; }
    else if ((r -= I_PA) < I_PA) { t.W = in[8]; t.N = DM; t.WT = (bf16*)(ws + WS_WPAB); t.ldt = 2048; t.koff = 1024; }
    else if ((r -= I_PA) < I_OUT) { t.W = in[9]; t.N = DM; t.WT = (bf16*)(ws + WS_WOUT); t.ldt = 2048; t.koff = 0; }
    else if ((r -= I_OUT) < I_1) { t.W = in[12]; t.N = DFF; t.WT = (bf16*)(ws + WS_W1); t.ldt = DM; t.koff = 0; }
    else { r -= I_1; t.W = in[14]; t.N = DM; t.WT = (bf16*)(ws + WS_W2); t.ldt = DFF; t.koff = 0; }
    const int nblk = t.N / 64, sub = r & 7, grp = r >> 3, nb = 2 * (grp % (nblk / 2)) + (sub & 1), kb = 4 * (grp / (nblk / 2)) + (sub >> 1);
    t.k0 = 64 * kb; t.n0 = 64 * nb; t.n0d = rev ? (t.N / 256 - 1 - t.n0 / 256) * 256 + (t.n0 & 255) : t.n0;
    return t;
}
__device__ __forceinline__ void tr_load(const TrItem& t, int lane, f32x4 (&va)[8], f32x4 (&vb)[8]) {
    const int cg = lane & 15, rg = lane >> 4;
#pragma unroll
    for (int i = 0; i < 8; ++i) { const GAS float* src = (const GAS float*)t.W + (size_t)(t.k0 + 8 * i + 2 * rg) * t.N + t.n0 + 4 * cg; va[i] = *(const GAS f32x4*)src; vb[i] = *(const GAS f32x4*)(src + t.N); }
}
__device__ __forceinline__ void tr_store(const TrItem& t, int lane, const f32x4 (&va)[8], const f32x4 (&vb)[8], LAS unsigned* scr) {
    const int cg = lane & 15, rg = lane >> 4;
#pragma unroll
    for (int i = 0; i < 8; ++i) { const int kp = 4 * i + rg;
        scr[(4 * cg + 0) * 33 + kp] = pk2(va[i].x, vb[i].x); scr[(4 * cg + 1) * 33 + kp] = pk2(va[i].y, vb[i].y);
        scr[(4 * cg + 2) * 33 + kp] = pk2(va[i].z, vb[i].z); scr[(4 * cg + 3) * 33 + kp] = pk2(va[i].w, vb[i].w); }
    LDS_WAIT(); asm volatile("" ::: "memory");
    const int c = lane & 7;
#pragma unroll
    for (int j = 0; j < 8; ++j) { const int n = (lane >> 3) + 8 * j; const LAS unsigned* sp = scr + n * 33 + 4 * c;
        v4u o; o.x = sp[0]; o.y = sp[1]; o.z = sp[2]; o.w = sp[3];
        *(GAS v4u*)(t.WT + (size_t)(t.n0d + n) * t.ldt + t.koff + t.k0 + 8 * c) = o; }
    LDS_WAIT(); asm volatile("" ::: "memory");
}
__device__ __forceinline__ int t5_bucket(int n) {
    if (n < 16) return n;
    const float nf = (float)n;
    int large = 16 + (int)(logf(nf / 16.0f) / 4.852030263919617f * 16.0f);
    return large < 31 ? large : 31;
}
__device__ __forceinline__ int pat_dil(int p) { return p == 0 ? 1 : (p == 1 ? 4 : 16); }

__device__ __forceinline__ void phase_prologue(Frame& F) {
    LAS unsigned* scr = (LAS unsigned*)(F.lds + RING_OFF + F.wave * 16384);
    const int gw = F.bid * NWAVES + F.wave, NGW = F.G * NWAVES;
    constexpr int NITEMS = (DM / 64) * (DIN / 64) + 2 * (DA / 64) * (DM / 64) + (DM / 64) * (DM / 64) + 2 * (DM / 64) * (DFF / 64);
    {   f32x4 a0[8], b0[8], a1[8], b1[8];
        TrItem t0 = tr_decode(F.in, F.ws, gw < NITEMS ? gw : 0), t1 = t0;
        if (gw < NITEMS) tr_load(t0, F.lane, a0, b0);
        for (int it = gw; it < NITEMS; it += 2 * NGW) {
            const bool h1 = it + NGW < NITEMS, h2 = it + 2 * NGW < NITEMS;
            if (h1) { t1 = tr_decode(F.in, F.ws, it + NGW); tr_load(t1, F.lane, a1, b1); }
            tr_store(t0, F.lane, a0, b0, scr);
            if (h2) { t0 = tr_decode(F.in, F.ws, it + 2 * NGW); tr_load(t0, F.lane, a0, b0); }
            if (h1) tr_store(t1, F.lane, a1, b1, scr);
        }
    }
    const float* x = F.in[0]; bf16* XB = (bf16*)(F.ws + WS_XB);
    {   f32x4 v0[8], v1[8];
        if (gw < M) {
#pragma unroll
            for (int j = 0; j < 8; ++j) v0[j] = ((const GAS f32x4*)(x + (size_t)gw * DM) + F.lane)[64 * j]; }
        for (int m = gw; m < M; m += 2 * NGW) {
            const bool h1 = m + NGW < M, h2 = m + 2 * NGW < M;
            if (h1) {
#pragma unroll
                for (int j = 0; j < 8; ++j) v1[j] = ((const GAS f32x4*)(x + (size_t)(m + NGW) * DM) + F.lane)[64 * j]; }
            { GAS v2u* o = (GAS v2u*)(XB + (size_t)m * DM) + F.lane;
#pragma unroll
              for (int j = 0; j < 8; ++j) o[64 * j] = (v2u){pk2(v0[j].x, v0[j].y), pk2(v0[j].z, v0[j].w)}; }
            if (h2) {
#pragma unroll
                for (int j = 0; j < 8; ++j) v0[j] = ((const GAS f32x4*)(x + (size_t)(m + 2 * NGW) * DM) + F.lane)[64 * j]; }
            if (h1) { GAS v2u* o = (GAS v2u*)(XB + (size_t)(m + NGW) * DM) + F.lane;
#pragma unroll
              for (int j = 0; j < 8; ++j) o[64 * j] = (v2u){pk2(v1[j].x, v1[j].y), pk2(v1[j].z, v1[j].w)}; }
        }
    }
    const int gt = F.bid * (NWAVES * 64) + F.tid, NGT = F.G * NWAVES * 64;
    const float* wsp = F.in[5]; bf16* WSP = (bf16*)(F.ws + WS_WSP);
    for (int e = gt; e < 8 * 128 * 128; e += NGT) { const int i = (e >> 7) & 127, j = e & 127; WSP[e] = (bf16)(j <= i ? f2bf(wsp[e]) : 0u); }
    const float* rb = F.in[2]; float* BT = (float*)(F.ws + WS_BTAB);
    for (int e = gt; e < NPAT * NH * BT_PITCH; e += NGT) { const int p = e / (NH * BT_PITCH), h = (e / BT_PITCH) % NH, j = e % BT_PITCH;
        BT[e] = (j <= 128) ? rb[t5_bucket(j * pat_dil(p)) * NH + h] * LOG2E : 0.f; }
}
template <bool BASE_BF16>
__device__ __forceinline__ void phase_ln(Frame& F, const float* base, const bf16* baseb, const bf16* add, float* outf, const float* gain, const float* bias, bf16* ob) {
    const int gw = F.bid * NWAVES + F.wave, NGW = F.G * NWAVES;
    for (int m = gw; m < M; m += NGW) {
        const GAS v2u* ar = (const GAS v2u*)(add + (size_t)m * DM) + F.lane;
        f32x4 v[8]; float s = 0.f;
#pragma unroll
        for (int j = 0; j < 8; ++j) { f32x4 x;
            if constexpr (BASE_BF16) { const v2u xb = ((const GAS v2u*)(baseb + (size_t)m * DM) + F.lane)[64 * j]; x = (f32x4){pg8::bf_lo(xb.x), pg8::bf_hi(xb.x), pg8::bf_lo(xb.y), pg8::bf_hi(xb.y)}; }
            else x = ((const GAS f32x4*)(base + (size_t)m * DM) + F.lane)[64 * j];
            const v2u a = ar[64 * j];
            v[j] = x * ALPHA + (f32x4){pg8::bf_lo(a.x), pg8::bf_hi(a.x), pg8::bf_lo(a.y), pg8::bf_hi(a.y)}; s += (v[j].x + v[j].y) + (v[j].z + v[j].w); }
        const float mean = wave_sum(s) * (1.f / DM); float s2 = 0.f;
#pragma unroll
        for (int j = 0; j < 8; ++j) { v[j] = v[j] - mean; s2 += (v[j].x * v[j].x + v[j].y * v[j].y) + (v[j].z * v[j].z + v[j].w * v[j].w); }
        const float rstd = 1.f / sqrtf(wave_sum(s2) * (1.f / DM) + LN_EPS);
        GAS f32x4* orow = (GAS f32x4*)(outf + (size_t)m * DM) + F.lane;
#pragma unroll
        for (int j = 0; j < 8; ++j) { const f32x4 g = ((const GAS f32x4*)gain)[64 * j + F.lane], b = ((const GAS f32x4*)bias)[64 * j + F.lane];
            const f32x4 o = v[j] * rstd * g + b; if (outf) orow[64 * j] = o;
            if (ob) ((GAS v2u*)(ob + (size_t)m * DM))[64 * j + F.lane] = (v2u){pk2(o.x, o.y), pk2(o.z, o.w)}; }
    }
}
__device__ __forceinline__ s16x4 tr_read(const LAS unsigned char* p) { return __builtin_bit_cast(s16x4, __builtin_amdgcn_ds_read_tr16_b64_v4i16((LAS s16x4*)p)); }
constexpr int ATT_K_OFF = 0, ATT_V_OFF = 65536;

__device__ __forceinline__ void attn_qk(const LAS unsigned char* kprev, const LAS unsigned char* kcur, int kt_lo,
                                        int w, int lane, const bf16x8 (&qf)[4], const LAS float* BTp, f32x4 (&st)[9], float& mx_out, float& lsum_out) {
    const int fr = lane & 15, g = lane >> 4, qi = 16 * w + fr;
    float mx = -1e30f;
#pragma unroll
    for (int t = 0; t < 9; ++t) {
        const int kt = w + t;
        if (kt >= kt_lo) {
            f32x4 a = (f32x4){0.f, 0.f, 0.f, 0.f};
            const LAS unsigned char* kb = ((kt < 8) ? kprev : kcur) + (16 * (kt & 7) + fr) * 256;
#pragma unroll
            for (int ks = 0; ks < 4; ++ks) { const bf16x8 kf = *(const LAS bf16x8*)(kb + (((4 * ks + g) ^ fr) << 4));
                a = __builtin_amdgcn_mfma_f32_16x16x32_bf16(kf, qf[ks], a, 0, 0, 0); }
#pragma unroll
            for (int e = 0; e < 4; ++e) { const int kj = 16 * kt + 4 * g + e, steps = 128 + qi - kj; const bool ok = (steps >= 0) && (steps <= 128);
                const float v = ok ? a[e] + BTp[ok ? steps : 0] : -1e30f; a[e] = v; mx = fmaxf(mx, v); }
            st[t] = a;
        } else st[t] = (f32x4){-1e30f, -1e30f, -1e30f, -1e30f};
    }
    mx = fmaxf(mx, __shfl_xor(mx, 16)); mx = fmaxf(mx, __shfl_xor(mx, 32));
    float lsum = 0.f;
#pragma unroll
    for (int t = 0; t < 9; ++t)
#pragma unroll
        for (int e = 0; e < 4; ++e) { const float pv = pg8::fast_exp2(st[t][e] - mx); st[t][e] = pv; lsum += pv; }
    lsum += __shfl_xor(lsum, 16); lsum += __shfl_xor(lsum, 32);
    mx_out = mx; lsum_out = lsum;
}
__device__ __forceinline__ void attn_pv(const LAS unsigned char* vprev, const LAS unsigned char* vcur, int kt_lo, int w, int lane, const f32x4 (&st)[9], f32x4 (&o)[8]) {
    const int fr = lane & 15, g = lane >> 4;
#pragma unroll
    for (int mt = 0; mt < 8; ++mt) o[mt] = (f32x4){0.f, 0.f, 0.f, 0.f};
#pragma unroll
    for (int a = 0; a < 5; ++a) {
        const int kt0 = w + 2 * a, kt1 = kt0 + 1; const bool v0 = kt0 >= kt_lo, v1 = (2 * a + 1 <= 8) && (kt1 >= kt_lo);
        if (v0 || v1) {
            v4u pw; pw.x = pg8::cvt_pk_bf16(st[2 * a][0], st[2 * a][1]); pw.y = pg8::cvt_pk_bf16(st[2 * a][2], st[2 * a][3]);
            if (2 * a + 1 <= 8) { pw.z = pg8::cvt_pk_bf16(st[(2 * a + 1 <= 8) ? 2 * a + 1 : 0][0], st[(2 * a + 1 <= 8) ? 2 * a + 1 : 0][1]); pw.w = pg8::cvt_pk_bf16(st[(2 * a + 1 <= 8) ? 2 * a + 1 : 0][2], st[(2 * a + 1 <= 8) ? 2 * a + 1 : 0][3]); }
            else { pw.z = 0u; pw.w = 0u; }
            if (!v0) { pw.x = 0u; pw.y = 0u; }
            if (!v1) { pw.z = 0u; pw.w = 0u; }
            const bf16x8 pf = __builtin_bit_cast(bf16x8, pw);
            const int krow = 4 * g + (fr >> 2), ksw = ((krow & 7) << 1);
            const LAS unsigned char* v0p = ((kt0 < 8) ? vprev : vcur) + (16 * (kt0 & 7) + krow) * 256 + ((lane & 1) << 3);
            const LAS unsigned char* v1p = ((kt1 < 8) ? vprev : vcur) + (16 * (kt1 & 7) + krow) * 256 + ((lane & 1) << 3);
#pragma unroll
            for (int mt = 0; mt < 8; ++mt) {
                const int gsw = ((2 * mt + ((lane & 3) >> 1)) ^ ksw) << 4;
                s16x4 lo = (s16x4){0, 0, 0, 0}, hi = (s16x4){0, 0, 0, 0};
                if (v0) lo = tr_read(v0p + gsw);
                if (v1) hi = tr_read(v1p + gsw);
                const bf16x8 vf = (bf16x8){lo[0], lo[1], lo[2], lo[3], hi[0], hi[1], hi[2], hi[3]};
                o[mt] = __builtin_amdgcn_mfma_f32_16x16x32_bf16(vf, pf, o[mt], 0, 0, 0);
            }
        }
    }
}
#define ATT_RAW_BAR() do { LDS_WAIT(); __builtin_amdgcn_s_barrier(); asm volatile("" ::: "memory"); } while (0)

struct AStepA { int b, h, p, d, r, blk, first; };
__device__ __forceinline__ AStepA astepA(int vcu, int G, int t) {
    const int c = vcu + G * (t >> 2), s = t & 3, bh = c >> 3, cc = c & 7; AStepA u; u.b = bh >> 3; u.h = bh & 7; u.first = (s == 0);
    if (cc < 4) { u.p = 0; u.d = 1; u.r = 0; u.blk = 4 * cc + s; } else { u.p = 1; u.d = 4; u.r = cc - 4; u.blk = s; }
    return u;
}
__device__ __forceinline__ void attn_phaseA(Frame& F, int vcu, float* Opart) {
    const int tid = F.tid, lane = F.lane, w = F.wave, fr = lane & 15, g = lane >> 4;
    const bf16* Qg = (const bf16*)(F.ws + WS_Q); const bf16* Kg = (const bf16*)(F.ws + WS_K); const bf16* Vg = (const bf16*)(F.ws + WS_V);
    float* LSE = (float*)(F.ws + WS_LSE);
    LAS unsigned char* lds = F.lds;
    LAS float* BTl = (LAS float*)(lds + LDS_BT_OFF);
    for (int e = tid; e < NPAT * NH * BT_PITCH; e += NWAVES * 64) BTl[e] = ((const float*)(F.ws + WS_BTAB))[e];
    const int nsteps = (512 - vcu + F.G - 1) / F.G * 4;
    v4u kr[8], vr[8];
#define ATTA_PREFETCH(U) do { const size_t _rb = (size_t)(U).b * SEQ; const int _lo = ((U).first && (U).blk > 0) ? 0 : 4; \
        _Pragma("unroll") for (int it = 0; it < 8; ++it) if (it >= _lo) { const int idx = it * 512 + tid, kj = idx >> 4, gr = idx & 15; \
            const unsigned off = (unsigned)(((int)_rb + (U).r + (U).d * (128 * ((U).blk - 1) + kj)) * DA + (U).h * HD + gr * 8) * 2u;     \
            kr[it] = *(const GAS v4u*)((const GAS char*)Kg + off); vr[it] = *(const GAS v4u*)((const GAS char*)Vg + off); } } while (0)
#define ATTA_PREFETCH_Q(U) do { const unsigned _qoff = (unsigned)(((int)((U).b * SEQ) + (U).r + (U).d * (128 * (U).blk + 16 * w + fr)) * DA + (U).h * HD + 8 * g) * 2u; \
        _Pragma("unroll") for (int ks = 0; ks < 4; ++ks) qf[ks] = *(const GAS bf16x8*)((const GAS char*)Qg + _qoff + 64 * ks); } while (0)
    AStepA cur = astepA(vcu, F.G, 0);
    bf16x8 qf[4];
    if (nsteps > 0) { ATTA_PREFETCH(cur); ATTA_PREFETCH_Q(cur); }
    for (int t = 0; t < nsteps; ++t) {
        const int cslot = (t & 1) * 32768, pslot = 32768 - cslot;
        const bool ldprev = cur.first && cur.blk > 0;
        const int kt_lo = (cur.blk == 0) ? 8 : 0;
#pragma unroll
        for (int it = 0; it < 8; ++it) if (it >= 4 || ldprev) {
            const int idx = it * 512 + tid, kj = idx >> 4, gr = idx & 15, row = kj & 127, slot = (it < 4) ? pslot : cslot;
            *(LAS v4u*)(lds + ATT_K_OFF + slot + row * 256 + ((gr ^ (row & 15)) << 4)) = kr[it];
            *(LAS v4u*)(lds + ATT_V_OFF + slot + row * 256 + ((gr ^ ((row & 7) << 1)) << 4)) = vr[it];
        }
#pragma unroll
        for (int ks = 0; ks < 4; ++ks) asm volatile("" : "+v"(qf[ks]));
        ATT_RAW_BAR();
        const AStepA me = cur;
        if (t + 1 < nsteps) { cur = astepA(vcu, F.G, t + 1); ATTA_PREFETCH(cur); }
        f32x4 st[9], o[8]; float mx, lsum;
        attn_qk(lds + ATT_K_OFF + pslot, lds + ATT_K_OFF + cslot, kt_lo, w, lane, qf, BTl + (me.p * NH + me.h) * BT_PITCH, st, mx, lsum);
        if (t + 1 < nsteps) ATTA_PREFETCH_Q(cur);
        attn_pv(lds + ATT_V_OFF + pslot, lds + ATT_V_OFF + cslot, kt_lo, w, lane, st, o);
        const size_t qrow = (size_t)me.b * SEQ + me.r + me.d * (128 * me.blk + 16 * w + fr);
        const float inv = 1.0f / lsum;
        bf16* orow = (bf16*)Opart + (size_t)me.p * M * DA + qrow * DA + me.h * HD + 4 * g;
#pragma unroll
        for (int mt = 0; mt < 8; ++mt) { const f32x4 v = o[mt] * inv; *(GAS v2u*)(orow + 16 * mt) = (v2u){pg8::cvt_pk_bf16(v[0], v[1]), pg8::cvt_pk_bf16(v[2], v[3])}; }
        if (g == 0) LSE[((size_t)me.p * M + qrow) * NH + me.h] = mx + log2f(lsum);
        ATT_RAW_BAR();
    }
#undef ATTA_PREFETCH
#undef ATTA_PREFETCH_Q
}
__device__ __forceinline__ void attn_phaseB(Frame& F, int vcu, const float* Opart) {
    const int tid = F.tid, lane = F.lane, w = F.wave, fr = lane & 15, g = lane >> 4;
    const bf16* Qg = (const bf16*)(F.ws + WS_Q); const bf16* Kg = (const bf16*)(F.ws + WS_K); const bf16* Vg = (const bf16*)(F.ws + WS_V);
    const float* LSE = (const float*)(F.ws + WS_LSE); bf16* AG = (bf16*)(F.ws + WS_AG);
    const bf16* O0 = (const bf16*)Opart; const bf16* O1 = O0 + (size_t)M * DA;
    LAS unsigned char* lds = F.lds;
    LAS float* BTl = (LAS float*)(lds + LDS_BT_OFF);
    for (int e = tid; e < NPAT * NH * BT_PITCH; e += NWAVES * 64) BTl[e] = ((const float*)(F.ws + WS_BTAB))[e];
    constexpr int NU = BATCH * NH * 16;
    v4u kr[4], vr[4]; bf16x8 qn[4];
#define ATTB_PREFETCH(UID) do { const int _bh = (UID) >> 4, _r = (UID) & 15; const size_t _rb = (size_t)(_bh >> 3) * SEQ; const int _h = _bh & 7; \
        _Pragma("unroll") for (int it = 0; it < 4; ++it) { const int idx = it * 512 + tid, kj = idx >> 4, gr = idx & 15; \
            const unsigned off = (unsigned)(((int)_rb + _r + 16 * kj) * DA + _h * HD + gr * 8) * 2u; \
            kr[it] = *(const GAS v4u*)((const GAS char*)Kg + off); vr[it] = *(const GAS v4u*)((const GAS char*)Vg + off); } \
        const unsigned _qoff = (unsigned)(((int)_rb + _r + 16 * (16 * w + fr)) * DA + _h * HD + 8 * g) * 2u; \
        _Pragma("unroll") for (int ks = 0; ks < 4; ++ks) qn[ks] = *(const GAS bf16x8*)((const GAS char*)Qg + _qoff + 64 * ks); } while (0)
    int uid = vcu;
    if (uid < NU) ATTB_PREFETCH(uid);
    for (int t = 0; uid < NU; uid += F.G, ++t) {
        const int cslot = (t & 1) * 32768;
#pragma unroll
        for (int it = 0; it < 4; ++it) { const int idx = it * 512 + tid, row = idx >> 4, gr = idx & 15;
            *(LAS v4u*)(lds + ATT_K_OFF + cslot + row * 256 + ((gr ^ (row & 15)) << 4)) = kr[it];
            *(LAS v4u*)(lds + ATT_V_OFF + cslot + row * 256 + ((gr ^ ((row & 7) << 1)) << 4)) = vr[it]; }
        bf16x8 qf[4];
#pragma unroll
        for (int ks = 0; ks < 4; ++ks) { qf[ks] = qn[ks]; asm volatile("" : "+v"(qf[ks])); }
        ATT_RAW_BAR();
        const int bh = uid >> 4, r = uid & 15, b = bh >> 3, h = bh & 7;
        const size_t qrow = (size_t)b * SEQ + r + 16 * (16 * w + fr);
        const float l0 = LSE[((size_t)0 * M + qrow) * NH + h], l1 = LSE[((size_t)1 * M + qrow) * NH + h];
        if (uid + F.G < NU) ATTB_PREFETCH(uid + F.G);
        f32x4 st[9], o[8]; float mx, lsum;
        attn_qk(lds + ATT_K_OFF + cslot, lds + ATT_K_OFF + cslot, 8, w, lane, qf, BTl + (2 * NH + h) * BT_PITCH, st, mx, lsum);
        attn_pv(lds + ATT_V_OFF + cslot, lds + ATT_V_OFF + cslot, 8, w, lane, st, o);
        v2u p0[8], p1[8];
        {   const bf16* a0 = O0 + qrow * DA + h * HD + 4 * g; const bf16* a1 = O1 + qrow * DA + h * HD + 4 * g;
#pragma unroll
            for (int mt = 0; mt < 8; ++mt) { p0[mt] = *(const GAS v2u*)(a0 + 16 * mt); p1[mt] = *(const GAS v2u*)(a1 + 16 * mt); } }
        const float l2 = mx + log2f(lsum), lm = fmaxf(l2, fmaxf(l0, l1));
        float w0 = exp2f(l0 - lm), w1 = exp2f(l1 - lm), w2 = exp2f(l2 - lm); const float zi = 1.0f / (w0 + w1 + w2); w0 *= zi; w1 *= zi; w2 *= zi / lsum;
        bf16* orow = AG + qrow * 2048 + h * HD + 4 * g;
#pragma unroll
        for (int mt = 0; mt < 8; ++mt) {
            const float y0 = w2 * o[mt][0] + w0 * pg8::bf_lo(p0[mt].x) + w1 * pg8::bf_lo(p1[mt].x), y1 = w2 * o[mt][1] + w0 * pg8::bf_hi(p0[mt].x) + w1 * pg8::bf_hi(p1[mt].x);
            const float y2 = w2 * o[mt][2] + w0 * pg8::bf_lo(p0[mt].y) + w1 * pg8::bf_lo(p1[mt].y), y3 = w2 * o[mt][3] + w0 * pg8::bf_hi(p0[mt].y) + w1 * pg8::bf_hi(p1[mt].y);
            *(GAS v2u*)(orow + 16 * mt) = (v2u){pg8::cvt_pk_bf16(y0, y1), pg8::cvt_pk_bf16(y2, y3)}; }
        ATT_RAW_BAR();
    }
#undef ATTB_PREFETCH
}

__device__ __forceinline__ void gmlp_unit(Frame& F, int uid) {
    const int gg = uid & 7, c = (uid >> 3) & 15, b = uid >> 7;
    const int tid = F.tid, lane = F.lane, w = F.wave, fr = lane & 15, g = lane >> 4;
    LAS unsigned char* lds = F.lds;
    LAS f32x2* STl = (LAS f32x2*)(lds + LDS_BT_OFF);
    const size_t R0 = (size_t)b * SEQ + 128 * c;
    const bf16* VBg = (const bf16*)(F.ws + WS_VB); const bf16* Ug = (const bf16*)(F.ws + WS_U); const bf16* WSP = (const bf16*)(F.ws + WS_WSP) + (size_t)gg * 128 * 128;
    const f32x2* VST = (const f32x2*)(F.ws + WS_VSTAT); bf16* AG = (bf16*)(F.ws + WS_AG);
    const float* gain = F.in[3]; const float* biasv = F.in[4]; const float* bsp = F.in[6];
    const int i = 16 * w + fr, nks = (w >> 1) + 1;
    v4u st8[8];
    if (tid < 128) {
#pragma unroll
        for (int k = 0; k < 8; ++k) st8[k] = *(const GAS v4u*)(VST + (R0 + tid) * 16 + 2 * k);
    }
    v4u raw[4];
#pragma unroll
    for (int it = 0; it < 4; ++it) { const int idx = it * 512 + tid, j = idx >> 4, gr = idx & 15; raw[it] = *(const GAS v4u*)(VBg + (R0 + j) * DB + gg * 128 + gr * 8); }
    const int gr0 = tid & 15;
    const f32x4 g0 = *(const GAS f32x4*)(gain + gg * 128 + gr0 * 8), g1 = *(const GAS f32x4*)(gain + gg * 128 + gr0 * 8 + 4);
    const f32x4 b0 = *(const GAS f32x4*)(biasv + gg * 128 + gr0 * 8), b1 = *(const GAS f32x4*)(biasv + gg * 128 + gr0 * 8 + 4);
    bf16x8 wf[4];
#pragma unroll
    for (int ks = 0; ks < 4; ++ks) wf[ks] = (ks < nks) ? *(const GAS bf16x8*)(WSP + (size_t)i * 128 + 32 * ks + 8 * g) : (bf16x8){0, 0, 0, 0, 0, 0, 0, 0};
    const bf16* urow = Ug + (R0 + i) * DB + gg * 128 + 4 * g;
    v2u uu[8];
#pragma unroll
    for (int mt = 0; mt < 8; ++mt) uu[mt] = *(const GAS v2u*)(urow + 16 * mt);
    const float bs = bsp[gg * 128 + i];
    if (tid < 128) { float s1 = 0.f, s2 = 0.f;
#pragma unroll
        for (int k = 0; k < 8; ++k) { s1 += __uint_as_float(st8[k].x) + __uint_as_float(st8[k].z); s2 += __uint_as_float(st8[k].y) + __uint_as_float(st8[k].w); }
        const float mean = s1 * (1.f / DB), var = fmaxf(s2 * (1.f / DB) - mean * mean, 0.f);
        STl[tid] = (f32x2){mean, 1.0f / sqrtf(var + LN_EPS)}; }
    LDS_WAIT(); __builtin_amdgcn_s_barrier(); asm volatile("" ::: "memory");
#pragma unroll
    for (int it = 0; it < 4; ++it) {
        const int idx = it * 512 + tid, j = idx >> 4, gr = idx & 15;
        const f32x2 st = STl[j]; const v4u r4 = raw[it];
        v4u o;
        o.x = pk2((pg8::bf_lo(r4.x) - st.x) * st.y * g0[0] + b0[0], (pg8::bf_hi(r4.x) - st.x) * st.y * g0[1] + b0[1]);
        o.y = pk2((pg8::bf_lo(r4.y) - st.x) * st.y * g0[2] + b0[2], (pg8::bf_hi(r4.y) - st.x) * st.y * g0[3] + b0[3]);
        o.z = pk2((pg8::bf_lo(r4.z) - st.x) * st.y * g1[0] + b1[0], (pg8::bf_hi(r4.z) - st.x) * st.y * g1[1] + b1[1]);
        o.w = pk2((pg8::bf_lo(r4.w) - st.x) * st.y * g1[2] + b1[2], (pg8::bf_hi(r4.w) - st.x) * st.y * g1[3] + b1[3]);
        *(LAS v4u*)(lds + j * 256 + ((gr ^ ((j & 7) << 1)) << 4)) = o;
    }
    LDS_WAIT(); __builtin_amdgcn_s_barrier(); asm volatile("" ::: "memory");
    f32x4 acc[8];
#pragma unroll
    for (int mt = 0; mt < 8; ++mt) acc[mt] = (f32x4){0.f, 0.f, 0.f, 0.f};
#pragma unroll
    for (int ks = 0; ks < 4; ++ks) if (ks < nks) {
        const int j0 = 32 * ks + 8 * g + (fr >> 2), j1 = j0 + 4;
        const LAS unsigned char* p0 = lds + j0 * 256 + ((lane & 1) << 3); const LAS unsigned char* p1 = lds + j1 * 256 + ((lane & 1) << 3);
        const int s0 = (j0 & 7) << 1, s1 = (j1 & 7) << 1;
#pragma unroll
        for (int mt = 0; mt < 8; ++mt) {
            const int gb = 2 * mt + ((lane & 3) >> 1);
            const s16x4 lo = tr_read(p0 + ((gb ^ s0) << 4)), hi = tr_read(p1 + ((gb ^ s1) << 4));
            const bf16x8 vf = (bf16x8){lo[0], lo[1], lo[2], lo[3], hi[0], hi[1], hi[2], hi[3]};
            acc[mt] = __builtin_amdgcn_mfma_f32_16x16x32_bf16(vf, wf[ks], acc[mt], 0, 0, 0);
        }
    }
    bf16* orow = AG + (R0 + i) * 2048 + 1024 + gg * 128 + 4 * g;
#pragma unroll
    for (int mt = 0; mt < 8; ++mt) {
        const float z0 = (acc[mt][0] + bs) * pg8::bf_lo(uu[mt].x), z1 = (acc[mt][1] + bs) * pg8::bf_hi(uu[mt].x), z2 = (acc[mt][2] + bs) * pg8::bf_lo(uu[mt].y), z3 = (acc[mt][3] + bs) * pg8::bf_hi(uu[mt].y);
        *(GAS v2u*)(orow + 16 * mt) = (v2u){pg8::cvt_pk_bf16(z0, z1), pg8::cvt_pk_bf16(z2, z3)}; }
    LDS_WAIT(); __builtin_amdgcn_s_barrier(); asm volatile("" ::: "memory");
}
__device__ __forceinline__ int vcu_of(const Frame& F) { return (F.G % 8 == 0) ? (F.bid & 7) * (F.G >> 3) + (F.bid >> 3) : F.bid; }
__device__ __forceinline__ void phase_attnA(Frame& F) { attn_phaseA(F, vcu_of(F), F.out); }
__device__ __forceinline__ void phase_attnB(Frame& F) { attn_phaseB(F, vcu_of(F), F.out); }
__device__ __forceinline__ void phase_gmlp(Frame& F) {
    for (int u = F.bid; u < BATCH * 16 * 8; u += F.G) gmlp_unit(F, u);
}

constexpr int N_PHASES = 11;
__global__ void __launch_bounds__(NWAVES * 64, 2) mk_fwd(Args args) {
    extern __shared__ __attribute__((aligned(16))) unsigned char lds_raw[];
    Frame F;
    F.lds = (LAS unsigned char*)lds_raw;
    F.tid = threadIdx.x; F.lane = F.tid & 63; F.wave = __builtin_amdgcn_readfirstlane(F.tid >> 6);
    F.G = gridDim.x; F.bid = blockIdx.x; F.in = args.in; F.out = args.out; F.ws = args.ws;
    for (int u = F.tid; u < (LDS_BYTES - LDSCTL_OFF) / 4; u += NWAVES * 64) ((LAS unsigned*)(F.lds + LDSCTL_OFF))[u] = 0u;
    __syncthreads();
    gu32* ctl = (gu32*)(args.ws + WS_CTL);
    const int lo = args.ph_lo, hi = args.ph_hi;
    XcdBarrier bar; bar.bar = (unsigned*)(ctl + CW_BAR); bar.x = 0; bar.st = nullptr;
    if (hi - lo > 1) bar = xcd_barrier_post((unsigned*)(ctl + CW_BAR), (volatile LAS unsigned*)(F.lds + MISC_OFF) + 8);
#define IN(k) (lo <= (k) && (k) < hi)
#define STAMP(k) do { if (MK_TPROBE && F.bid == 0 && F.tid == 0) ((unsigned long long*)(ctl + CW_TS))[k] = __builtin_amdgcn_s_memrealtime(); } while (0)
#define SEAM(k) do { if (IN(k) && IN((k) + 1)) xcd_barrier(bar); STAMP((k) + 1); } while (0)
    STAMP(0);
    unsigned char* ws = args.ws;
    if (IN(0)) { phase_prologue(F); SEAM(0); }
    if (IN(1)) {
        pg8::Gemm g{(const bf16*)(ws + WS_XB), (const bf16*)(ws + WS_WIN), DM, DM, 0}; pg8::StaticOrder S; S.init(M, DIN, F.G, F.bid);
        pg8::EpiProj E{(bf16*)(ws + WS_Q), (bf16*)(ws + WS_K), (bf16*)(ws + WS_V), (bf16*)(ws + WS_U), (bf16*)(ws + WS_VB), (bf16*)(ws + WS_GA), (bf16*)(ws + WS_GB), (pg8::f32x2*)(ws + WS_VSTAT), QSCALE};
        pg8::gemm_phase<pg8::EpiProj, pg8::StaticOrder, true>(F.lds + RING_OFF, g, S, E);
        SEAM(1);
    }
    if (IN(2)) { phase_attnA(F); if (MK_TPROBE) SEAM(2); }
    if (IN(3)) { phase_gmlp(F); SEAM(3); }
    if (IN(4)) { phase_attnB(F); SEAM(4); }
    if (IN(5)) {
        pg8::Gemm g{(const bf16*)(ws + WS_AG), (const bf16*)(ws + WS_WPAB), 1024, 2048, 2048}; pg8::PairOrder S; S.so.init(M, DM, F.G, F.bid);
        pg8::EpiGate E{(const unsigned char*)(ws + WS_GA), (const unsigned char*)(ws + WS_GB), (bf16*)(ws + WS_MRG)};
        pg8::gemm_phase<pg8::EpiGate, pg8::PairOrder, true>(F.lds + RING_OFF, g, S, E);
        SEAM(5);
    }
    if (IN(6)) {
        pg8::Gemm g{(const bf16*)(ws + WS_MRG), (const bf16*)(ws + WS_WOUT), DM, DM, 0}; pg8::StaticOrder S; S.init(M, DM, F.G, F.bid);
        pg8::EpiBiasAct<0> E{(bf16*)(ws + WS_MIX), DM, nullptr};
        pg8::gemm_phase<pg8::EpiBiasAct<0>, pg8::StaticOrder, true>(F.lds + RING_OFF, g, S, E);
        SEAM(6);
    }
    if (IN(7)) { phase_ln<false>(F, args.in[0], nullptr, (const bf16*)(ws + WS_MIX), nullptr, args.in[10], args.in[11], (bf16*)(ws + WS_HB)); SEAM(7); }
    if (IN(8)) {
        pg8::Gemm g{(const bf16*)(ws + WS_HB), (const bf16*)(ws + WS_W1), DM, DM, 0}; pg8::StaticOrder S; S.init(M, DFF, F.G, F.bid);
        pg8::EpiBiasAct<1> E{(bf16*)(ws + WS_ACT), DFF, args.in[13]};
        pg8::gemm_phase<pg8::EpiBiasAct<1>, pg8::StaticOrder, true>(F.lds + RING_OFF, g, S, E);
        SEAM(8);
    }
    if (IN(9)) {
        pg8::Gemm g{(const bf16*)(ws + WS_ACT), (const bf16*)(ws + WS_W2), DFF, DFF, 0}; pg8::StaticOrder S; S.init(M, DM, F.G, F.bid);
        pg8::EpiBiasAct<0> E{(bf16*)(ws + WS_FF), DM, args.in[15]};
        pg8::gemm_phase<pg8::EpiBiasAct<0>, pg8::StaticOrder, true>(F.lds + RING_OFF, g, S, E);
        SEAM(9);
    }
    if (IN(10)) { phase_ln<true>(F, nullptr, (const bf16*)(ws + WS_HB), (const bf16*)(ws + WS_FF), args.out, args.in[16], args.in[17], nullptr); }
#if MK_TPROBE
    if (hi - lo > 1) {
        xcd_barrier(bar); STAMP(11);
        if (F.bid == 0 && F.tid == 0) {
            const unsigned long long* ts = (const unsigned long long*)(ctl + CW_TS);
            const unsigned long long dt = (ts[MK_TPA + 1] - ts[MK_TPA]) * (unsigned long long)(MK_TPB), t0 = __builtin_amdgcn_s_memrealtime();
            while (__builtin_amdgcn_s_memrealtime() - t0 < dt) __builtin_amdgcn_s_sleep(20);
        }
    }
#endif
#undef IN
#undef SEAM
}

#if MK_DEBUG_CHECKS
__device__ __forceinline__ unsigned hsh(unsigned x) { x ^= x >> 16; x *= 0x7feb352dU; x ^= x >> 15; x *= 0x846ca68bU; x ^= x >> 16; return x; }
__device__ float dot_bf(const bf16* a, const bf16* b, int K) { float s = 0.f; for (int k = 0; k < K; ++k) s += bf2f(a[k]) * bf2f(b[k]); return s; }
__device__ __forceinline__ bool bad(float got, float ex, float rt, float at) { return !(fabsf(got - ex) <= at + rt * fabsf(ex)); }
__device__ float gelu_ref(float v) { return 0.5f * v * (1.0f + tanhf(0.7978845608028654f * (v + 0.044715f * v * v * v))); }
__global__ void mk_check(Args args, int stage) {
    const unsigned gid = blockIdx.x * blockDim.x + threadIdx.x; unsigned char* ws = args.ws; unsigned* flag = (unsigned*)(ws + WS_CTL) + CW_CHK + stage;
    const unsigned h1 = hsh(gid * 2654435761u + 17u * stage + 1u), h2 = hsh(h1 + 0x9e3779b9u), h3 = hsh(h2 + 0x85ebca6bu);
    bool fail = false;
    if (stage == 0) {
        const int sel = gid % 7;
        if (sel == 0) { const int n = h1 % DIN, k = h2 % DM; fail = ((const bf16*)(ws + WS_WIN))[(size_t)n * DM + k] != (bf16)f2bf(args.in[1][(size_t)k * DIN + n]); }
        else if (sel == 1) { const int n = h1 % DM, k = h2 % DA; fail = ((const bf16*)(ws + WS_WPAB))[(size_t)n * 2048 + k] != (bf16)f2bf(args.in[7][(size_t)k * DM + n]); }
        else if (sel == 2) { const int n = h1 % DM, k = h2 % DB; fail = ((const bf16*)(ws + WS_WPAB))[(size_t)n * 2048 + 1024 + k] != (bf16)f2bf(args.in[8][(size_t)k * DM + n]); }
        else if (sel == 3) { const int n = h1 % DM, k = h2 % DM; fail = ((const bf16*)(ws + WS_WOUT))[(size_t)n * DM + k] != (bf16)f2bf(args.in[9][(size_t)k * DM + n]); }
        else if (sel == 4) { const int m = h1 % M, k = h2 % DM; fail = ((const bf16*)(ws + WS_XB))[(size_t)m * DM + k] != (bf16)f2bf(args.in[0][(size_t)m * DM + k]); }
        else if (sel == 5) { const int e = h1 % (8 * 128 * 128), i = (e >> 7) & 127, j = e & 127; fail = ((const bf16*)(ws + WS_WSP))[e] != (bf16)(j <= i ? f2bf(args.in[5][e]) : 0u); }
        else { const int p = h1 % 3, h = h2 % 8, j = h3 % 129; const float ex = args.in[2][t5_bucket(j * pat_dil(p)) * NH + h] * LOG2E; fail = bad(((const float*)(ws + WS_BTAB))[(p * NH + h) * BT_PITCH + j], ex, 1e-5f, 1e-6f); }
    } else if (stage == 1) {
        const int row = h1 % M, col = h2 % DIN;
        if (gid < 7680) {
            const float dv = dot_bf((const bf16*)(ws + WS_XB) + (size_t)row * DM, (const bf16*)(ws + WS_WIN) + (size_t)col * DM, DM);
            float ex, got;
            if (col < 1024) { ex = dv * QSCALE; got = bf2f(((const bf16*)(ws + WS_Q))[(size_t)row * 1024 + col]); }
            else if (col < 2048) { ex = dv; got = bf2f(((const bf16*)(ws + WS_K))[(size_t)row * 1024 + col - 1024]); }
            else if (col < 3072) { ex = dv; got = bf2f(((const bf16*)(ws + WS_V))[(size_t)row * 1024 + col - 2048]); }
            else if (col < 4096) { ex = gelu_ref(dv); got = bf2f(((const bf16*)(ws + WS_U))[(size_t)row * 1024 + col - 3072]); }
            else if (col < 5120) { ex = gelu_ref(dv); got = bf2f(((const bf16*)(ws + WS_VB))[(size_t)row * 1024 + col - 4096]); }
            else if (col < 7168) { ex = dv; got = bf2f(((const bf16*)(ws + WS_GA))[(size_t)row * 2048 + col - 5120]); }
            else { ex = dv; got = bf2f(((const bf16*)(ws + WS_GB))[(size_t)row * 2048 + col - 7168]); }
            fail = bad(got, ex, 1.5e-2f, 1e-2f);
        } else {
            float s1 = 0.f, s2 = 0.f; for (int c = 0; c < 1024; ++c) { const float v = bf2f(((const bf16*)(ws + WS_VB))[(size_t)row * 1024 + c]); s1 += v; s2 += v * v; }
            float t1 = 0.f, t2 = 0.f; for (int k = 0; k < 16; ++k) { const f32x2 t = ((const f32x2*)(ws + WS_VSTAT))[(size_t)row * 16 + k]; t1 += t.x; t2 += t.y; }
            fail = bad(t1, s1, 1e-2f, 1.0f) || bad(t2, s2, 1e-2f, 1.0f);
        }
    } else if (stage == 2) {
        if (gid < 6144) {
            const int b = h1 % BATCH, s = h2 % SEQ, h = h3 % NH, p = (h3 >> 8) % 3, d = pat_dil(p);
            const bf16* Qg = (const bf16*)(ws + WS_Q); const bf16* Kg = (const bf16*)(ws + WS_K); const bf16* Vg = (const bf16*)(ws + WS_V);
            const bf16* Og = (const bf16*)(ws + (p == 0 ? WS_O0 : (p == 1 ? WS_O1 : WS_O2))); const float* BT = (const float*)(ws + WS_BTAB) + (p * NH + h) * BT_PITCH;
            const size_t qrow = (size_t)b * SEQ + s; float mx = -1e30f;
            for (int j = 0; j <= 128; ++j) { const int sk = s - j * d; if (sk < 0) break; const float sc = dot_bf(Qg + qrow * DA + h * HD, Kg + ((size_t)b * SEQ + sk) * DA + h * HD, HD) + BT[j]; mx = fmaxf(mx, sc); }
            float den = 0.f; for (int j = 0; j <= 128; ++j) { const int sk = s - j * d; if (sk < 0) break; const float sc = dot_bf(Qg + qrow * DA + h * HD, Kg + ((size_t)b * SEQ + sk) * DA + h * HD, HD) + BT[j]; den += exp2f(sc - mx); }
            const float l2 = mx + log2f(den);
            fail = bad(((const float*)(ws + WS_LSE))[((size_t)p * M + qrow) * NH + h], l2, 2e-3f, 2e-2f);
            for (int dd = 0; dd < HD; dd += 7) { float o = 0.f;
                for (int j = 0; j <= 128; ++j) { const int sk = s - j * d; if (sk < 0) break; const float sc = dot_bf(Qg + qrow * DA + h * HD, Kg + ((size_t)b * SEQ + sk) * DA + h * HD, HD) + BT[j]; o += exp2f(sc - mx) * bf2f(Vg[((size_t)b * SEQ + sk) * DA + h * HD + dd]); }
                o /= den; fail = fail || bad(bf2f(Og[qrow * DA + h * HD + dd]), o, 3e-2f, 1e-2f); }
        } else {
            const int row = h1 % M, ch = h2 % DB, gg = ch >> 7, i = row & 127; const size_t R0 = (size_t)(row - i);
            const bf16* WSP = (const bf16*)(ws + WS_WSP) + (size_t)gg * 128 * 128;
            float z = args.in[6][gg * 128 + i];
            for (int j = 0; j <= i; ++j) { float s1 = 0.f, s2 = 0.f; for (int k = 0; k < 16; ++k) { const f32x2 t = ((const f32x2*)(ws + WS_VSTAT))[(R0 + j) * 16 + k]; s1 += t.x; s2 += t.y; }
                const float mean = s1 / DB, var = fmaxf(s2 / DB - mean * mean, 0.f), rstd = 1.0f / sqrtf(var + LN_EPS);
                const float vn = (bf2f(((const bf16*)(ws + WS_VB))[(R0 + j) * DB + ch]) - mean) * rstd * args.in[3][ch] + args.in[4][ch];
                z += bf2f(WSP[i * 128 + j]) * bf2f((bf16)f2bf(vn)); }
            const float ex = z * bf2f(((const bf16*)(ws + WS_U))[(size_t)row * DB + ch]);
            fail = bad(bf2f(((const bf16*)(ws + WS_AG))[(size_t)row * 2048 + 1024 + ch]), ex, 2e-2f, 1e-2f);
        }
    } else if (stage == 3) {
        const int row = h1 % M, col = h2 % DA, h = col >> 7; const float* LSE = (const float*)(ws + WS_LSE);
        const float l0 = LSE[((size_t)0 * M + row) * NH + h], l1 = LSE[((size_t)1 * M + row) * NH + h], l2 = LSE[((size_t)2 * M + row) * NH + h], mx = fmaxf(l0, fmaxf(l1, l2));
        const float w0 = exp2f(l0 - mx), w1 = exp2f(l1 - mx), w2 = exp2f(l2 - mx);
        const float ex = (w0 * bf2f(((const bf16*)(ws + WS_O0))[(size_t)row * DA + col]) + w1 * bf2f(((const bf16*)(ws + WS_O1))[(size_t)row * DA + col]) + w2 * bf2f(((const bf16*)(ws + WS_O2))[(size_t)row * DA + col])) / (w0 + w1 + w2);
        fail = bad(bf2f(((const bf16*)(ws + WS_AG))[(size_t)row * 2048 + col]), ex, 1e-2f, 5e-3f);
    } else if (stage == 4) {
        const int row = h1 % M, col = h2 % DM; const bf16* AG = (const bf16*)(ws + WS_AG) + (size_t)row * 2048; const bf16* Wt = (const bf16*)(ws + WS_WPAB) + (size_t)col * 2048;
        const float ya = dot_bf(AG, Wt, 1024), yb = dot_bf(AG + 1024, Wt + 1024, 1024);
        const float ga = bf2f(((const bf16*)(ws + WS_GA))[(size_t)row * 2048 + col]), gb = bf2f(((const bf16*)(ws + WS_GB))[(size_t)row * 2048 + col]);
        const float ex = ya / (1.f + expf(-ga)) + yb / (1.f + expf(-gb));
        fail = bad(bf2f(((const bf16*)(ws + WS_MRG))[(size_t)row * 2048 + col]), ex, 2e-2f, 5e-3f);
    } else if (stage == 5) {
        const int row = h1 % M, col = h2 % DM;
        const float ex = ALPHA * args.in[0][(size_t)row * DM + col] + dot_bf((const bf16*)(ws + WS_MRG) + (size_t)row * 2048, (const bf16*)(ws + WS_WOUT) + (size_t)col * 2048, DM);
        fail = bad(args.out[(size_t)row * DM + col], ex, 2e-3f, 2e-3f);
    } else if (stage == 6 || stage == 9) {
        const float* gain = args.in[stage == 6 ? 10 : 16]; const float* bias = args.in[stage == 6 ? 11 : 17];
        if (gid < 2048) { const int row = h1 % M; float s1 = 0.f, s2 = 0.f;
            for (int c = 0; c < DM; ++c) { const float v = (args.out[(size_t)row * DM + c] - bias[c]) / gain[c]; s1 += v; s2 += v * v; }
            const float mean = s1 / DM, var = s2 / DM - mean * mean; fail = (fabsf(mean) > 2e-3f) || (fabsf(var - 1.f) > 1e-2f);
        } else if (stage == 6) {
            const int sel = gid % 3;
            if (sel == 0) { const int row = h1 % M, c = h2 % DM; fail = bad(bf2f(((const bf16*)(ws + WS_HB))[(size_t)row * DM + c]), args.out[(size_t)row * DM + c], 5e-3f, 1e-4f); }
            else if (sel == 1) { const int n = h1 % DFF, k = h2 % DM; fail = ((const bf16*)(ws + WS_W1))[(size_t)n * DM + k] != (bf16)f2bf(args.in[12][(size_t)k * DFF + n]); }
            else { const int n = h1 % DM, k = h2 % DFF; fail = ((const bf16*)(ws + WS_W2))[(size_t)n * DFF + k] != (bf16)f2bf(args.in[14][(size_t)k * DM + n]); }
        }
    } else if (stage == 7) {
        const int row = h1 % M, col = h2 % DFF;
        const float v = dot_bf((const bf16*)(ws + WS_HB) + (size_t)row * DM, (const bf16*)(ws + WS_W1) + (size_t)col * DM, DM) + args.in[13][col]; const float r = fmaxf(v, 0.f);
        fail = bad(bf2f(((const bf16*)(ws + WS_ACT))[(size_t)row * DFF + col]), r * r, 2e-2f, 5e-3f);
    } else if (stage == 8) {
        const int row = h1 % M, col = h2 % DM;
        const float ex = ALPHA * bf2f(((const bf16*)(ws + WS_HB))[(size_t)row * DM + col]) + dot_bf((const bf16*)(ws + WS_ACT) + (size_t)row * DFF, (const bf16*)(ws + WS_W2) + (size_t)col * DFF, DFF) + args.in[15][col];
        fail = bad(args.out[(size_t)row * DM + col], ex, 5e-3f, 3e-2f);
    }
    if (fail) atomicAdd(flag, 1u);
}
__global__ void mk_report(Args args) {
    const unsigned* flag = (const unsigned*)(args.ws + WS_CTL) + CW_CHK;
    if (threadIdx.x == 0 && blockIdx.x == 0) { for (int s = 0; s < N_PHASES; ++s) if (flag[s] != 0u) { args.out[0] = 1000.0f * (float)(s + 1); break; } }
}
#endif

extern "C" void kernel_launch(void* const* d_in, const int* in_sizes, int n_in, void* d_out, int out_size, void* d_ws, size_t ws_size, hipStream_t stream) {
    static int grid = 0;
    if (grid == 0) {
        if (n_in != 18 || in_sizes[0] != M * DM || out_size != M * DM || ws_size < WS_END) { fprintf(stderr, "kernel_launch: unexpected shapes (n_in %d, in0 %d, out %d, ws %zu); nothing launched\n", n_in, n_in > 0 ? in_sizes[0] : -1, out_size, ws_size); grid = -1; return; }
        int dev = 0, cus = 0, per_cu = 0;
        if (hipGetDevice(&dev) != hipSuccess || hipDeviceGetAttribute(&cus, hipDeviceAttributeMultiprocessorCount, dev) != hipSuccess) { grid = -1; return; }
        if (hipFuncSetAttribute((const void*)mk_fwd, hipFuncAttributeMaxDynamicSharedMemorySize, LDS_BYTES) != hipSuccess) { fprintf(stderr, "kernel_launch: hipFuncSetAttribute failed\n"); grid = -1; return; }
        if (hipOccupancyMaxActiveBlocksPerMultiprocessor(&per_cu, (const void*)mk_fwd, NWAVES * 64, LDS_BYTES) != hipSuccess || per_cu < 1) { fprintf(stderr, "kernel_launch: occupancy query reports %d blocks per CU\n", per_cu); (void)hipGetLastError(); grid = -1; return; }
        grid = cus;
    }
    if (grid < 0) return;
    (void)hipMemsetAsync((char*)d_ws + WS_CTL, 0, CTL_ZERO_BYTES, stream);
    Args a{};
    for (int i = 0; i < 18; ++i) a.in[i] = (const float*)d_in[i];
    a.out = (float*)d_out; a.ws = (unsigned char*)d_ws;
#if MK_ONE_LAUNCH
    a.ph_lo = 0; a.ph_hi = N_PHASES;
    hipLaunchKernelGGL(mk_fwd, dim3(grid), dim3(NWAVES * 64), LDS_BYTES, stream, a);
#else
    for (int ph = 0; ph < N_PHASES; ++ph) {
        a.ph_lo = ph; a.ph_hi = ph + 1;
        hipLaunchKernelGGL(mk_fwd, dim3(grid), dim3(NWAVES * 64), LDS_BYTES, stream, a);
        if (ph == (MK_REPEAT_PHASE)) hipLaunchKernelGGL(mk_fwd, dim3(grid), dim3(NWAVES * 64), LDS_BYTES, stream, a);
#if MK_DEBUG_CHECKS
        hipLaunchKernelGGL(mk_check, dim3(32), dim3(256), 0, stream, a, ph);
#endif
    }
#if MK_DEBUG_CHECKS
    hipLaunchKernelGGL(mk_report, dim3(1), dim3(64), 0, stream, a);
#endif
#endif
}
```

```cpp
#include <hip/hip_runtime.h>
#include <cstdio>
#include <cstdint>

#ifndef MK_DEBUG_CHECKS
#define MK_DEBUG_CHECKS 0
#endif
#ifndef MK_REPEAT_PHASE
#define MK_REPEAT_PHASE 3
#endif
#ifndef MK_TPROBE
#define MK_TPROBE 0
#endif
#ifndef MK_TPA
#define MK_TPA 0
#endif
#ifndef MK_TPB
#define MK_TPB 4
#endif
#ifndef MK_ONE_LAUNCH
#define MK_ONE_LAUNCH 1
#endif

namespace pg8 {
#define PG8_LAS __attribute__((address_space(3)))
typedef unsigned short bf16_t;
typedef short bf16x8 __attribute__((ext_vector_type(8)));
typedef float f32x4 __attribute__((ext_vector_type(4)));
typedef float f32x2 __attribute__((ext_vector_type(2)));
typedef unsigned u32x4 __attribute__((ext_vector_type(4)));
typedef unsigned u32x2 __attribute__((ext_vector_type(2)));
constexpr int BM = 256, BK = 64, HALF = 128, HTB = HALF * BK * 2, STAGE_BYTES = 8 * HTB, NXCD = 8, WGM = 8;

__host__ __device__ __forceinline__ int lds_byte(int r, int c) { const int st = (r >> 4) * 2 + (c >> 5), rr = r & 15, cc = c & 31, ob = rr * 64 + cc * 2; return st * 1024 + (ob ^ (((ob >> 9) & 1) << 5)); }
__host__ __device__ __forceinline__ void stage_rc(int b, int& R, int& C) { const int st = b / 1024, sb = b % 1024, swz = sb ^ (((sb >> 9) & 1) << 5); R = (st >> 1) * 16 + swz / 64; C = (st & 1) * 32 + (swz % 64) / 2; }
__host__ __device__ __forceinline__ int perm32(int rho) { const int n = rho >> 4, i = rho & 15; return 8 * (i >> 2) + 4 * n + (i & 3); }

struct Unit { int pm, pn, kh; };
struct Gemm { const bf16_t* A; const bf16_t* Bt; int K; int ld; int khstep; };

struct StaticOrder {
    int nM, nN, nwg, G, c;
    __host__ __device__ void init(int M, int N, int G_, int c_) { nM = M / BM; nN = N / BM; nwg = nM * nN; G = G_; c = c_; }
    __host__ __device__ bool next(int i, Unit& u) const {
        const long L = (long)i * G + c; if (L >= nwg) return false;
        int wgid = (int)L; { const int q = nwg / NXCD, r = nwg % NXCD, xcd = wgid % NXCD, off = wgid / NXCD; wgid = (xcd < r ? xcd * (q + 1) : r * (q + 1) + (xcd - r) * q) + off; }
        const int nig = WGM * nN, gid = wgid / nig, fm = gid * WGM, gsz = (nM - fm) < WGM ? (nM - fm) : WGM;
        u.pm = fm + ((wgid % nig) % gsz); u.pn = (wgid % nig) / gsz; u.kh = 0; return true;
    }
};
struct PairOrder {
    StaticOrder so;
    __host__ __device__ bool next(int i, Unit& u) const { if (!so.next(i >> 1, u)) return false; u.kh = i & 1; return true; }
};

__device__ __forceinline__ unsigned cvt_pk_bf16(float lo, float hi) { unsigned r; asm volatile("v_cvt_pk_bf16_f32 %0, %1, %2" : "=v"(r) : "v"(lo), "v"(hi)); return r; }
__device__ __forceinline__ float bf_lo(unsigned w) { return __uint_as_float(w << 16); }
__device__ __forceinline__ float bf_hi(unsigned w) { return __uint_as_float(w & 0xffff0000u); }
__device__ __forceinline__ float fast_exp2(float x) { return __builtin_amdgcn_exp2f(x); }
__device__ __forceinline__ float fast_rcp(float x) { return __builtin_amdgcn_rcpf(x); }
__device__ __forceinline__ float gelu_tanh(float v) {
    const float t = v * (1.0f + 0.044715f * v * v);
    const float e = fast_exp2(t * (-2.0f * 0.7978845608028654f * 1.4426950408889634f));
    return v * fast_rcp(1.0f + e);
}


struct EpiProj {
    static constexpr bool PERM = true, AFTER_DRAIN = false, KEEPS = false;
    bf16_t *Q, *Kb, *V, *U, *VB, *GA, *GB; f32x2* vstat; float qscale;
    __device__ __forceinline__ bool operator()(f32x4 (&acc)[2][2][4][2], const Unit& u, int wr, int wc, int fr, int fq) const {
        const int pn = 35 - u.pn; bf16_t* base; int ldc = 1024, colt, act = 0; float sc = 1.0f;
        if (pn < 4) { base = Q; colt = pn * BM; sc = qscale; }
        else if (pn < 8) { base = Kb; colt = (pn - 4) * BM; }
        else if (pn < 12) { base = V; colt = (pn - 8) * BM; }
        else if (pn < 16) { base = U; colt = (pn - 12) * BM; act = 1; }
        else if (pn < 20) { base = VB; colt = (pn - 16) * BM; act = 2; }
        else if (pn < 28) { base = GA; colt = (pn - 20) * BM; ldc = 2048; }
        else { base = GB; colt = (pn - 28) * BM; ldc = 2048; }
        const int row0 = u.pm * BM + wr * 64 + fr, col0 = colt + wc * 32 + 8 * fq;
        if (pn >= 20) {
            unsigned char* gbase = (unsigned char*)base + ((((size_t)u.pm * 8 + (pn >= 28 ? pn - 28 : pn - 20)) * 8 + (wr * 4 + wc)) * 16) * 512 + (fq * 16 + fr) * 8;
#pragma unroll
            for (int ai = 0; ai < 2; ++ai)
#pragma unroll
                for (int m = 0; m < 4; ++m)
#pragma unroll
                    for (int bj = 0; bj < 2; ++bj) { unsigned q[8];
#pragma unroll
                        for (int e = 0; e < 8; ++e) { const float v = e < 4 ? acc[ai][bj][m][0][e] : acc[ai][bj][m][1][e - 4];
                            q[e] = (unsigned)(255.0f * fast_rcp(1.0f + fast_exp2(v * -1.4426950408889634f)) + 0.5f); }
                        *(u32x2*)(gbase + ((ai * 4 + m) * 2 + bj) * 512) = (u32x2){q[0] | (q[1] << 8) | (q[2] << 16) | (q[3] << 24), q[4] | (q[5] << 8) | (q[6] << 16) | (q[7] << 24)}; }
            return false;
        }
#pragma unroll
        for (int ai = 0; ai < 2; ++ai)
#pragma unroll
            for (int m = 0; m < 4; ++m) {
                const int row = row0 + ai * HALF + m * 16; bf16_t* rowp = base + (size_t)row * ldc + col0; float s1 = 0.f, s2 = 0.f;
#pragma unroll
                for (int bj = 0; bj < 2; ++bj) { f32x4 v0 = acc[ai][bj][m][0], v1 = acc[ai][bj][m][1];
                    if (act != 0) {
#pragma unroll
                        for (int e = 0; e < 4; ++e) { v0[e] = gelu_tanh(v0[e]); v1[e] = gelu_tanh(v1[e]); }
                        s1 += (v0[0] + v0[1]) + (v0[2] + v0[3]) + (v1[0] + v1[1]) + (v1[2] + v1[3]);
                        s2 += (v0[0] * v0[0] + v0[1] * v0[1]) + (v0[2] * v0[2] + v0[3] * v0[3]) + (v1[0] * v1[0] + v1[1] * v1[1]) + (v1[2] * v1[2] + v1[3] * v1[3]);
                    }
                    v0 = v0 * sc; v1 = v1 * sc; u32x4 w; w.x = cvt_pk_bf16(v0[0], v0[1]); w.y = cvt_pk_bf16(v0[2], v0[3]); w.z = cvt_pk_bf16(v1[0], v1[1]); w.w = cvt_pk_bf16(v1[2], v1[3]);
                    *(u32x4*)(rowp + bj * HALF) = w; }
                if (act == 2) {
                    s1 += __shfl_xor(s1, 16); s1 += __shfl_xor(s1, 32); s2 += __shfl_xor(s2, 16); s2 += __shfl_xor(s2, 32);
                    if (fq == 0) vstat[(size_t)row * 16 + (pn - 16) * 4 + wc] = (f32x2){s1, s2};
                }
            }
        return false;
    }
};
struct EpiGate {
    static constexpr bool PERM = true, AFTER_DRAIN = false, KEEPS = true;
    const unsigned char *GA, *GB; bf16_t* O;
    __device__ __forceinline__ bool operator()(f32x4 (&acc)[2][2][4][2], const Unit& u, int wr, int wc, int fr, int fq) const {
        const int row0 = u.pm * BM + wr * 64 + fr, col0 = u.pn * BM + wc * 32 + 8 * fq;
        const size_t goff = ((((size_t)u.pm * 8 + u.pn) * 8 + (wr * 4 + wc)) * 16) * 512 + (fq * 16 + fr) * 8;
        u32x2 gb[16], ga[16];
#pragma unroll
        for (int i = 0; i < 16; ++i) gb[i] = *(const u32x2*)(GB + goff + i * 512);
        if (u.kh == 0) {
#pragma unroll
            for (int i = 0; i < 16; ++i) ga[i] = *(const u32x2*)(GA + goff + i * 512);
        }
#pragma unroll
        for (int ai = 0; ai < 2; ++ai)
#pragma unroll
            for (int m = 0; m < 4; ++m)
#pragma unroll
                for (int bj = 0; bj < 2; ++bj) { const int i = (ai * 4 + m) * 2 + bj; float qb[8];
#pragma unroll
                    for (int e = 0; e < 8; ++e) qb[e] = fmaxf((float)(((e < 4 ? gb[i].x : gb[i].y) >> (8 * (e & 3))) & 255u), 1.0f);
                    if (u.kh == 0) {
#pragma unroll
                        for (int e = 0; e < 8; ++e) { const float r = (float)(((e < 4 ? ga[i].x : ga[i].y) >> (8 * (e & 3))) & 255u) * fast_rcp(qb[e]);
                            if (e < 4) acc[ai][bj][m][0][e] *= r; else acc[ai][bj][m][1][e - 4] *= r; }
                    } else {
                        float o[8];
#pragma unroll
                        for (int e = 0; e < 8; ++e) o[e] = (e < 4 ? acc[ai][bj][m][0][e] : acc[ai][bj][m][1][e - 4]) * (qb[e] * (1.0f / 255.0f));
                        u32x4 w; w.x = cvt_pk_bf16(o[0], o[1]); w.y = cvt_pk_bf16(o[2], o[3]); w.z = cvt_pk_bf16(o[4], o[5]); w.w = cvt_pk_bf16(o[6], o[7]);
                        *(u32x4*)(O + (size_t)(row0 + ai * HALF + m * 16) * 2048 + col0 + bj * HALF) = w;
                    }
                }
        return u.kh == 0;
    }
};
template <int ACT> struct EpiBiasAct {
    static constexpr bool PERM = true, AFTER_DRAIN = false, KEEPS = false;
    bf16_t* O; int ldc; const float* bias;
    __device__ __forceinline__ bool operator()(f32x4 (&acc)[2][2][4][2], const Unit& u, int wr, int wc, int fr, int fq) const {
        const int row0 = u.pm * BM + wr * 64 + fr, col0 = u.pn * BM + wc * 32 + 8 * fq;
        f32x4 bv[2][2];
#pragma unroll
        for (int bj = 0; bj < 2; ++bj)
#pragma unroll
            for (int n = 0; n < 2; ++n) bv[bj][n] = bias ? *(const f32x4*)(bias + col0 + bj * HALF + 4 * n) : (f32x4){0.f, 0.f, 0.f, 0.f};
#pragma unroll
        for (int ai = 0; ai < 2; ++ai)
#pragma unroll
            for (int m = 0; m < 4; ++m) { bf16_t* rowp = O + (size_t)(row0 + ai * HALF + m * 16) * ldc + col0;
#pragma unroll
                for (int bj = 0; bj < 2; ++bj) { f32x4 v0 = acc[ai][bj][m][0] + bv[bj][0], v1 = acc[ai][bj][m][1] + bv[bj][1];
                    if (ACT == 1) {
#pragma unroll
                        for (int e = 0; e < 4; ++e) { const float a = fmaxf(v0[e], 0.f), b = fmaxf(v1[e], 0.f); v0[e] = a * a; v1[e] = b * b; } }
                    u32x4 w; w.x = cvt_pk_bf16(v0[0], v0[1]); w.y = cvt_pk_bf16(v0[2], v0[3]); w.z = cvt_pk_bf16(v1[0], v1[1]); w.w = cvt_pk_bf16(v1[2], v1[3]);
                    *(u32x4*)(rowp + bj * HALF) = w; } }
        return false;
    }
};
struct EpiResF32 {
    static constexpr bool PERM = false, AFTER_DRAIN = false, KEEPS = false;
    const float* base; float* out; const float* bias; float alpha;
    __device__ __forceinline__ bool operator()(f32x4 (&acc)[2][2][4][2], const Unit& u, int wr, int wc, int fr, int fq) const {
        const int row0 = u.pm * BM + wr * 64 + fr, col0 = u.pn * BM + wc * 32 + 4 * fq;
        f32x4 bv[2][2];
#pragma unroll
        for (int bj = 0; bj < 2; ++bj)
#pragma unroll
            for (int n = 0; n < 2; ++n) bv[bj][n] = bias ? *(const f32x4*)(bias + col0 + bj * HALF + n * 16) : (f32x4){0.f, 0.f, 0.f, 0.f};
#pragma unroll
        for (int ai = 0; ai < 2; ++ai)
#pragma unroll
            for (int m = 0; m < 4; ++m) { const size_t off = (size_t)(row0 + ai * HALF + m * 16) * 2048 + col0;
#pragma unroll
                for (int bj = 0; bj < 2; ++bj)
#pragma unroll
                    for (int n = 0; n < 2; ++n) { const f32x4 bs = *(const f32x4*)(base + off + bj * HALF + n * 16);
                        *(f32x4*)(out + off + bj * HALF + n * 16) = bs * alpha + (acc[ai][bj][m][n] + bv[bj][n]); }
                if (m & 1) asm volatile("" ::: "memory"); }
        return false;
    }
};

template <class Epi, class Sched, bool ALIGN_EPI = false>
__device__ __forceinline__ void gemm_phase(PG8_LAS unsigned char* lds, const Gemm g, const Sched& S, const Epi& E) {
    const int tid = threadIdx.x, wid = __builtin_amdgcn_readfirstlane(tid >> 6), lane = tid & 63, wr = wid >> 2, wc = wid & 3, fr = lane & 15, fq = lane >> 4;
    const int K = g.K, nt = K / BK, ld = g.ld;
    unsigned voffA[2], voffB[2];
#pragma unroll
    for (int i = 0; i < 2; ++i) { int R, C; stage_rc(tid * 16 + i * 8192, R, C); const int Rb = Epi::PERM ? ((R & ~31) + perm32(R & 31)) : R;
        voffA[i] = (unsigned)(R * ld + C) * 2u; voffB[i] = (unsigned)(Rb * ld + C) * 2u; }
    const size_t kstep = (size_t)(BK * 2);
    const size_t hstep = (size_t)HALF * ld * 2;
    const size_t tstep = 2 * hstep;
    const unsigned ldsw = (unsigned)wid * 1024u;
    const int aoff = lds_byte(wr * 64 + fr, fq * 8), boff = lds_byte(wc * 32 + fr, fq * 8);
#define PG8_SA(b, h) (((b) * 2 + (h)) * HTB)
#define PG8_SB(b, h) ((4 + (b) * 2 + (h)) * HTB)
#define PG8_STAGE(bufoff, gbase, voff) do { _Pragma("unroll") for (int _i = 0; _i < 2; ++_i) \
        __builtin_amdgcn_global_load_lds((const unsigned*)((const char*)(gbase) + (voff)[_i]), (PG8_LAS unsigned*)(lds + (bufoff) + ldsw + _i * 8192), 16, 0, 0); } while (0)
#define PG8_LDA(dst, b, h) do { _Pragma("unroll") for (int m = 0; m < 4; ++m) _Pragma("unroll") for (int k = 0; k < 2; ++k) dst[m][k] = *(const PG8_LAS bf16x8*)(lds + PG8_SA(b, h) + aoff + m * 2048 + k * 1024); } while (0)
#define PG8_LDB(dst, b, h) do { _Pragma("unroll") for (int n = 0; n < 2; ++n) _Pragma("unroll") for (int k = 0; k < 2; ++k) dst[n][k] = *(const PG8_LAS bf16x8*)(lds + PG8_SB(b, h) + boff + n * 2048 + k * 1024); } while (0)
#define PG8_MMA(ai, bj, At, Bt) do { __builtin_amdgcn_s_setprio(1); _Pragma("unroll") for (int m = 0; m < 4; ++m) _Pragma("unroll") for (int n = 0; n < 2; ++n) _Pragma("unroll") for (int k = 0; k < 2; ++k) \
        acc[ai][bj][m][n] = __builtin_amdgcn_mfma_f32_16x16x32_bf16(Bt[n][k], At[m][k], acc[ai][bj][m][n], 0, 0, 0); __builtin_amdgcn_s_setprio(0); } while (0)
#define PG8_WAIT_V(n) asm volatile("s_waitcnt vmcnt(" #n ")" ::: "memory")
#define PG8_WAIT_L(n) asm volatile("s_waitcnt lgkmcnt(" #n ")" ::: "memory")
#define PG8_BAR __builtin_amdgcn_s_barrier()
#define PG8_SCHED __builtin_amdgcn_sched_barrier(0)
    Unit cur, nxt; int ui = 0;
    if (!S.next(0, cur)) return;
    f32x4 acc[2][2][4][2];
#pragma unroll
    for (int a = 0; a < 2; ++a)
#pragma unroll
        for (int b = 0; b < 2; ++b)
#pragma unroll
            for (int m = 0; m < 4; ++m)
#pragma unroll
                for (int n = 0; n < 2; ++n) acc[a][b][m][n] = (f32x4){0.f, 0.f, 0.f, 0.f};
    bf16x8 At[4][2], B0[2][2], B1[2][2];
    const char* cA = (const char*)g.A + (size_t)cur.pm * tstep + (size_t)cur.kh * g.khstep; const char* cB = (const char*)g.Bt + (size_t)cur.pn * tstep + (size_t)cur.kh * g.khstep;
    PG8_STAGE(PG8_SB(0, 0), cB, voffB); PG8_STAGE(PG8_SB(0, 1), cB + hstep, voffB); PG8_STAGE(PG8_SA(0, 0), cA, voffA); PG8_STAGE(PG8_SA(0, 1), cA + hstep, voffA);
    if (wr == 1) PG8_BAR;
    PG8_WAIT_V(2); PG8_BAR;
    PG8_STAGE(PG8_SB(1, 0), cB + kstep, voffB); PG8_STAGE(PG8_SA(1, 0), cA + kstep, voffA); PG8_STAGE(PG8_SB(1, 1), cB + hstep + kstep, voffB);
    PG8_WAIT_V(6); PG8_BAR;
    for (;;) {
        const bool has_next = S.next(ui + 1, nxt);
        const char* nA = has_next ? (const char*)g.A + (size_t)nxt.pm * tstep + (size_t)nxt.kh * g.khstep : cA; const char* nB = has_next ? (const char*)g.Bt + (size_t)nxt.pn * tstep + (size_t)nxt.kh * g.khstep : cB;
        for (int t = 0; t < nt; t += 2) {
            const bool last = (t == nt - 2);
            const char* a1 = cA + (size_t)(t + 1) * kstep;
            const char* a2 = last ? nA : cA + (size_t)(t + 2) * kstep; const char* b2 = last ? nB : cB + (size_t)(t + 2) * kstep;
            const char* a3 = a2 + kstep; const char* b3 = b2 + kstep;
            PG8_LDB(B0, 0, 0); PG8_LDB(B1, 0, 1); PG8_SCHED; PG8_LDA(At, 0, 0); PG8_STAGE(PG8_SA(1, 1), a1 + hstep, voffA);
            PG8_WAIT_V(8); PG8_WAIT_L(0); PG8_BAR; PG8_MMA(0, 0, At, B0); PG8_MMA(0, 1, At, B1); PG8_BAR; PG8_SCHED;
            PG8_LDA(At, 0, 1); PG8_STAGE(PG8_SB(0, 0), b2, voffB); PG8_STAGE(PG8_SB(0, 1), b2 + hstep, voffB); PG8_STAGE(PG8_SA(0, 0), a2, voffA);
            PG8_WAIT_V(8); PG8_WAIT_L(0); PG8_BAR; PG8_MMA(1, 0, At, B0); PG8_MMA(1, 1, At, B1); PG8_BAR; PG8_SCHED;
            PG8_LDB(B0, 1, 0); PG8_LDB(B1, 1, 1); PG8_SCHED; PG8_LDA(At, 1, 0); PG8_STAGE(PG8_SA(0, 1), a2 + hstep, voffA);
            PG8_WAIT_V(8); PG8_WAIT_L(0); PG8_BAR; PG8_MMA(0, 0, At, B0); PG8_MMA(0, 1, At, B1); PG8_BAR; PG8_SCHED;
            PG8_LDA(At, 1, 1); PG8_STAGE(PG8_SB(1, 0), b3, voffB); PG8_STAGE(PG8_SB(1, 1), b3 + hstep, voffB); PG8_STAGE(PG8_SA(1, 0), a3, voffA);
            PG8_WAIT_V(8); PG8_WAIT_L(0); PG8_BAR; PG8_MMA(1, 0, At, B0); PG8_MMA(1, 1, At, B1); PG8_BAR; PG8_SCHED;
        }
        if constexpr (ALIGN_EPI) { if (wr == 0) PG8_BAR; }
        const bool keep = E(acc, cur, wr, wc, fr, fq);
        if (!has_next) break;
        if (!(Epi::KEEPS && keep)) {
#pragma unroll
            for (int a = 0; a < 2; ++a)
#pragma unroll
                for (int b = 0; b < 2; ++b)
#pragma unroll
                    for (int m = 0; m < 4; ++m)
#pragma unroll
                        for (int n = 0; n < 2; ++n) acc[a][b][m][n] = (f32x4){0.f, 0.f, 0.f, 0.f};
        }
        cur = nxt; cA = nA; cB = nB; ++ui;
        if constexpr (ALIGN_EPI) { if (wr == 1) PG8_BAR; }
    }
    PG8_WAIT_V(0);
    if constexpr (!ALIGN_EPI) { if (wr == 0) PG8_BAR; }
    PG8_BAR;
#undef PG8_SA
#undef PG8_SB
#undef PG8_STAGE
#undef PG8_LDA
#undef PG8_LDB
#undef PG8_MMA
#undef PG8_WAIT_V
#undef PG8_WAIT_L
#undef PG8_BAR
#undef PG8_SCHED
}
}

constexpr int NWAVES = 8;
constexpr int BATCH = 8, SEQ = 2048, DM = 2048, M = BATCH * SEQ;
constexpr int NH = 8, HD = 128, DA = 1024, DB = 1024, DFF = 8192, DIN = 9216;
constexpr int NPAT = 3;
constexpr float LN_EPS = 1e-5f;
constexpr float ALPHA = 1.189207115002721f;
constexpr float LOG2E = 1.4426950408889634f;
constexpr float QSCALE = 0.08838834764831845f * 1.4426950408889634f;

constexpr size_t MiB = 1u << 20;
constexpr size_t WS_CTL = 0, CTL_ZERO_BYTES = 256 * 1024;
constexpr size_t WS_VSTAT = 1 * MiB;
constexpr size_t WS_LSE = 3 * MiB;
constexpr size_t WS_WSP = 5 * MiB - 512 * 1024;
constexpr size_t WS_BTAB = 5 * MiB - 128 * 1024;
constexpr size_t WS_WIN = 5 * MiB;
constexpr size_t WS_O1 = 5 * MiB;
constexpr size_t WS_WPAB = 41 * MiB;
constexpr size_t WS_WOUT = 49 * MiB;
constexpr size_t WS_W1 = 57 * MiB;
constexpr size_t WS_W2 = 89 * MiB;
constexpr size_t WS_O0 = 57 * MiB, WS_O2 = 89 * MiB;
constexpr size_t WS_XB = 121 * MiB;
constexpr size_t WS_AG = WS_XB, WS_HB = WS_XB;
constexpr size_t WS_Q = 185 * MiB, WS_K = 217 * MiB, WS_V = 249 * MiB, WS_U = 281 * MiB, WS_VB = 313 * MiB;
constexpr size_t WS_GA = 345 * MiB, WS_GB = 409 * MiB;
constexpr size_t WS_MRG = WS_Q;
constexpr size_t WS_ACT = 185 * MiB;
constexpr size_t WS_MIX = WS_V;
constexpr size_t WS_FF = WS_WIN;
constexpr size_t WS_END = 473 * MiB;
constexpr int BT_PITCH = 132;
constexpr int CW_BAR = 4096;
constexpr int CW_CHK = 1024;
constexpr int CW_TS = 2048;

constexpr int RING_OFF = 0, RING_BYTES = 131072;
constexpr int LDSCTL_OFF = RING_BYTES, MISC_OFF = LDSCTL_OFF + 320;
constexpr int LDS_BT_OFF = RING_BYTES + 1024;
constexpr int LDS_BYTES = 147456;

#define GAS __attribute__((address_space(1)))
#define LAS __attribute__((address_space(3)))
typedef unsigned short bf16;
typedef unsigned v4u __attribute__((ext_vector_type(4)));
typedef unsigned v2u __attribute__((ext_vector_type(2)));
typedef float f32x4 __attribute__((ext_vector_type(4)));
typedef float f32x2 __attribute__((ext_vector_type(2)));
typedef short bf16x8 __attribute__((ext_vector_type(8)));
typedef short s16x4 __attribute__((ext_vector_type(4)));
typedef GAS unsigned gu32;
#define RLX_AGENT __ATOMIC_RELAXED, __HIP_MEMORY_SCOPE_AGENT
#define LDS_WAIT() asm volatile("s_waitcnt lgkmcnt(0)" ::: "memory")
#define VM_WAIT() asm volatile("s_waitcnt vmcnt(0)" ::: "memory")
__device__ __forceinline__ unsigned f2bf(float f) { unsigned u = __builtin_bit_cast(unsigned, f); return (u + 0x7fffu + ((u >> 16) & 1u)) >> 16; }
__device__ __forceinline__ unsigned pk2(float lo, float hi) { return f2bf(lo) | (f2bf(hi) << 16); }
__device__ __forceinline__ float bf2f(bf16 v) { return __uint_as_float((unsigned)v << 16); }

#define XB_TMO      128
#define XB_XCNT(j)  (256  + 64 * (j))
#define XB_XSUB(j)  (1280 + 64 * (j))
#define XB_XGEN(j)  (2304 + 64 * (j))
#define XB_TOP      3328
#define XB_TOPGEN   3392
#define XCD_BAR_WORDS 3456
#define XB_SPIN_CAP (1u << 22)
__device__ __forceinline__ unsigned xb_ld(unsigned* p)              { return __hip_atomic_load(p, __ATOMIC_RELAXED, __HIP_MEMORY_SCOPE_AGENT); }
__device__ __forceinline__ unsigned xb_add(unsigned* p, unsigned v) { return __hip_atomic_fetch_add(p, v, __ATOMIC_RELAXED, __HIP_MEMORY_SCOPE_AGENT); }
__device__ __forceinline__ unsigned xb_xcc_id() { return (unsigned)__builtin_amdgcn_s_getreg((3 << 11) | 20) & 0xFu; }
#define XB_SPIN(cond, bar) do { unsigned _sp = 0; while (cond) { __builtin_amdgcn_s_sleep(1); \
    if ((++_sp & 255u) == 0u) { if (xb_ld(&(bar)[XB_TMO])) break; if (_sp > XB_SPIN_CAP) { atomicAdd(&(bar)[XB_TMO], 1u); break; } } } } while (0)
struct XcdBarrier { unsigned* bar; unsigned x; volatile LAS unsigned* st; };
__device__ __forceinline__ XcdBarrier xcd_barrier_post(unsigned* bar, volatile LAS unsigned* st) {
    XcdBarrier b; b.bar = bar; b.x = xb_xcc_id(); b.st = st;
    if (threadIdx.x == 0) (void)xb_add(&bar[XB_XCNT(b.x)], 1u);
    return b;
}
__device__ __forceinline__ void xcd_barrier_complete(unsigned* bar, unsigned x, unsigned& nloc, unsigned& nx) {
    const unsigned G = gridDim.x * gridDim.y * gridDim.z;
    unsigned sum, cnt, mine, sp = 0u;
    for (;;) {
        sum = 0u; cnt = 0u; mine = 0u;
#pragma unroll
        for (unsigned j = 0; j < 16; ++j) { const unsigned c = xb_ld(&bar[XB_XCNT(j)]); sum += c; cnt += (c > 0u) ? 1u : 0u; mine = (j == x) ? c : mine; }
        if (sum == G) break;
        __builtin_amdgcn_s_sleep(1);
        if ((++sp & 255u) == 0u) { if (xb_ld(&bar[XB_TMO])) break; if (sp > XB_SPIN_CAP) { atomicAdd(&bar[XB_TMO], 1u); break; } }
    }
    nloc = mine > 0u ? mine : 1u; nx = cnt > 0u ? cnt : 1u;
}
__device__ __forceinline__ void xcd_barrier(const XcdBarrier& b) {
    asm volatile("s_waitcnt vmcnt(0)" ::: "memory");
    __syncthreads();
    if (threadIdx.x == 0) {
        unsigned* bar = b.bar;
        __builtin_amdgcn_s_waitcnt(0);
        unsigned nloc = b.st[0], nx = b.st[1];
        if (nloc == 0u) { xcd_barrier_complete(bar, b.x, nloc, nx); b.st[0] = nloc; b.st[1] = nx; }
        const unsigned old = xb_add(&bar[XB_XSUB(b.x)], 1u);
        const unsigned gen = old / nloc;
        if (old + 1u == (gen + 1u) * nloc) {
            __builtin_amdgcn_fence(__ATOMIC_RELEASE, "agent");
            asm volatile("s_waitcnt vmcnt(0)" ::: "memory");
            const unsigned og = xb_add(&bar[XB_TOP], 1u);
            const unsigned tg = og / nx;
            if (og + 1u == (tg + 1u) * nx) xb_add(&bar[XB_TOPGEN], 1u);
            else XB_SPIN(xb_ld(&bar[XB_TOPGEN]) == tg, bar);
            __builtin_amdgcn_fence(__ATOMIC_ACQUIRE, "agent");
            xb_add(&bar[XB_XGEN(b.x)], 1u);
            asm volatile("s_waitcnt vmcnt(0)" ::: "memory");
        } else {
            XB_SPIN(xb_ld(&bar[XB_XGEN(b.x)]) == gen, bar);
            __builtin_amdgcn_fence(__ATOMIC_ACQUIRE, "agent");
            asm volatile("s_waitcnt vmcnt(0)" ::: "memory");
        }
    }
    __syncthreads();
}

struct Args { const float* in[18]; float* out; unsigned char* ws; int ph_lo, ph_hi; };
struct Frame {
    LAS unsigned char* lds;
    int tid, lane, wave, G, bid;
    const float* const* in; float* out; unsigned char* ws;
};
__device__ __forceinline__ float wave_sum(float v) {
#pragma unroll
    for (int o = 1; o < 64; o <<= 1) v += __shfl_xor(v, o);
    return v;
}

struct TrItem { const float* W; bf16* WT; int N, ldt, koff, k0, n0, n0d; };
__device__ __forceinline__ TrItem tr_decode(const float* const* in, unsigned char* ws, int it) {
    constexpr int I_IN = (DM / 64) * (DIN / 64), I_PA = (DA / 64) * (DM / 64), I_OUT = (DM / 64) * (DM / 64), I_1 = (DM / 64) * (DFF / 64);
    TrItem t; bool rev = false; int r = it;
    if (r < I_IN) { t.W = in[1]; t.N = DIN; t.WT = (bf16*)(ws + WS_WIN); t.ldt = DM; t.koff = 0; rev = true; }
    else if ((r -= I_IN) < I_PA) { t.W = in[7]; t.N = DM; t.WT = (bf16*)(ws + WS_WPAB); t.ldt = 2048; t.koff = 0; }
    else if ((r -= I_PA) < I_PA) { t.W = in[8]; t.N = DM; t.WT = (bf16*)(ws + WS_WPAB); t.ldt = 2048; t.koff = 1024; }
    else if ((r -= I_PA) < I_OUT) { t.W = in[9]; t.N = DM; t.WT = (bf16*)(ws + WS_WOUT); t.ldt = 2048; t.koff = 0; }
    else if ((r -= I_OUT) < I_1) { t.W = in[12]; t.N = DFF; t.WT = (bf16*)(ws + WS_W1); t.ldt = DM; t.koff = 0; }
    else { r -= I_1; t.W = in[14]; t.N = DM; t.WT = (bf16*)(ws + WS_W2); t.ldt = DFF; t.koff = 0; }
    const int nblk = t.N / 64, sub = r & 7, grp = r >> 3, nb = 2 * (grp % (nblk / 2)) + (sub & 1), kb = 4 * (grp / (nblk / 2)) + (sub >> 1);
    t.k0 = 64 * kb; t.n0 = 64 * nb; t.n0d = rev ? (t.N / 256 - 1 - t.n0 / 256) * 256 + (t.n0 & 255) : t.n0;
    return t;
}
__device__ __forceinline__ void tr_load(const TrItem& t, int lane, f32x4 (&va)[8], f32x4 (&vb)[8]) {
    const int cg = lane & 15, rg = lane >> 4;
#pragma unroll
    for (int i = 0; i < 8; ++i) { const GAS float* src = (const GAS float*)t.W + (size_t)(t.k0 + 8 * i + 2 * rg) * t.N + t.n0 + 4 * cg; va[i] = *(const GAS f32x4*)src; vb[i] = *(const GAS f32x4*)(src + t.N); }
}
__device__ __forceinline__ void tr_store(const TrItem& t, int lane, const f32x4 (&va)[8], const f32x4 (&vb)[8], LAS unsigned* scr) {
    const int cg = lane & 15, rg = lane >> 4;
#pragma unroll
    for (int i = 0; i < 8; ++i) { const int kp = 4 * i + rg;
        scr[(4 * cg + 0) * 33 + kp] = pk2(va[i].x, vb[i].x); scr[(4 * cg + 1) * 33 + kp] = pk2(va[i].y, vb[i].y);
        scr[(4 * cg + 2) * 33 + kp] = pk2(va[i].z, vb[i].z); scr[(4 * cg + 3) * 33 + kp] = pk2(va[i].w, vb[i].w); }
    LDS_WAIT(); asm volatile("" ::: "memory");
    const int c = lane & 7;
#pragma unroll
    for (int j = 0; j < 8; ++j) { const int n = (lane >> 3) + 8 * j; const LAS unsigned* sp = scr + n * 33 + 4 * c;
        v4u o; o.x = sp[0]; o.y = sp[1]; o.z = sp[2]; o.w = sp[3];
        *(GAS v4u*)(t.WT + (size_t)(t.n0d + n) * t.ldt + t.koff + t.k0 + 8 * c) = o; }
    LDS_WAIT(); asm volatile("" ::: "memory");
}
__device__ __forceinline__ int t5_bucket(int n) {
    if (n < 16) return n;
    const float nf = (float)n;
    int large = 16 + (int)(logf(nf / 16.0f) / 4.852030263919617f * 16.0f);
    return large < 31 ? large : 31;
}
__device__ __forceinline__ int pat_dil(int p) { return p == 0 ? 1 : (p == 1 ? 4 : 16); }

__device__ __forceinline__ void phase_prologue(Frame& F) {
    LAS unsigned* scr = (LAS unsigned*)(F.lds + RING_OFF + F.wave * 16384);
    const int gw = F.bid * NWAVES + F.wave, NGW = F.G * NWAVES;
    constexpr int NITEMS = (DM / 64) * (DIN / 64) + 2 * (DA / 64) * (DM / 64) + (DM / 64) * (DM / 64) + 2 * (DM / 64) * (DFF / 64);
    {   f32x4 a0[8], b0[8], a1[8], b1[8];
        TrItem t0 = tr_decode(F.in, F.ws, gw < NITEMS ? gw : 0), t1 = t0;
        if (gw < NITEMS) tr_load(t0, F.lane, a0, b0);
        for (int it = gw; it < NITEMS; it += 2 * NGW) {
            const bool h1 = it + NGW < NITEMS, h2 = it + 2 * NGW < NITEMS;
            if (h1) { t1 = tr_decode(F.in, F.ws, it + NGW); tr_load(t1, F.lane, a1, b1); }
            tr_store(t0, F.lane, a0, b0, scr);
            if (h2) { t0 = tr_decode(F.in, F.ws, it + 2 * NGW); tr_load(t0, F.lane, a0, b0); }
            if (h1) tr_store(t1, F.lane, a1, b1, scr);
        }
    }
    const float* x = F.in[0]; bf16* XB = (bf16*)(F.ws + WS_XB);
    {   f32x4 v0[8], v1[8];
        if (gw < M) {
#pragma unroll
            for (int j = 0; j < 8; ++j) v0[j] = ((const GAS f32x4*)(x + (size_t)gw * DM) + F.lane)[64 * j]; }
        for (int m = gw; m < M; m += 2 * NGW) {
            const bool h1 = m + NGW < M, h2 = m + 2 * NGW < M;
            if (h1) {
#pragma unroll
                for (int j = 0; j < 8; ++j) v1[j] = ((const GAS f32x4*)(x + (size_t)(m + NGW) * DM) + F.lane)[64 * j]; }
            { GAS v2u* o = (GAS v2u*)(XB + (size_t)m * DM) + F.lane;
#pragma unroll
              for (int j = 0; j < 8; ++j) o[64 * j] = (v2u){pk2(v0[j].x, v0[j].y), pk2(v0[j].z, v0[j].w)}; }
            if (h2) {
#pragma unroll
                for (int j = 0; j < 8; ++j) v0[j] = ((const GAS f32x4*)(x + (size_t)(m + 2 * NGW) * DM) + F.lane)[64 * j]; }
            if (h1) { GAS v2u* o = (GAS v2u*)(XB + (size_t)(m + NGW) * DM) + F.lane;
#pragma unroll
              for (int j = 0; j < 8; ++j) o[64 * j] = (v2u){pk2(v1[j].x, v1[j].y), pk2(v1[j].z, v1[j].w)}; }
        }
    }
    const int gt = F.bid * (NWAVES * 64) + F.tid, NGT = F.G * NWAVES * 64;
    const float* wsp = F.in[5]; bf16* WSP = (bf16*)(F.ws + WS_WSP);
    for (int e = gt; e < 8 * 128 * 128; e += NGT) { const int i = (e >> 7) & 127, j = e & 127; WSP[e] = (bf16)(j <= i ? f2bf(wsp[e]) : 0u); }
    const float* rb = F.in[2]; float* BT = (float*)(F.ws + WS_BTAB);
    for (int e = gt; e < NPAT * NH * BT_PITCH; e += NGT) { const int p = e / (NH * BT_PITCH), h = (e / BT_PITCH) % NH, j = e % BT_PITCH;
        BT[e] = (j <= 128) ? rb[t5_bucket(j * pat_dil(p)) * NH + h] * LOG2E : 0.f; }
}
template <bool BASE_BF16>
__device__ __forceinline__ void phase_ln(Frame& F, const float* base, const bf16* baseb, const bf16* add, float* outf, const float* gain, const float* bias, bf16* ob) {
    const int gw = F.bid * NWAVES + F.wave, NGW = F.G * NWAVES;
    for (int m = gw; m < M; m += NGW) {
        const GAS v2u* ar = (const GAS v2u*)(add + (size_t)m * DM) + F.lane;
        f32x4 v[8]; float s = 0.f;
#pragma unroll
        for (int j = 0; j < 8; ++j) { f32x4 x;
            if constexpr (BASE_BF16) { const v2u xb = ((const GAS v2u*)(baseb + (size_t)m * DM) + F.lane)[64 * j]; x = (f32x4){pg8::bf_lo(xb.x), pg8::bf_hi(xb.x), pg8::bf_lo(xb.y), pg8::bf_hi(xb.y)}; }
            else x = ((const GAS f32x4*)(base + (size_t)m * DM) + F.lane)[64 * j];
            const v2u a = ar[64 * j];
            v[j] = x * ALPHA + (f32x4){pg8::bf_lo(a.x), pg8::bf_hi(a.x), pg8::bf_lo(a.y), pg8::bf_hi(a.y)}; s += (v[j].x + v[j].y) + (v[j].z + v[j].w); }
        const float mean = wave_sum(s) * (1.f / DM); float s2 = 0.f;
#pragma unroll
        for (int j = 0; j < 8; ++j) { v[j] = v[j] - mean; s2 += (v[j].x * v[j].x + v[j].y * v[j].y) + (v[j].z * v[j].z + v[j].w * v[j].w); }
        const float rstd = 1.f / sqrtf(wave_sum(s2) * (1.f / DM) + LN_EPS);
        GAS f32x4* orow = (GAS f32x4*)(outf + (size_t)m * DM) + F.lane;
#pragma unroll
        for (int j = 0; j < 8; ++j) { const f32x4 g = ((const GAS f32x4*)gain)[64 * j + F.lane], b = ((const GAS f32x4*)bias)[64 * j + F.lane];
            const f32x4 o = v[j] * rstd * g + b; if (outf) orow[64 * j] = o;
            if (ob) ((GAS v2u*)(ob + (size_t)m * DM))[64 * j + F.lane] = (v2u){pk2(o.x, o.y), pk2(o.z, o.w)}; }
    }
}
__device__ __forceinline__ s16x4 tr_read(const LAS unsigned char* p) { return __builtin_bit_cast(s16x4, __builtin_amdgcn_ds_read_tr16_b64_v4i16((LAS s16x4*)p)); }
constexpr int ATT_K_OFF = 0, ATT_V_OFF = 65536;

template <bool FULL>
__device__ __forceinline__ void attn_qk(const LAS unsigned char* kprev, const LAS unsigned char* kcur, int kt_lo,
                                        int w, int lane, const bf16x8 (&qf)[4], const LAS float* BTp, f32x4 (&st)[9], float& mx_out, float& lsum_out) {
    const int fr = lane & 15, g = lane >> 4;
    f32x4 bias[9];
#pragma unroll
    for (int t = 0; t < 9; ++t)
#pragma unroll
        for (int e = 0; e < 4; ++e) { const int steps = 128 + fr - 16 * t - 4 * g - e; const float bv = BTp[steps < 0 ? 0 : (steps > 128 ? 128 : steps)];
            bias[t][e] = (steps >= 0 && steps <= 128) ? bv : -1e30f; }
    float mx = -1e30f;
#pragma unroll
    for (int t = 0; t < 9; ++t) {
        const int kt = w + t;
        if (FULL || kt >= kt_lo) {
            f32x4 a = (f32x4){0.f, 0.f, 0.f, 0.f};
            const LAS unsigned char* kb = ((kt < 8) ? kprev : kcur) + (16 * (kt & 7) + fr) * 256;
#pragma unroll
            for (int ks = 0; ks < 4; ++ks) { const bf16x8 kf = *(const LAS bf16x8*)(kb + (((4 * ks + g) ^ fr) << 4));
                a = __builtin_amdgcn_mfma_f32_16x16x32_bf16(kf, qf[ks], a, 0, 0, 0); }
            a = a + bias[t];
            mx = fmaxf(mx, fmaxf(fmaxf(a[0], a[1]), fmaxf(a[2], a[3])));
            st[t] = a;
        } else st[t] = (f32x4){-1e30f, -1e30f, -1e30f, -1e30f};
    }
    mx = fmaxf(mx, __shfl_xor(mx, 16)); mx = fmaxf(mx, __shfl_xor(mx, 32));
    float lsum = 0.f;
#pragma unroll
    for (int t = 0; t < 9; ++t)
#pragma unroll
        for (int e = 0; e < 4; ++e) { const float pv = pg8::fast_exp2(st[t][e] - mx); st[t][e] = pv; lsum += pv; }
    lsum += __shfl_xor(lsum, 16); lsum += __shfl_xor(lsum, 32);
    mx_out = mx; lsum_out = lsum;
}
template <bool FULL>
__device__ __forceinline__ void attn_pv(const LAS unsigned char* vprev, const LAS unsigned char* vcur, int kt_lo, int w, int lane, const f32x4 (&st)[9], f32x4 (&o)[8]) {
    const int fr = lane & 15, g = lane >> 4;
#pragma unroll
    for (int mt = 0; mt < 8; ++mt) o[mt] = (f32x4){0.f, 0.f, 0.f, 0.f};
#pragma unroll
    for (int a = 0; a < 5; ++a) {
        const int kt0 = w + 2 * a, kt1 = kt0 + 1; const bool v0 = FULL || kt0 >= kt_lo, v1 = (2 * a + 1 <= 8) && (FULL || kt1 >= kt_lo);
        if (v0 || v1) {
            v4u pw; pw.x = pg8::cvt_pk_bf16(st[2 * a][0], st[2 * a][1]); pw.y = pg8::cvt_pk_bf16(st[2 * a][2], st[2 * a][3]);
            if (2 * a + 1 <= 8) { pw.z = pg8::cvt_pk_bf16(st[(2 * a + 1 <= 8) ? 2 * a + 1 : 0][0], st[(2 * a + 1 <= 8) ? 2 * a + 1 : 0][1]); pw.w = pg8::cvt_pk_bf16(st[(2 * a + 1 <= 8) ? 2 * a + 1 : 0][2], st[(2 * a + 1 <= 8) ? 2 * a + 1 : 0][3]); }
            else { pw.z = 0u; pw.w = 0u; }
            if (!v0) { pw.x = 0u; pw.y = 0u; }
            if (!v1) { pw.z = 0u; pw.w = 0u; }
            const bf16x8 pf = __builtin_bit_cast(bf16x8, pw);
            const int krow = 4 * g + (fr >> 2), ksw = ((krow & 7) << 1);
            const LAS unsigned char* v0p = ((kt0 < 8) ? vprev : vcur) + (16 * (kt0 & 7) + krow) * 256 + ((lane & 1) << 3);
            const LAS unsigned char* v1p = ((kt1 < 8) ? vprev : vcur) + (16 * (kt1 & 7) + krow) * 256 + ((lane & 1) << 3);
#pragma unroll
            for (int mt = 0; mt < 8; ++mt) {
                const int gsw = ((2 * mt + ((lane & 3) >> 1)) ^ ksw) << 4;
                s16x4 lo = (s16x4){0, 0, 0, 0}, hi = (s16x4){0, 0, 0, 0};
                if (v0) lo = tr_read(v0p + gsw);
                if (v1) hi = tr_read(v1p + gsw);
                const bf16x8 vf = (bf16x8){lo[0], lo[1], lo[2], lo[3], hi[0], hi[1], hi[2], hi[3]};
                o[mt] = __builtin_amdgcn_mfma_f32_16x16x32_bf16(vf, pf, o[mt], 0, 0, 0);
            }
        }
    }
}
#define ATT_RAW_BAR() do { LDS_WAIT(); __builtin_amdgcn_s_barrier(); asm volatile("" ::: "memory"); } while (0)

struct AStepA { int b, h, p, d, r, blk, first; };
__device__ __forceinline__ AStepA astepA(int vcu, int G, int t) {
    const int c = vcu + G * (t >> 2), s = t & 3, bh = c >> 3, cc = c & 7; AStepA u; u.b = bh >> 3; u.h = bh & 7; u.first = (s == 0);
    if (cc < 4) { u.p = 0; u.d = 1; u.r = 0; u.blk = 4 * cc + s; } else { u.p = 1; u.d = 4; u.r = cc - 4; u.blk = s; }
    return u;
}
__device__ __forceinline__ void attn_phaseA(Frame& F, int vcu, float* Opart) {
    const int tid = F.tid, lane = F.lane, w = F.wave, fr = lane & 15, g = lane >> 4;
    const bf16* Qg = (const bf16*)(F.ws + WS_Q); const bf16* Kg = (const bf16*)(F.ws + WS_K); const bf16* Vg = (const bf16*)(F.ws + WS_V);
    float* LSE = (float*)(F.ws + WS_LSE);
    LAS unsigned char* lds = F.lds;
    LAS float* BTl = (LAS float*)(lds + LDS_BT_OFF);
    for (int e = tid; e < NPAT * NH * BT_PITCH; e += NWAVES * 64) BTl[e] = ((const float*)(F.ws + WS_BTAB))[e];
    const int nsteps = (512 - vcu + F.G - 1) / F.G * 4;
    v4u kr[8], vr[8];
#define ATTA_PREFETCH(U) do { const size_t _rb = (size_t)(U).b * SEQ; const int _lo = ((U).first && (U).blk > 0) ? 0 : 4; \
        _Pragma("unroll") for (int it = 0; it < 8; ++it) if (it >= _lo) { const int idx = it * 512 + tid, kj = idx >> 4, gr = idx & 15; \
            const unsigned off = (unsigned)(((int)_rb + (U).r + (U).d * (128 * ((U).blk - 1) + kj)) * DA + (U).h * HD + gr * 8) * 2u;     \
            kr[it] = *(const GAS v4u*)((const GAS char*)Kg + off); vr[it] = *(const GAS v4u*)((const GAS char*)Vg + off); } } while (0)
#define ATTA_PREFETCH_Q(U) do { const unsigned _qoff = (unsigned)(((int)((U).b * SEQ) + (U).r + (U).d * (128 * (U).blk + 16 * w + fr)) * DA + (U).h * HD + 8 * g) * 2u; \
        _Pragma("unroll") for (int ks = 0; ks < 4; ++ks) qf[ks] = *(const GAS bf16x8*)((const GAS char*)Qg + _qoff + 64 * ks); } while (0)
    AStepA cur = astepA(vcu, F.G, 0);
    bf16x8 qf[4];
    if (nsteps > 0) { ATTA_PREFETCH(cur); ATTA_PREFETCH_Q(cur); }
    for (int t = 0; t < nsteps; ++t) {
        const int cslot = (t & 1) * 32768, pslot = 32768 - cslot;
        const bool ldprev = cur.first && cur.blk > 0;
        const int kt_lo = (cur.blk == 0) ? 8 : 0;
#pragma unroll
        for (int it = 0; it < 8; ++it) if (it >= 4 || ldprev) {
            const int idx = it * 512 + tid, kj = idx >> 4, gr = idx & 15, row = kj & 127, slot = (it < 4) ? pslot : cslot;
            *(LAS v4u*)(lds + ATT_K_OFF + slot + row * 256 + ((gr ^ (row & 15)) << 4)) = kr[it];
            *(LAS v4u*)(lds + ATT_V_OFF + slot + row * 256 + ((gr ^ ((row & 7) << 1)) << 4)) = vr[it];
        }
#pragma unroll
        for (int ks = 0; ks < 4; ++ks) asm volatile("" : "+v"(qf[ks]));
        ATT_RAW_BAR();
        const AStepA me = cur;
        if (t + 1 < nsteps) { cur = astepA(vcu, F.G, t + 1); ATTA_PREFETCH(cur); }
        f32x4 st[9], o[8]; float mx, lsum;
        if (kt_lo == 0) {
            attn_qk<true>(lds + ATT_K_OFF + pslot, lds + ATT_K_OFF + cslot, 0, w, lane, qf, BTl + (me.p * NH + me.h) * BT_PITCH, st, mx, lsum);
            if (t + 1 < nsteps) ATTA_PREFETCH_Q(cur);
            attn_pv<true>(lds + ATT_V_OFF + pslot, lds + ATT_V_OFF + cslot, 0, w, lane, st, o);
        } else {
            attn_qk<false>(lds + ATT_K_OFF + pslot, lds + ATT_K_OFF + cslot, kt_lo, w, lane, qf, BTl + (me.p * NH + me.h) * BT_PITCH, st, mx, lsum);
            if (t + 1 < nsteps) ATTA_PREFETCH_Q(cur);
            attn_pv<false>(lds + ATT_V_OFF + pslot, lds + ATT_V_OFF + cslot, kt_lo, w, lane, st, o);
        }
        const size_t qrow = (size_t)me.b * SEQ + me.r + me.d * (128 * me.blk + 16 * w + fr);
        const float inv = 1.0f / lsum;
        bf16* orow = (bf16*)Opart + (size_t)me.p * M * DA + qrow * DA + me.h * HD + 4 * g;
#pragma unroll
        for (int mt = 0; mt < 8; ++mt) { const f32x4 v = o[mt] * inv; *(GAS v2u*)(orow + 16 * mt) = (v2u){pg8::cvt_pk_bf16(v[0], v[1]), pg8::cvt_pk_bf16(v[2], v[3])}; }
        if (g == 0) LSE[((size_t)me.p * M + qrow) * NH + me.h] = mx + log2f(lsum);
        ATT_RAW_BAR();
    }
#undef ATTA_PREFETCH
#undef ATTA_PREFETCH_Q
}
__device__ __forceinline__ void attn_phaseB(Frame& F, int vcu, const float* Opart) {
    const int tid = F.tid, lane = F.lane, w = F.wave, fr = lane & 15, g = lane >> 4;
    const bf16* Qg = (const bf16*)(F.ws + WS_Q); const bf16* Kg = (const bf16*)(F.ws + WS_K); const bf16* Vg = (const bf16*)(F.ws + WS_V);
    const float* LSE = (const float*)(F.ws + WS_LSE); bf16* AG = (bf16*)(F.ws + WS_AG);
    const bf16* O0 = (const bf16*)Opart; const bf16* O1 = O0 + (size_t)M * DA;
    LAS unsigned char* lds = F.lds;
    LAS float* BTl = (LAS float*)(lds + LDS_BT_OFF);
    for (int e = tid; e < NPAT * NH * BT_PITCH; e += NWAVES * 64) BTl[e] = ((const float*)(F.ws + WS_BTAB))[e];
    constexpr int NU = BATCH * NH * 16;
    v4u kr[4], vr[4]; bf16x8 qn[4];
#define ATTB_PREFETCH(UID) do { const int _bh = (UID) >> 4, _r = (UID) & 15; const size_t _rb = (size_t)(_bh >> 3) * SEQ; const int _h = _bh & 7; \
        _Pragma("unroll") for (int it = 0; it < 4; ++it) { const int idx = it * 512 + tid, kj = idx >> 4, gr = idx & 15; \
            const unsigned off = (unsigned)(((int)_rb + _r + 16 * kj) * DA + _h * HD + gr * 8) * 2u; \
            kr[it] = *(const GAS v4u*)((const GAS char*)Kg + off); vr[it] = *(const GAS v4u*)((const GAS char*)Vg + off); } \
        const unsigned _qoff = (unsigned)(((int)_rb + _r + 16 * (16 * w + fr)) * DA + _h * HD + 8 * g) * 2u; \
        _Pragma("unroll") for (int ks = 0; ks < 4; ++ks) qn[ks] = *(const GAS bf16x8*)((const GAS char*)Qg + _qoff + 64 * ks); } while (0)
    int uid = vcu;
    if (uid < NU) ATTB_PREFETCH(uid);
    for (int t = 0; uid < NU; uid += F.G, ++t) {
        const int cslot = (t & 1) * 32768;
#pragma unroll
        for (int it = 0; it < 4; ++it) { const int idx = it * 512 + tid, row = idx >> 4, gr = idx & 15;
            *(LAS v4u*)(lds + ATT_K_OFF + cslot + row * 256 + ((gr ^ (row & 15)) << 4)) = kr[it];
            *(LAS v4u*)(lds + ATT_V_OFF + cslot + row * 256 + ((gr ^ ((row & 7) << 1)) << 4)) = vr[it]; }
        bf16x8 qf[4];
#pragma unroll
        for (int ks = 0; ks < 4; ++ks) { qf[ks] = qn[ks]; asm volatile("" : "+v"(qf[ks])); }
        ATT_RAW_BAR();
        const int bh = uid >> 4, r = uid & 15, b = bh >> 3, h = bh & 7;
        const size_t qrow = (size_t)b * SEQ + r + 16 * (16 * w + fr);
        const float l0 = LSE[((size_t)0 * M + qrow) * NH + h], l1 = LSE[((size_t)1 * M + qrow) * NH + h];
        if (uid + F.G < NU) ATTB_PREFETCH(uid + F.G);
        f32x4 st[9], o[8]; float mx, lsum;
        attn_qk<false>(lds + ATT_K_OFF + cslot, lds + ATT_K_OFF + cslot, 8, w, lane, qf, BTl + (2 * NH + h) * BT_PITCH, st, mx, lsum);
        attn_pv<false>(lds + ATT_V_OFF + cslot, lds + ATT_V_OFF + cslot, 8, w, lane, st, o);
        v2u p0[8], p1[8];
        {   const bf16* a0 = O0 + qrow * DA + h * HD + 4 * g; const bf16* a1 = O1 + qrow * DA + h * HD + 4 * g;
#pragma unroll
            for (int mt = 0; mt < 8; ++mt) { p0[mt] = *(const GAS v2u*)(a0 + 16 * mt); p1[mt] = *(const GAS v2u*)(a1 + 16 * mt); } }
        const float l2 = mx + log2f(lsum), lm = fmaxf(l2, fmaxf(l0, l1));
        float w0 = exp2f(l0 - lm), w1 = exp2f(l1 - lm), w2 = exp2f(l2 - lm); const float zi = 1.0f / (w0 + w1 + w2); w0 *= zi; w1 *= zi; w2 *= zi / lsum;
        bf16* orow = AG + qrow * 2048 + h * HD + 4 * g;
#pragma unroll
        for (int mt = 0; mt < 8; ++mt) {
            const float y0 = w2 * o[mt][0] + w0 * pg8::bf_lo(p0[mt].x) + w1 * pg8::bf_lo(p1[mt].x), y1 = w2 * o[mt][1] + w0 * pg8::bf_hi(p0[mt].x) + w1 * pg8::bf_hi(p1[mt].x);
            const float y2 = w2 * o[mt][2] + w0 * pg8::bf_lo(p0[mt].y) + w1 * pg8::bf_lo(p1[mt].y), y3 = w2 * o[mt][3] + w0 * pg8::bf_hi(p0[mt].y) + w1 * pg8::bf_hi(p1[mt].y);
            *(GAS v2u*)(orow + 16 * mt) = (v2u){pg8::cvt_pk_bf16(y0, y1), pg8::cvt_pk_bf16(y2, y3)}; }
        ATT_RAW_BAR();
    }
#undef ATTB_PREFETCH
}

__device__ __forceinline__ void gmlp_unit(Frame& F, int uid) {
    const int gg = uid & 7, c = (uid >> 3) & 15, b = uid >> 7;
    const int tid = F.tid, lane = F.lane, w = F.wave, fr = lane & 15, g = lane >> 4;
    LAS unsigned char* lds = F.lds;
    LAS f32x2* STl = (LAS f32x2*)(lds + LDS_BT_OFF);
    const size_t R0 = (size_t)b * SEQ + 128 * c;
    const bf16* VBg = (const bf16*)(F.ws + WS_VB); const bf16* Ug = (const bf16*)(F.ws + WS_U); const bf16* WSP = (const bf16*)(F.ws + WS_WSP) + (size_t)gg * 128 * 128;
    const f32x2* VST = (const f32x2*)(F.ws + WS_VSTAT); bf16* AG = (bf16*)(F.ws + WS_AG);
    const float* gain = F.in[3]; const float* biasv = F.in[4]; const float* bsp = F.in[6];
    const int i = 16 * w + fr, nks = (w >> 1) + 1;
    v4u st8[8];
    if (tid < 128) {
#pragma unroll
        for (int k = 0; k < 8; ++k) st8[k] = *(const GAS v4u*)(VST + (R0 + tid) * 16 + 2 * k);
    }
    v4u raw[4];
#pragma unroll
    for (int it = 0; it < 4; ++it) { const int idx = it * 512 + tid, j = idx >> 4, gr = idx & 15; raw[it] = *(const GAS v4u*)(VBg + (R0 + j) * DB + gg * 128 + gr * 8); }
    const int gr0 = tid & 15;
    const f32x4 g0 = *(const GAS f32x4*)(gain + gg * 128 + gr0 * 8), g1 = *(const GAS f32x4*)(gain + gg * 128 + gr0 * 8 + 4);
    const f32x4 b0 = *(const GAS f32x4*)(biasv + gg * 128 + gr0 * 8), b1 = *(const GAS f32x4*)(biasv + gg * 128 + gr0 * 8 + 4);
    bf16x8 wf[4];
#pragma unroll
    for (int ks = 0; ks < 4; ++ks) wf[ks] = (ks < nks) ? *(const GAS bf16x8*)(WSP + (size_t)i * 128 + 32 * ks + 8 * g) : (bf16x8){0, 0, 0, 0, 0, 0, 0, 0};
    const bf16* urow = Ug + (R0 + i) * DB + gg * 128 + 4 * g;
    v2u uu[8];
#pragma unroll
    for (int mt = 0; mt < 8; ++mt) uu[mt] = *(const GAS v2u*)(urow + 16 * mt);
    const float bs = bsp[gg * 128 + i];
    if (tid < 128) { float s1 = 0.f, s2 = 0.f;
#pragma unroll
        for (int k = 0; k < 8; ++k) { s1 += __uint_as_float(st8[k].x) + __uint_as_float(st8[k].z); s2 += __uint_as_float(st8[k].y) + __uint_as_float(st8[k].w); }
        const float mean = s1 * (1.f / DB), var = fmaxf(s2 * (1.f / DB) - mean * mean, 0.f);
        STl[tid] = (f32x2){mean, 1.0f / sqrtf(var + LN_EPS)}; }
    LDS_WAIT(); __builtin_amdgcn_s_barrier(); asm volatile("" ::: "memory");
#pragma unroll
    for (int it = 0; it < 4; ++it) {
        const int idx = it * 512 + tid, j = idx >> 4, gr = idx & 15;
        const f32x2 st = STl[j]; const v4u r4 = raw[it];
        v4u o;
        o.x = pk2((pg8::bf_lo(r4.x) - st.x) * st.y * g0[0] + b0[0], (pg8::bf_hi(r4.x) - st.x) * st.y * g0[1] + b0[1]);
        o.y = pk2((pg8::bf_lo(r4.y) - st.x) * st.y * g0[2] + b0[2], (pg8::bf_hi(r4.y) - st.x) * st.y * g0[3] + b0[3]);
        o.z = pk2((pg8::bf_lo(r4.z) - st.x) * st.y * g1[0] + b1[0], (pg8::bf_hi(r4.z) - st.x) * st.y * g1[1] + b1[1]);
        o.w = pk2((pg8::bf_lo(r4.w) - st.x) * st.y * g1[2] + b1[2], (pg8::bf_hi(r4.w) - st.x) * st.y * g1[3] + b1[3]);
        *(LAS v4u*)(lds + j * 256 + ((gr ^ ((j & 7) << 1)) << 4)) = o;
    }
    LDS_WAIT(); __builtin_amdgcn_s_barrier(); asm volatile("" ::: "memory");
    f32x4 acc[8];
#pragma unroll
    for (int mt = 0; mt < 8; ++mt) acc[mt] = (f32x4){0.f, 0.f, 0.f, 0.f};
#pragma unroll
    for (int ks = 0; ks < 4; ++ks) if (ks < nks) {
        const int j0 = 32 * ks + 8 * g + (fr >> 2), j1 = j0 + 4;
        const LAS unsigned char* p0 = lds + j0 * 256 + ((lane & 1) << 3); const LAS unsigned char* p1 = lds + j1 * 256 + ((lane & 1) << 3);
        const int s0 = (j0 & 7) << 1, s1 = (j1 & 7) << 1;
#pragma unroll
        for (int mt = 0; mt < 8; ++mt) {
            const int gb = 2 * mt + ((lane & 3) >> 1);
            const s16x4 lo = tr_read(p0 + ((gb ^ s0) << 4)), hi = tr_read(p1 + ((gb ^ s1) << 4));
            const bf16x8 vf = (bf16x8){lo[0], lo[1], lo[2], lo[3], hi[0], hi[1], hi[2], hi[3]};
            acc[mt] = __builtin_amdgcn_mfma_f32_16x16x32_bf16(vf, wf[ks], acc[mt], 0, 0, 0);
        }
    }
    bf16* orow = AG + (R0 + i) * 2048 + 1024 + gg * 128 + 4 * g;
#pragma unroll
    for (int mt = 0; mt < 8; ++mt) {
        const float z0 = (acc[mt][0] + bs) * pg8::bf_lo(uu[mt].x), z1 = (acc[mt][1] + bs) * pg8::bf_hi(uu[mt].x), z2 = (acc[mt][2] + bs) * pg8::bf_lo(uu[mt].y), z3 = (acc[mt][3] + bs) * pg8::bf_hi(uu[mt].y);
        *(GAS v2u*)(orow + 16 * mt) = (v2u){pg8::cvt_pk_bf16(z0, z1), pg8::cvt_pk_bf16(z2, z3)}; }
    LDS_WAIT(); __builtin_amdgcn_s_barrier(); asm volatile("" ::: "memory");
}
__device__ __forceinline__ int vcu_of(const Frame& F) { return (F.G % 8 == 0) ? (F.bid & 7) * (F.G >> 3) + (F.bid >> 3) : F.bid; }
__device__ __forceinline__ void phase_attnA(Frame& F) { attn_phaseA(F, vcu_of(F), F.out); }
__device__ __forceinline__ void phase_attnB(Frame& F) { attn_phaseB(F, vcu_of(F), F.out); }
__device__ __forceinline__ void phase_gmlp(Frame& F) {
    for (int u = F.bid; u < BATCH * 16 * 8; u += F.G) gmlp_unit(F, u);
}

constexpr int N_PHASES = 11;
__global__ void __launch_bounds__(NWAVES * 64, 2) mk_fwd(Args args) {
    extern __shared__ __attribute__((aligned(16))) unsigned char lds_raw[];
    Frame F;
    F.lds = (LAS unsigned char*)lds_raw;
    F.tid = threadIdx.x; F.lane = F.tid & 63; F.wave = __builtin_amdgcn_readfirstlane(F.tid >> 6);
    F.G = gridDim.x; F.bid = blockIdx.x; F.in = args.in; F.out = args.out; F.ws = args.ws;
    for (int u = F.tid; u < (LDS_BYTES - LDSCTL_OFF) / 4; u += NWAVES * 64) ((LAS unsigned*)(F.lds + LDSCTL_OFF))[u] = 0u;
    __syncthreads();
    gu32* ctl = (gu32*)(args.ws + WS_CTL);
    const int lo = args.ph_lo, hi = args.ph_hi;
    XcdBarrier bar; bar.bar = (unsigned*)(ctl + CW_BAR); bar.x = 0; bar.st = nullptr;
    if (hi - lo > 1) bar = xcd_barrier_post((unsigned*)(ctl + CW_BAR), (volatile LAS unsigned*)(F.lds + MISC_OFF) + 8);
#define IN(k) (lo <= (k) && (k) < hi)
#define STAMP(k) do { if (MK_TPROBE && F.bid == 0 && F.tid == 0) ((unsigned long long*)(ctl + CW_TS))[k] = __builtin_amdgcn_s_memrealtime(); } while (0)
#define SEAM(k) do { if (IN(k) && IN((k) + 1)) xcd_barrier(bar); STAMP((k) + 1); } while (0)
    STAMP(0);
    unsigned char* ws = args.ws;
    if (IN(0)) { phase_prologue(F); SEAM(0); }
    if (IN(1)) {
        pg8::Gemm g{(const bf16*)(ws + WS_XB), (const bf16*)(ws + WS_WIN), DM, DM, 0}; pg8::StaticOrder S; S.init(M, DIN, F.G, F.bid);
        pg8::EpiProj E{(bf16*)(ws + WS_Q), (bf16*)(ws + WS_K), (bf16*)(ws + WS_V), (bf16*)(ws + WS_U), (bf16*)(ws + WS_VB), (bf16*)(ws + WS_GA), (bf16*)(ws + WS_GB), (pg8::f32x2*)(ws + WS_VSTAT), QSCALE};
        pg8::gemm_phase<pg8::EpiProj, pg8::StaticOrder, true>(F.lds + RING_OFF, g, S, E);
        SEAM(1);
    }
    if (IN(2)) { phase_attnA(F); if (MK_TPROBE) SEAM(2); }
    if (IN(3)) { phase_gmlp(F); SEAM(3); }
    if (IN(4)) { phase_attnB(F); SEAM(4); }
    if (IN(5)) {
        pg8::Gemm g{(const bf16*)(ws + WS_AG), (const bf16*)(ws + WS_WPAB), 1024, 2048, 2048}; pg8::PairOrder S; S.so.init(M, DM, F.G, F.bid);
        pg8::EpiGate E{(const unsigned char*)(ws + WS_GA), (const unsigned char*)(ws + WS_GB), (bf16*)(ws + WS_MRG)};
        pg8::gemm_phase<pg8::EpiGate, pg8::PairOrder, true>(F.lds + RING_OFF, g, S, E);
        SEAM(5);
    }
    if (IN(6)) {
        pg8::Gemm g{(const bf16*)(ws + WS_MRG), (const bf16*)(ws + WS_WOUT), DM, DM, 0}; pg8::StaticOrder S; S.init(M, DM, F.G, F.bid);
        pg8::EpiBiasAct<0> E{(bf16*)(ws + WS_MIX), DM, nullptr};
        pg8::gemm_phase<pg8::EpiBiasAct<0>, pg8::StaticOrder, true>(F.lds + RING_OFF, g, S, E);
        SEAM(6);
    }
    if (IN(7)) { phase_ln<false>(F, args.in[0], nullptr, (const bf16*)(ws + WS_MIX), nullptr, args.in[10], args.in[11], (bf16*)(ws + WS_HB)); SEAM(7); }
    if (IN(8)) {
        pg8::Gemm g{(const bf16*)(ws + WS_HB), (const bf16*)(ws + WS_W1), DM, DM, 0}; pg8::StaticOrder S; S.init(M, DFF, F.G, F.bid);
        pg8::EpiBiasAct<1> E{(bf16*)(ws + WS_ACT), DFF, args.in[13]};
        pg8::gemm_phase<pg8::EpiBiasAct<1>, pg8::StaticOrder, true>(F.lds + RING_OFF, g, S, E);
        SEAM(8);
    }
    if (IN(9)) {
        pg8::Gemm g{(const bf16*)(ws + WS_ACT), (const bf16*)(ws + WS_W2), DFF, DFF, 0}; pg8::StaticOrder S; S.init(M, DM, F.G, F.bid);
        pg8::EpiBiasAct<0> E{(bf16*)(ws + WS_FF), DM, args.in[15]};
        pg8::gemm_phase<pg8::EpiBiasAct<0>, pg8::StaticOrder, true>(F.lds + RING_OFF, g, S, E);
        SEAM(9);
    }
    if (IN(10)) { phase_ln<true>(F, nullptr, (const bf16*)(ws + WS_HB), (const bf16*)(ws + WS_FF), args.out, args.in[16], args.in[17], nullptr); }
#if MK_TPROBE
    if (hi - lo > 1) {
        xcd_barrier(bar); STAMP(11);
        if (F.bid == 0 && F.tid == 0) {
            const unsigned long long* ts = (const unsigned long long*)(ctl + CW_TS);
            const unsigned long long dt = (ts[MK_TPA + 1] - ts[MK_TPA]) * (unsigned long long)(MK_TPB), t0 = __builtin_amdgcn_s_memrealtime();
            while (__builtin_amdgcn_s_memrealtime() - t0 < dt) __builtin_amdgcn_s_sleep(20);
        }
    }
#endif
#undef IN
#undef SEAM
}

#if MK_DEBUG_CHECKS
__device__ __forceinline__ unsigned hsh(unsigned x) { x ^= x >> 16; x *= 0x7feb352dU; x ^= x >> 15; x *= 0x846ca68bU; x ^= x >> 16; return x; }
__device__ float dot_bf(const bf16* a, const bf16* b, int K) { float s = 0.f; for (int k = 0; k < K; ++k) s += bf2f(a[k]) * bf2f(b[k]); return s; }
__device__ __forceinline__ bool bad(float got, float ex, float rt, float at) { return !(fabsf(got - ex) <= at + rt * fabsf(ex)); }
__device__ float gelu_ref(float v) { return 0.5f * v * (1.0f + tanhf(0.7978845608028654f * (v + 0.044715f * v * v * v))); }
__global__ void mk_check(Args args, int stage) {
    const unsigned gid = blockIdx.x * blockDim.x + threadIdx.x; unsigned char* ws = args.ws; unsigned* flag = (unsigned*)(ws + WS_CTL) + CW_CHK + stage;
    const unsigned h1 = hsh(gid * 2654435761u + 17u * stage + 1u), h2 = hsh(h1 + 0x9e3779b9u), h3 = hsh(h2 + 0x85ebca6bu);
    bool fail = false;
    if (stage == 0) {
        const int sel = gid % 7;
        if (sel == 0) { const int n = h1 % DIN, k = h2 % DM; fail = ((const bf16*)(ws + WS_WIN))[(size_t)n * DM + k] != (bf16)f2bf(args.in[1][(size_t)k * DIN + n]); }
        else if (sel == 1) { const int n = h1 % DM, k = h2 % DA; fail = ((const bf16*)(ws + WS_WPAB))[(size_t)n * 2048 + k] != (bf16)f2bf(args.in[7][(size_t)k * DM + n]); }
        else if (sel == 2) { const int n = h1 % DM, k = h2 % DB; fail = ((const bf16*)(ws + WS_WPAB))[(size_t)n * 2048 + 1024 + k] != (bf16)f2bf(args.in[8][(size_t)k * DM + n]); }
        else if (sel == 3) { const int n = h1 % DM, k = h2 % DM; fail = ((const bf16*)(ws + WS_WOUT))[(size_t)n * DM + k] != (bf16)f2bf(args.in[9][(size_t)k * DM + n]); }
        else if (sel == 4) { const int m = h1 % M, k = h2 % DM; fail = ((const bf16*)(ws + WS_XB))[(size_t)m * DM + k] != (bf16)f2bf(args.in[0][(size_t)m * DM + k]); }
        else if (sel == 5) { const int e = h1 % (8 * 128 * 128), i = (e >> 7) & 127, j = e & 127; fail = ((const bf16*)(ws + WS_WSP))[e] != (bf16)(j <= i ? f2bf(args.in[5][e]) : 0u); }
        else { const int p = h1 % 3, h = h2 % 8, j = h3 % 129; const float ex = args.in[2][t5_bucket(j * pat_dil(p)) * NH + h] * LOG2E; fail = bad(((const float*)(ws + WS_BTAB))[(p * NH + h) * BT_PITCH + j], ex, 1e-5f, 1e-6f); }
    } else if (stage == 1) {
        const int row = h1 % M, col = h2 % DIN;
        if (gid < 7680) {
            const float dv = dot_bf((const bf16*)(ws + WS_XB) + (size_t)row * DM, (const bf16*)(ws + WS_WIN) + (size_t)col * DM, DM);
            float ex, got;
            if (col < 1024) { ex = dv * QSCALE; got = bf2f(((const bf16*)(ws + WS_Q))[(size_t)row * 1024 + col]); }
            else if (col < 2048) { ex = dv; got = bf2f(((const bf16*)(ws + WS_K))[(size_t)row * 1024 + col - 1024]); }
            else if (col < 3072) { ex = dv; got = bf2f(((const bf16*)(ws + WS_V))[(size_t)row * 1024 + col - 2048]); }
            else if (col < 4096) { ex = gelu_ref(dv); got = bf2f(((const bf16*)(ws + WS_U))[(size_t)row * 1024 + col - 3072]); }
            else if (col < 5120) { ex = gelu_ref(dv); got = bf2f(((const bf16*)(ws + WS_VB))[(size_t)row * 1024 + col - 4096]); }
            else if (col < 7168) { ex = dv; got = bf2f(((const bf16*)(ws + WS_GA))[(size_t)row * 2048 + col - 5120]); }
            else { ex = dv; got = bf2f(((const bf16*)(ws + WS_GB))[(size_t)row * 2048 + col - 7168]); }
            fail = bad(got, ex, 1.5e-2f, 1e-2f);
        } else {
            float s1 = 0.f, s2 = 0.f; for (int c = 0; c < 1024; ++c) { const float v = bf2f(((const bf16*)(ws + WS_VB))[(size_t)row * 1024 + c]); s1 += v; s2 += v * v; }
            float t1 = 0.f, t2 = 0.f; for (int k = 0; k < 16; ++k) { const f32x2 t = ((const f32x2*)(ws + WS_VSTAT))[(size_t)row * 16 + k]; t1 += t.x; t2 += t.y; }
            fail = bad(t1, s1, 1e-2f, 1.0f) || bad(t2, s2, 1e-2f, 1.0f);
        }
    } else if (stage == 2) {
        if (gid < 6144) {
            const int b = h1 % BATCH, s = h2 % SEQ, h = h3 % NH, p = (h3 >> 8) % 3, d = pat_dil(p);
            const bf16* Qg = (const bf16*)(ws + WS_Q); const bf16* Kg = (const bf16*)(ws + WS_K); const bf16* Vg = (const bf16*)(ws + WS_V);
            const bf16* Og = (const bf16*)(ws + (p == 0 ? WS_O0 : (p == 1 ? WS_O1 : WS_O2))); const float* BT = (const float*)(ws + WS_BTAB) + (p * NH + h) * BT_PITCH;
            const size_t qrow = (size_t)b * SEQ + s; float mx = -1e30f;
            for (int j = 0; j <= 128; ++j) { const int sk = s - j * d; if (sk < 0) break; const float sc = dot_bf(Qg + qrow * DA + h * HD, Kg + ((size_t)b * SEQ + sk) * DA + h * HD, HD) + BT[j]; mx = fmaxf(mx, sc); }
            float den = 0.f; for (int j = 0; j <= 128; ++j) { const int sk = s - j * d; if (sk < 0) break; const float sc = dot_bf(Qg + qrow * DA + h * HD, Kg + ((size_t)b * SEQ + sk) * DA + h * HD, HD) + BT[j]; den += exp2f(sc - mx); }
            const float l2 = mx + log2f(den);
            fail = bad(((const float*)(ws + WS_LSE))[((size_t)p * M + qrow) * NH + h], l2, 2e-3f, 2e-2f);
            for (int dd = 0; dd < HD; dd += 7) { float o = 0.f;
                for (int j = 0; j <= 128; ++j) { const int sk = s - j * d; if (sk < 0) break; const float sc = dot_bf(Qg + qrow * DA + h * HD, Kg + ((size_t)b * SEQ + sk) * DA + h * HD, HD) + BT[j]; o += exp2f(sc - mx) * bf2f(Vg[((size_t)b * SEQ + sk) * DA + h * HD + dd]); }
                o /= den; fail = fail || bad(bf2f(Og[qrow * DA + h * HD + dd]), o, 3e-2f, 1e-2f); }
        } else {
            const int row = h1 % M, ch = h2 % DB, gg = ch >> 7, i = row & 127; const size_t R0 = (size_t)(row - i);
            const bf16* WSP = (const bf16*)(ws + WS_WSP) + (size_t)gg * 128 * 128;
            float z = args.in[6][gg * 128 + i];
            for (int j = 0; j <= i; ++j) { float s1 = 0.f, s2 = 0.f; for (int k = 0; k < 16; ++k) { const f32x2 t = ((const f32x2*)(ws + WS_VSTAT))[(R0 + j) * 16 + k]; s1 += t.x; s2 += t.y; }
                const float mean = s1 / DB, var = fmaxf(s2 / DB - mean * mean, 0.f), rstd = 1.0f / sqrtf(var + LN_EPS);
                const float vn = (bf2f(((const bf16*)(ws + WS_VB))[(R0 + j) * DB + ch]) - mean) * rstd * args.in[3][ch] + args.in[4][ch];
                z += bf2f(WSP[i * 128 + j]) * bf2f((bf16)f2bf(vn)); }
            const float ex = z * bf2f(((const bf16*)(ws + WS_U))[(size_t)row * DB + ch]);
            fail = bad(bf2f(((const bf16*)(ws + WS_AG))[(size_t)row * 2048 + 1024 + ch]), ex, 2e-2f, 1e-2f);
        }
    } else if (stage == 3) {
        const int row = h1 % M, col = h2 % DA, h = col >> 7; const float* LSE = (const float*)(ws + WS_LSE);
        const float l0 = LSE[((size_t)0 * M + row) * NH + h], l1 = LSE[((size_t)1 * M + row) * NH + h], l2 = LSE[((size_t)2 * M + row) * NH + h], mx = fmaxf(l0, fmaxf(l1, l2));
        const float w0 = exp2f(l0 - mx), w1 = exp2f(l1 - mx), w2 = exp2f(l2 - mx);
        const float ex = (w0 * bf2f(((const bf16*)(ws + WS_O0))[(size_t)row * DA + col]) + w1 * bf2f(((const bf16*)(ws + WS_O1))[(size_t)row * DA + col]) + w2 * bf2f(((const bf16*)(ws + WS_O2))[(size_t)row * DA + col])) / (w0 + w1 + w2);
        fail = bad(bf2f(((const bf16*)(ws + WS_AG))[(size_t)row * 2048 + col]), ex, 1e-2f, 5e-3f);
    } else if (stage == 4) {
        const int row = h1 % M, col = h2 % DM; const bf16* AG = (const bf16*)(ws + WS_AG) + (size_t)row * 2048; const bf16* Wt = (const bf16*)(ws + WS_WPAB) + (size_t)col * 2048;
        const float ya = dot_bf(AG, Wt, 1024), yb = dot_bf(AG + 1024, Wt + 1024, 1024);
        const float ga = bf2f(((const bf16*)(ws + WS_GA))[(size_t)row * 2048 + col]), gb = bf2f(((const bf16*)(ws + WS_GB))[(size_t)row * 2048 + col]);
        const float ex = ya / (1.f + expf(-ga)) + yb / (1.f + expf(-gb));
        fail = bad(bf2f(((const bf16*)(ws + WS_MRG))[(size_t)row * 2048 + col]), ex, 2e-2f, 5e-3f);
    } else if (stage == 5) {
        const int row = h1 % M, col = h2 % DM;
        const float ex = ALPHA * args.in[0][(size_t)row * DM + col] + dot_bf((const bf16*)(ws + WS_MRG) + (size_t)row * 2048, (const bf16*)(ws + WS_WOUT) + (size_t)col * 2048, DM);
        fail = bad(args.out[(size_t)row * DM + col], ex, 2e-3f, 2e-3f);
    } else if (stage == 6 || stage == 9) {
        const float* gain = args.in[stage == 6 ? 10 : 16]; const float* bias = args.in[stage == 6 ? 11 : 17];
        if (gid < 2048) { const int row = h1 % M; float s1 = 0.f, s2 = 0.f;
            for (int c = 0; c < DM; ++c) { const float v = (args.out[(size_t)row * DM + c] - bias[c]) / gain[c]; s1 += v; s2 += v * v; }
            const float mean = s1 / DM, var = s2 / DM - mean * mean; fail = (fabsf(mean) > 2e-3f) || (fabsf(var - 1.f) > 1e-2f);
        } else if (stage == 6) {
            const int sel = gid % 3;
            if (sel == 0) { const int row = h1 % M, c = h2 % DM; fail = bad(bf2f(((const bf16*)(ws + WS_HB))[(size_t)row * DM + c]), args.out[(size_t)row * DM + c], 5e-3f, 1e-4f); }
            else if (sel == 1) { const int n = h1 % DFF, k = h2 % DM; fail = ((const bf16*)(ws + WS_W1))[(size_t)n * DM + k] != (bf16)f2bf(args.in[12][(size_t)k * DFF + n]); }
            else { const int n = h1 % DM, k = h2 % DFF; fail = ((const bf16*)(ws + WS_W2))[(size_t)n * DFF + k] != (bf16)f2bf(args.in[14][(size_t)k * DM + n]); }
        }
    } else if (stage == 7) {
        const int row = h1 % M, col = h2 % DFF;
        const float v = dot_bf((const bf16*)(ws + WS_HB) + (size_t)row * DM, (const bf16*)(ws + WS_W1) + (size_t)col * DM, DM) + args.in[13][col]; const float r = fmaxf(v, 0.f);
        fail = bad(bf2f(((const bf16*)(ws + WS_ACT))[(size_t)row * DFF + col]), r * r, 2e-2f, 5e-3f);
    } else if (stage == 8) {
        const int row = h1 % M, col = h2 % DM;
        const float ex = ALPHA * bf2f(((const bf16*)(ws + WS_HB))[(size_t)row * DM + col]) + dot_bf((const bf16*)(ws + WS_ACT) + (size_t)row * DFF, (const bf16*)(ws + WS_W2) + (size_t)col * DFF, DFF) + args.in[15][col];
        fail = bad(args.out[(size_t)row * DM + col], ex, 5e-3f, 3e-2f);
    }
    if (fail) atomicAdd(flag, 1u);
}
__global__ void mk_report(Args args) {
    const unsigned* flag = (const unsigned*)(args.ws + WS_CTL) + CW_CHK;
    if (threadIdx.x == 0 && blockIdx.x == 0) { for (int s = 0; s < N_PHASES; ++s) if (flag[s] != 0u) { args.out[0] = 1000.0f * (float)(s + 1); break; } }
}
#endif

extern "C" void kernel_launch(void* const* d_in, const int* in_sizes, int n_in, void* d_out, int out_size, void* d_ws, size_t ws_size, hipStream_t stream) {
    static int grid = 0;
    if (grid == 0) {
        if (n_in != 18 || in_sizes[0] != M * DM || out_size != M * DM || ws_size < WS_END) { fprintf(stderr, "kernel_launch: unexpected shapes (n_in %d, in0 %d, out %d, ws %zu); nothing launched\n", n_in, n_in > 0 ? in_sizes[0] : -1, out_size, ws_size); grid = -1; return; }
        int dev = 0, cus = 0, per_cu = 0;
        if (hipGetDevice(&dev) != hipSuccess || hipDeviceGetAttribute(&cus, hipDeviceAttributeMultiprocessorCount, dev) != hipSuccess) { grid = -1; return; }
        if (hipFuncSetAttribute((const void*)mk_fwd, hipFuncAttributeMaxDynamicSharedMemorySize, LDS_BYTES) != hipSuccess) { fprintf(stderr, "kernel_launch: hipFuncSetAttribute failed\n"); grid = -1; return; }
        if (hipOccupancyMaxActiveBlocksPerMultiprocessor(&per_cu, (const void*)mk_fwd, NWAVES * 64, LDS_BYTES) != hipSuccess || per_cu < 1) { fprintf(stderr, "kernel_launch: occupancy query reports %d blocks per CU\n", per_cu); (void)hipGetLastError(); grid = -1; return; }
        grid = cus;
    }
    if (grid < 0) return;
    (void)hipMemsetAsync((char*)d_ws + WS_CTL, 0, CTL_ZERO_BYTES, stream);
    Args a{};
    for (int i = 0; i < 18; ++i) a.in[i] = (const float*)d_in[i];
    a.out = (float*)d_out; a.ws = (unsigned char*)d_ws;
#if MK_ONE_LAUNCH
    a.ph_lo = 0; a.ph_hi = N_PHASES;
    hipLaunchKernelGGL(mk_fwd, dim3(grid), dim3(NWAVES * 64), LDS_BYTES, stream, a);
#else
    for (int ph = 0; ph < N_PHASES; ++ph) {
        a.ph_lo = ph; a.ph_hi = ph + 1;
        hipLaunchKernelGGL(mk_fwd, dim3(grid), dim3(NWAVES * 64), LDS_BYTES, stream, a);
        if (ph == (MK_REPEAT_PHASE)) hipLaunchKernelGGL(mk_fwd, dim3(grid), dim3(NWAVES * 64), LDS_BYTES, stream, a);
#if MK_DEBUG_CHECKS
        hipLaunchKernelGGL(mk_check, dim3(32), dim3(256), 0, stream, a, ph);
#endif
    }
#if MK_DEBUG_CHECKS
    hipLaunchKernelGGL(mk_report, dim3(1), dim3(64), 0, stream, a);
#endif
#endif
}
```
